# Optimizing an MI355X kernel written in HIP

```python
import jax, jax.numpy as jnp
from jax import lax
import numpy as np

D_MODEL = 1024
BATCH = 16
SEQ = 4096
DEPTH = 4

A_WIDTH = D_MODEL
A_GROUPS = 8
A_GROUP_DIM = A_WIDTH // A_GROUPS
CHUNK = 128
B_WIDTH = D_MODEL
B_HEADS = 8
B_HEAD_DIM = B_WIDTH // B_HEADS
CONV_WIDTH = 4
LRU_C = 8.0
NORM_EPS = 1e-6
IN_WIDTH = 3 * A_WIDTH + 2 * B_WIDTH + 2 * D_MODEL

kernel_name = 'hybrid_gmlp_rglru_gated_trunk'


def rms_norm(x, g):
    xf = x.astype(jnp.float32)
    xf = xf * lax.rsqrt(jnp.mean(xf * xf, axis=-1, keepdims=True) + NORM_EPS)
    return (xf * g.astype(jnp.float32)).astype(x.dtype)


def spatial_gating(u, v, v_g, w_s, b_s):
    bsz, seq, _ = v.shape
    v = rms_norm(jax.nn.gelu(v), v_g)
    v = v.reshape(bsz, seq // CHUNK, CHUNK, A_GROUPS, A_GROUP_DIM)
    causal = jnp.tril(jnp.ones((CHUNK, CHUNK), dtype=w_s.dtype))
    sv = jnp.einsum('gts,bnsgc->bntgc', w_s * causal, v) + jnp.transpose(b_s)[None, None, :, :, None]
    return jax.nn.gelu(u) * sv.reshape(bsz, seq, A_WIDTH)


def linear_scan_combine(c1, c2):
    a1, b1 = c1
    a2, b2 = c2
    return a1 * a2, a2 * b1 + b2


def rg_lru_branch(xb, conv_w, conv_b, w_r, b_r, w_i, b_i, lam):
    bsz, seq, _ = xb.shape
    xp = jnp.pad(xb, ((0, 0), (CONV_WIDTH - 1, 0), (0, 0)))
    xc = conv_b + sum(xp[:, k:k + seq] * conv_w[k] for k in range(CONV_WIDTH))
    xg = xc.reshape(bsz, seq, B_HEADS, B_HEAD_DIM)
    r = jax.nn.sigmoid(jnp.einsum('bshi,hij->bshj', xg, w_r).reshape(bsz, seq, B_WIDTH) + b_r)
    i = jax.nn.sigmoid(jnp.einsum('bshi,hij->bshj', xg, w_i).reshape(bsz, seq, B_WIDTH) + b_i)
    log_a = -LRU_C * jax.nn.softplus(-lam.astype(jnp.float32)) * r.astype(jnp.float32)
    a = jnp.exp(log_a)
    gated_x = jnp.sqrt(-jnp.expm1(2.0 * log_a)) * (i * xc).astype(jnp.float32)
    _, h = lax.associative_scan(linear_scan_combine, (a, gated_x), axis=1)
    return h.astype(xb.dtype)


def setup_inputs(seed: int = 0) -> dict:
    key = jax.random.key(seed)
    ks = jax.random.split(key, 18)

    def nrm(k, shape, scale):
        return scale * jax.random.normal(k, shape, jnp.float32)

    a_init = jax.random.uniform(ks[13], (DEPTH, B_WIDTH), jnp.float32, 0.9, 0.999) ** (1.0 / LRU_C)
    return {
        'x': nrm(ks[0], (BATCH, SEQ, D_MODEL), 1.0),
        'norm_g': 1.0 + nrm(ks[1], (DEPTH, D_MODEL), 0.02),
        'w_in': nrm(ks[2], (DEPTH, D_MODEL, IN_WIDTH), D_MODEL ** -0.5),
        'b_merge': nrm(ks[3], (DEPTH, 2, D_MODEL), 0.1),
        'v_norm_g': 1.0 + nrm(ks[4], (DEPTH, A_WIDTH), 0.02),
        'w_spatial': nrm(ks[5], (DEPTH, A_GROUPS, CHUNK, CHUNK), 0.5 * CHUNK ** -0.5),
        'b_spatial': 1.0 + nrm(ks[6], (DEPTH, A_GROUPS, CHUNK), 0.02),
        'conv_w': nrm(ks[7], (DEPTH, CONV_WIDTH, B_WIDTH), CONV_WIDTH ** -0.5),
        'conv_b': nrm(ks[8], (DEPTH, B_WIDTH), 0.02),
        'w_rgate': nrm(ks[9], (DEPTH, B_HEADS, B_HEAD_DIM, B_HEAD_DIM), B_HEAD_DIM ** -0.5),
        'b_rgate': nrm(ks[10], (DEPTH, B_WIDTH), 0.02),
        'w_igate': nrm(ks[11], (DEPTH, B_HEADS, B_HEAD_DIM, B_HEAD_DIM), B_HEAD_DIM ** -0.5),
        'b_igate': nrm(ks[12], (DEPTH, B_WIDTH), 0.02),
        'lru_lambda': jnp.log(a_init) - jnp.log1p(-a_init),
        'w_proj_a': nrm(ks[14], (DEPTH, A_WIDTH, D_MODEL), A_WIDTH ** -0.5),
        'w_proj_b': nrm(ks[15], (DEPTH, B_WIDTH, D_MODEL), B_WIDTH ** -0.5),
        'w_out': nrm(ks[16], (DEPTH, D_MODEL, D_MODEL), D_MODEL ** -0.5),
        'final_g': 1.0 + nrm(ks[17], (D_MODEL,), 0.02),
    }


def reference(x, norm_g, w_in, b_merge, v_norm_g, w_spatial, b_spatial, conv_w, conv_b,
              w_rgate, b_rgate, w_igate, b_igate, lru_lambda, w_proj_a, w_proj_b, w_out, final_g):
    sizes = (A_WIDTH, A_WIDTH, A_WIDTH, B_WIDTH, B_WIDTH, D_MODEL, D_MODEL)
    cuts = [int(c) for c in np.cumsum(sizes)[:-1]]
    for l in range(DEPTH):
        h = rms_norm(x, norm_g[l])
        proj = jnp.einsum('bsd,de->bse', h, w_in[l])
        u, v, z_a, x_b, z_b, g_a, g_b = jnp.split(proj, cuts, axis=-1)
        y_a = spatial_gating(u, v, v_norm_g[l], w_spatial[l], b_spatial[l]) * jax.nn.silu(z_a)
        y_b = rg_lru_branch(x_b, conv_w[l], conv_b[l], w_rgate[l], b_rgate[l],
                            w_igate[l], b_igate[l], lru_lambda[l]) * jax.nn.silu(z_b)
        merged = (jax.nn.sigmoid(g_a + b_merge[l, 0]) * (y_a @ w_proj_a[l])
                  + jax.nn.sigmoid(g_b + b_merge[l, 1]) * (y_b @ w_proj_b[l]))
        x = x + merged @ w_out[l]
    return rms_norm(x, final_g)
```

```cpp
#include <hip/hip_runtime.h>
#include <hip/hip_cooperative_groups.h>
#include <cstdio>
namespace cg = cooperative_groups;

#define LAS __attribute__((address_space(3)))
typedef unsigned short bf16_t;
typedef short bf16x8 __attribute__((ext_vector_type(8)));
typedef float f32x4 __attribute__((ext_vector_type(4)));
typedef unsigned u32x4 __attribute__((ext_vector_type(4)));
typedef unsigned u32x2 __attribute__((ext_vector_type(2)));

constexpr int DM = 1024, NBATCH = 16, SEQ = 4096, MTOT = NBATCH * SEQ, DEPTH = 4, NIN = 7168;
constexpr int NGRP = 2, MG = MTOT / NGRP, BG = NBATCH / NGRP;
constexpr int LSEG = 128, NSEG = SEQ / LSEG;
constexpr int NBITEM = BG * 8 * NSEG, NAITEM = (MG / 128) * 8;
constexpr float EPS = 1e-6f;
constexpr int LDS_BYTES = 142848 + 16;

constexpr size_t WS_WIN = 0;
constexpr size_t WS_WP = WS_WIN + (size_t)DEPTH * NIN * DM * 2;
constexpr size_t WS_WO = WS_WP + (size_t)DEPTH * DM * 2048 * 2;
constexpr size_t WS_WSB = WS_WO + (size_t)DEPTH * DM * DM * 2;
constexpr size_t WS_WRT = WS_WSB + (size_t)DEPTH * 8 * 128 * 128 * 2;
constexpr size_t WS_WIT = WS_WRT + (size_t)DEPTH * 8 * 128 * 128 * 2;
constexpr size_t WS_XBF = WS_WIT + (size_t)DEPTH * 8 * 128 * 128 * 2;
constexpr size_t WS_SSQX = WS_XBF + (size_t)MTOT * DM * 2;
constexpr size_t WS_SSQV = WS_SSQX + (size_t)MTOT * 16 * 4;
constexpr size_t WS_PROJ = WS_SSQV + (size_t)MG * 16 * 4;
constexpr size_t WS_Y = WS_PROJ + (size_t)7 * MG * DM * 2;
constexpr size_t WS_MB = WS_Y + (size_t)MG * 2048 * 2;
constexpr size_t WS_PAY = WS_MB + (size_t)MG * DM * 2;
constexpr size_t WS_PAYP = WS_PAY + (size_t)NBITEM * 8 * 16 * 8;
constexpr size_t WS_FLG = WS_PAYP + (size_t)NBITEM * 8 * 16 * 4;
constexpr size_t WS_BAR = WS_FLG + (size_t)NBITEM * 8 * 4;
constexpr size_t WS_END = WS_BAR + 16384;

struct Params {
    const float* x; const float* norm_g; const float* w_in; const float* b_merge; const float* v_norm_g; const float* w_spatial; const float* b_spatial;
    const float* conv_w; const float* conv_b; const float* w_rgate; const float* b_rgate; const float* w_igate; const float* b_igate; const float* lru_lambda;
    const float* w_proj_a; const float* w_proj_b; const float* w_out; const float* final_g;
    float* out; unsigned char* ws;
};

__device__ __forceinline__ float shfl_idx_(float v, int src_lane) { return __uint_as_float((unsigned)__builtin_amdgcn_ds_bpermute(src_lane << 2, (int)__float_as_uint(v))); }
__device__ __forceinline__ int lane_id_() { return (int)__builtin_amdgcn_mbcnt_hi(~0u, __builtin_amdgcn_mbcnt_lo(~0u, 0u)); }
__device__ __forceinline__ unsigned cvt_pk_bf16(float lo, float hi) { unsigned r; asm volatile("v_cvt_pk_bf16_f32 %0, %1, %2" : "=v"(r) : "v"(lo), "v"(hi)); return r; }
__device__ __forceinline__ float bf_lo(unsigned w) { return __uint_as_float(w << 16); }
__device__ __forceinline__ float bf_hi(unsigned w) { return __uint_as_float(w & 0xffff0000u); }
__device__ __forceinline__ float fast_rcp(float x) { return __builtin_amdgcn_rcpf(x); }
__device__ __forceinline__ float fast_exp2(float x) { return __builtin_amdgcn_exp2f(x); }
__device__ __forceinline__ float sigmoidf_(float x) { return fast_rcp(1.0f + fast_exp2(-1.4426950409f * x)); }

namespace pg8 {
constexpr int BM = 256, BK = 64, HALF = 128, HTB = HALF * BK * 2, STAGE_BYTES = 8 * HTB, NXCD = 8, WGM = 8;
__host__ __device__ __forceinline__ int lds_byte(int r, int c) { const int st = (r >> 4) * 2 + (c >> 5), rr = r & 15, cc = c & 31, ob = rr * 64 + cc * 2; return st * 1024 + (ob ^ (((ob >> 9) & 1) << 5)); }
__host__ __device__ __forceinline__ void stage_rc(int b, int& R, int& C) { const int st = b / 1024, sb = b % 1024, swz = sb ^ (((sb >> 9) & 1) << 5); R = (st >> 1) * 16 + swz / 64; C = (st & 1) * 32 + (swz % 64) / 2; }
__host__ __device__ __forceinline__ int perm32(int rho) { const int n = rho >> 4, i = rho & 15; return 8 * (i >> 2) + 4 * n + (i & 3); }
struct Unit { int pm, pn; };
struct Gemm { const bf16_t* A; const bf16_t* Bt; int M, N, K; };
struct StaticOrder {
    int nM, nN, nwg, G, c;
    __device__ void init(int M, int N, int G_, int c_) { nM = M / BM; nN = N / BM; nwg = nM * nN; G = G_; c = c_; }
    __device__ bool next(int i, Unit& u) const {
        const long L = (long)i * G + c; if (L >= nwg) return false;
        int wgid = (int)L; { const int q = nwg / NXCD, r = nwg % NXCD, xcd = wgid % NXCD, off = wgid / NXCD; wgid = (xcd < r ? xcd * (q + 1) : r * (q + 1) + (xcd - r) * q) + off; }
        const int nig = WGM * nN, gid = wgid / nig, fm = gid * WGM, gsz = (nM - fm) < WGM ? (nM - fm) : WGM;
        u.pm = fm + ((wgid % nig) % gsz); u.pn = (wgid % nig) / gsz; return true;
    }
};
template <class Epi>
__device__ __forceinline__ void gemm_phase(LAS unsigned char* lds, const Gemm g, const StaticOrder& S, const Epi& E, int wid_s) {
    int tid_ = wid_s * 64 + lane_id_(); asm volatile("" : "+v"(tid_));
    const int tid = tid_, wid = __builtin_amdgcn_readfirstlane(tid >> 6), lane = tid & 63, wr = wid >> 2, wc = wid & 3, fr = lane & 15, fq = lane >> 4;
    const int K = g.K, nt = K / BK;
    unsigned voffA[2], voffB[2];
#pragma unroll
    for (int i = 0; i < 2; ++i) { int R, C; stage_rc(tid * 16 + i * 8192, R, C); const int Rb = ((R & ~31) + perm32(R & 31));
        voffA[i] = (unsigned)(R * K + C) * 2u; voffB[i] = (unsigned)(Rb * K + C) * 2u; }
    const size_t kstep = (size_t)(BK * 2);
    const size_t hstep = (size_t)HALF * K * 2;
    const size_t tstep = 2 * hstep;
    const unsigned ldsw = (unsigned)wid * 1024u;
    const int aoff = lds_byte(wr * 64 + fr, fq * 8), boff = lds_byte(wc * 32 + fr, fq * 8);
#define PG8_SA(b, h) (((b) * 2 + (h)) * HTB)
#define PG8_SB(b, h) ((4 + (b) * 2 + (h)) * HTB)
#define PG8_STAGE(bufoff, gbase, voff) do { _Pragma("unroll") for (int _i = 0; _i < 2; ++_i) \
        __builtin_amdgcn_global_load_lds((const unsigned*)((const char*)(gbase) + (voff)[_i]), (LAS unsigned*)(lds + (bufoff) + ldsw + _i * 8192), 16, 0, 0); } while (0)
#define PG8_LDA(dst, b, h) do { _Pragma("unroll") for (int m = 0; m < 4; ++m) _Pragma("unroll") for (int k = 0; k < 2; ++k) dst[m][k] = *(const LAS bf16x8*)(lds + PG8_SA(b, h) + aoff + m * 2048 + k * 1024); } while (0)
#define PG8_LDB(dst, b, h) do { _Pragma("unroll") for (int n = 0; n < 2; ++n) _Pragma("unroll") for (int k = 0; k < 2; ++k) dst[n][k] = *(const LAS bf16x8*)(lds + PG8_SB(b, h) + boff + n * 2048 + k * 1024); } while (0)
#define PG8_MMA(ai, bj, At, Bt) do { __builtin_amdgcn_s_setprio(1); _Pragma("unroll") for (int m = 0; m < 4; ++m) _Pragma("unroll") for (int n = 0; n < 2; ++n) _Pragma("unroll") for (int k = 0; k < 2; ++k) \
        acc[ai][bj][m][n] = __builtin_amdgcn_mfma_f32_16x16x32_bf16(Bt[n][k], At[m][k], acc[ai][bj][m][n], 0, 0, 0); __builtin_amdgcn_s_setprio(0); } while (0)
#define PG8_WAIT_V(n) asm volatile("s_waitcnt vmcnt(" #n ")" ::: "memory")
#define PG8_WAIT_L(n) asm volatile("s_waitcnt lgkmcnt(" #n ")" ::: "memory")
#define PG8_BAR __builtin_amdgcn_s_barrier()
#define PG8_SCHED __builtin_amdgcn_sched_barrier(0)
    Unit cur, nxt; int ui = 0;
    if (!S.next(0, cur)) return;
    float est[8]; int est_pm = -1;
#pragma unroll
    for (int i = 0; i < 8; ++i) est[i] = 0.f;
    f32x4 acc[2][2][4][2];
#pragma unroll
    for (int a = 0; a < 2; ++a)
#pragma unroll
        for (int b = 0; b < 2; ++b)
#pragma unroll
            for (int m = 0; m < 4; ++m)
#pragma unroll
                for (int n = 0; n < 2; ++n) acc[a][b][m][n] = (f32x4){0.f, 0.f, 0.f, 0.f};
    bf16x8 At[4][2], B0[2][2], B1[2][2];
    const char* cA = (const char*)g.A + (size_t)cur.pm * tstep; const char* cB = (const char*)g.Bt + (size_t)cur.pn * tstep;
    PG8_STAGE(PG8_SB(0, 0), cB, voffB); PG8_STAGE(PG8_SB(0, 1), cB + hstep, voffB); PG8_STAGE(PG8_SA(0, 0), cA, voffA); PG8_STAGE(PG8_SA(0, 1), cA + hstep, voffA);
    if (wr == 1) PG8_BAR;
    PG8_WAIT_V(2); PG8_BAR;
    PG8_STAGE(PG8_SB(1, 0), cB + kstep, voffB); PG8_STAGE(PG8_SA(1, 0), cA + kstep, voffA); PG8_STAGE(PG8_SB(1, 1), cB + hstep + kstep, voffB);
    PG8_WAIT_V(6); PG8_BAR;
    for (;;) {
        const bool has_next = S.next(ui + 1, nxt);
        const char* nA = has_next ? (const char*)g.A + (size_t)nxt.pm * tstep : cA; const char* nB = has_next ? (const char*)g.Bt + (size_t)nxt.pn * tstep : cB;
        for (int t = 0; t < nt; t += 2) {
            const bool last = (t == nt - 2);
            const char* a1 = cA + (size_t)(t + 1) * kstep;
            const char* a2 = last ? nA : cA + (size_t)(t + 2) * kstep; const char* b2 = last ? nB : cB + (size_t)(t + 2) * kstep;
            const char* a3 = a2 + kstep; const char* b3 = b2 + kstep;
            if constexpr (Epi::HAS_MID) { if (t == nt / 2) E.mid(acc, cur, wr, wc, fr, fq); }
            PG8_LDB(B0, 0, 0); PG8_LDB(B1, 0, 1); PG8_SCHED; PG8_LDA(At, 0, 0); PG8_STAGE(PG8_SA(1, 1), a1 + hstep, voffA);
            PG8_WAIT_V(8); PG8_WAIT_L(0); PG8_BAR; PG8_MMA(0, 0, At, B0); PG8_MMA(0, 1, At, B1); PG8_BAR; PG8_SCHED;
            PG8_LDA(At, 0, 1); PG8_STAGE(PG8_SB(0, 0), b2, voffB); PG8_STAGE(PG8_SB(0, 1), b2 + hstep, voffB); PG8_STAGE(PG8_SA(0, 0), a2, voffA);
            PG8_WAIT_V(8); PG8_WAIT_L(0); PG8_BAR; PG8_MMA(1, 0, At, B0); PG8_MMA(1, 1, At, B1); PG8_BAR; PG8_SCHED;
            PG8_LDB(B0, 1, 0); PG8_LDB(B1, 1, 1); PG8_SCHED; PG8_LDA(At, 1, 0); PG8_STAGE(PG8_SA(0, 1), a2 + hstep, voffA);
            PG8_WAIT_V(8); PG8_WAIT_L(0); PG8_BAR; PG8_MMA(0, 0, At, B0); PG8_MMA(0, 1, At, B1); PG8_BAR; PG8_SCHED;
            PG8_LDA(At, 1, 1); PG8_STAGE(PG8_SB(1, 0), b3, voffB); PG8_STAGE(PG8_SB(1, 1), b3 + hstep, voffB); PG8_STAGE(PG8_SA(1, 0), a3, voffA);
            PG8_WAIT_V(8); PG8_WAIT_L(0); PG8_BAR; PG8_MMA(1, 0, At, B0); PG8_MMA(1, 1, At, B1); PG8_BAR; PG8_SCHED;
        }
        if (wr == 0) PG8_BAR;
        E(acc, cur, wr, wc, fr, fq, est, est_pm);
        if (!has_next) break;
#pragma unroll
        for (int a = 0; a < 2; ++a)
#pragma unroll
            for (int b = 0; b < 2; ++b)
#pragma unroll
                for (int m = 0; m < 4; ++m)
#pragma unroll
                    for (int n = 0; n < 2; ++n) acc[a][b][m][n] = (f32x4){0.f, 0.f, 0.f, 0.f};
        cur = nxt; cA = nA; cB = nB; ++ui;
        if (wr == 1) PG8_BAR;
    }
    PG8_WAIT_V(0);
    PG8_BAR;
#undef PG8_SA
#undef PG8_SB
#undef PG8_STAGE
#undef PG8_LDA
#undef PG8_LDB
#undef PG8_MMA
#undef PG8_WAIT_V
#undef PG8_WAIT_L
#undef PG8_BAR
#undef PG8_SCHED
}
}

typedef float f32x2 __attribute__((ext_vector_type(2)));
struct Epi1 {
    static constexpr bool HAS_MID = false;
    bf16_t* proj; const float* ssqx; float* ssqv; const float* bm;
    __device__ __forceinline__ void mid(f32x4 (&)[2][2][4][2], const pg8::Unit&, int, int, int, int) const {}
    __device__ __forceinline__ void operator()(const f32x4 (&acc)[2][2][4][2], const pg8::Unit& u, int wr, int wc, int fr, int fq, float (&est)[8], int& est_pm) const {
        const int pn = u.pn; const bool uz = pn < 8, gg = pn >= 20;
        const int seg = uz ? 0 : (pn < 12 ? 1 : (gg ? 5 : (pn >> 2)));
        const int colt = uz ? pn * 128 : (gg ? (pn - 20) * 128 : (pn & 3) * 256);
        bf16_t* base = proj + (size_t)seg * MG * DM;
        const int row0 = u.pm * 256 + wr * 64 + fr, colw = wc * 32 + 8 * fq;
        const float G1c = -2.3022082f, G3c = -2.3022082f * 0.044715f, S1c = -1.4426950409f;
        const bool numx = (seg <= 4), raw = (seg == 3);
        const float c1_0 = raw ? 0.f : ((seg <= 1) ? G1c : S1c), c3_0 = (!raw && seg <= 1) ? G3c : 0.f;
        const float c1_1 = raw ? 0.f : ((seg == 1) ? G1c : S1c), c3_1 = (seg == 1) ? G3c : 0.f;
        const float nxf = numx ? 1.f : 0.f, onx = 1.f - nxf;
        f32x2 cb[2][4];
#pragma unroll
        for (int bj = 0; bj < 2; ++bj)
#pragma unroll
            for (int q = 0; q < 4; ++q) {
                if (gg) { cb[bj][q].x = -1.4426950409f * bm[bj * DM + colt + colw + 2 * q]; cb[bj][q].y = -1.4426950409f * bm[bj * DM + colt + colw + 2 * q + 1]; }
                else { const float b = raw ? -200.f : 0.f; cb[bj][q] = (f32x2){b, b}; }
            }
        if (u.pm != est_pm) {
            est_pm = u.pm;
            f32x4 pp[2][4];
#pragma unroll
            for (int ai = 0; ai < 2; ++ai)
#pragma unroll
                for (int m = 0; m < 4; ++m) pp[ai][m] = *(const f32x4*)(ssqx + (size_t)(row0 + ai * 128 + m * 16) * 16 + fq * 4);
#pragma unroll
            for (int ai = 0; ai < 2; ++ai)
#pragma unroll
                for (int m = 0; m < 4; ++m) { float s = (pp[ai][m][0] + pp[ai][m][1]) + (pp[ai][m][2] + pp[ai][m][3]); s += shfl_idx_(s, (fq * 16 + fr) ^ 16); s += shfl_idx_(s, (fq * 16 + fr) ^ 32);
                    est[ai * 4 + m] = __builtin_amdgcn_rsqf(s * (1.0f / DM) + EPS); }
        }
#pragma unroll
        for (int ai = 0; ai < 2; ++ai)
#pragma unroll
            for (int m = 0; m < 4; ++m) {
                const int row = row0 + ai * 128 + m * 16;
                const float rstd = est[ai * 4 + m];
                f32x2 sq2 = (f32x2){0.f, 0.f};
                f32x2 v[2][4];
#pragma unroll
                for (int bj = 0; bj < 2; ++bj) {
                    const float c1 = bj ? c1_1 : c1_0, c3 = bj ? c3_1 : c3_0;
#pragma unroll
                    for (int q = 0; q < 4; ++q) {
                        const f32x2 x = (f32x2){acc[ai][bj][m][q >> 1][(q & 1) * 2], acc[ai][bj][m][q >> 1][(q & 1) * 2 + 1]} * rstd;
                        const f32x2 arg = x * ((x * x) * c3 + c1) + cb[bj][q];
                        f32x2 e; e.x = fast_exp2(arg.x); e.y = fast_exp2(arg.y);
                        const f32x2 d = e + 1.0f;
                        f32x2 r; r.x = fast_rcp(d.x); r.y = fast_rcp(d.y);
                        v[bj][q] = r * (x * nxf + onx);
                    }
                    if (seg == 1) {
#pragma unroll
                        for (int q = 0; q < 4; ++q) sq2 += v[bj][q] * v[bj][q];
                    }
                }
                if (uz) {
                    f32x2 t[4];
#pragma unroll
                    for (int q = 0; q < 4; ++q) t[q] = v[0][q] * v[1][q];
                    u32x4 w; w.x = cvt_pk_bf16(t[0].x, t[0].y); w.y = cvt_pk_bf16(t[1].x, t[1].y); w.z = cvt_pk_bf16(t[2].x, t[2].y); w.w = cvt_pk_bf16(t[3].x, t[3].y);
                    *(u32x4*)(base + (size_t)row * DM + colt + colw) = w;
                } else if (gg) {
                    f32x2 t[4];
#pragma unroll
                    for (int q = 0; q < 4; ++q) { t[q].x = v[0][q].x * fast_rcp(fmaxf(v[1][q].x, 1e-30f)); t[q].y = v[0][q].y * fast_rcp(fmaxf(v[1][q].y, 1e-30f)); }
                    u32x4 w; w.x = cvt_pk_bf16(t[0].x, t[0].y); w.y = cvt_pk_bf16(t[1].x, t[1].y); w.z = cvt_pk_bf16(t[2].x, t[2].y); w.w = cvt_pk_bf16(t[3].x, t[3].y);
                    *(u32x4*)(base + (size_t)row * DM + colt + colw) = w;
                    u32x4 w2; w2.x = cvt_pk_bf16(v[1][0].x, v[1][0].y); w2.y = cvt_pk_bf16(v[1][1].x, v[1][1].y); w2.z = cvt_pk_bf16(v[1][2].x, v[1][2].y); w2.w = cvt_pk_bf16(v[1][3].x, v[1][3].y);
                    *(u32x4*)(base + (size_t)MG * DM + (size_t)row * DM + colt + colw) = w2;
                } else {
#pragma unroll
                    for (int bj = 0; bj < 2; ++bj) {
                        u32x4 w; w.x = cvt_pk_bf16(v[bj][0].x, v[bj][0].y); w.y = cvt_pk_bf16(v[bj][1].x, v[bj][1].y); w.z = cvt_pk_bf16(v[bj][2].x, v[bj][2].y); w.w = cvt_pk_bf16(v[bj][3].x, v[bj][3].y);
                        *(u32x4*)(base + (size_t)row * DM + colt + bj * 128 + colw) = w;
                    }
                }
                if (seg == 1) { float sq = sq2.x + sq2.y; sq += shfl_idx_(sq, (fq * 16 + fr) ^ 16); sq += shfl_idx_(sq, (fq * 16 + fr) ^ 32); if (fq == 0) ssqv[(size_t)row * 16 + (pn & 3) * 4 + wc] = sq; }
            }
    }
};
struct Epi2 {
    static constexpr bool HAS_MID = true;
    const bf16_t* sa; const bf16_t* sb; bf16_t* mout;
    __device__ __forceinline__ void mid(f32x4 (&acc)[2][2][4][2], const pg8::Unit& u, int wr, int wc, int fr, int fq) const {
        int row0 = u.pm * 256 + wr * 64 + fr, col0 = u.pn * 256 + wc * 32 + 8 * fq;
        asm volatile("" : "+v"(row0), "+v"(col0));
#pragma unroll
        for (int ai = 0; ai < 2; ++ai) {
            u32x4 av[4][2];
#pragma unroll
            for (int m = 0; m < 4; ++m)
#pragma unroll
                for (int bj = 0; bj < 2; ++bj) av[m][bj] = *(const u32x4*)(sa + (size_t)(row0 + ai * 128 + m * 16) * DM + col0 + bj * 128);
#pragma unroll
            for (int m = 0; m < 4; ++m)
#pragma unroll
                for (int bj = 0; bj < 2; ++bj) {
#pragma unroll
                    for (int q = 0; q < 4; ++q) { acc[ai][bj][m][q >> 1][(q & 1) * 2] *= bf_lo(av[m][bj][q]); acc[ai][bj][m][q >> 1][(q & 1) * 2 + 1] *= bf_hi(av[m][bj][q]); }
                }
            asm volatile("" ::: "memory");
        }
    }
    __device__ __forceinline__ void operator()(const f32x4 (&acc)[2][2][4][2], const pg8::Unit& u, int wr, int wc, int fr, int fq, float (&)[8], int&) const {
        const int row0 = u.pm * 256 + wr * 64 + fr, col0 = u.pn * 256 + wc * 32 + 8 * fq;
        u32x4 bv[2][4][2];
#pragma unroll
        for (int ai = 0; ai < 2; ++ai)
#pragma unroll
            for (int m = 0; m < 4; ++m)
#pragma unroll
                for (int bj = 0; bj < 2; ++bj) bv[ai][m][bj] = *(const u32x4*)(sb + (size_t)(row0 + ai * 128 + m * 16) * DM + col0 + bj * 128);
#pragma unroll
        for (int ai = 0; ai < 2; ++ai)
#pragma unroll
            for (int m = 0; m < 4; ++m)
#pragma unroll
                for (int bj = 0; bj < 2; ++bj) {
                    const size_t off = (size_t)(row0 + ai * 128 + m * 16) * DM + col0 + bj * 128;
                    const u32x4 b = bv[ai][m][bj];
                    u32x4 w;
#pragma unroll
                    for (int q = 0; q < 4; ++q) w[q] = cvt_pk_bf16(acc[ai][bj][m][q >> 1][(q & 1) * 2] * bf_lo(b[q]), acc[ai][bj][m][q >> 1][(q & 1) * 2 + 1] * bf_hi(b[q]));
                    *(u32x4*)(mout + off) = w;
                }
    }
};
struct Epi3 {
    static constexpr bool HAS_MID = false;
    const float* xin_f; float* xout_f; bf16_t* xbf; float* ssqx;
    __device__ __forceinline__ void mid(f32x4 (&)[2][2][4][2], const pg8::Unit&, int, int, int, int) const {}
    __device__ __forceinline__ void operator()(const f32x4 (&acc)[2][2][4][2], const pg8::Unit& u, int wr, int wc, int fr, int fq, float (&)[8], int&) const {
        const int row0 = u.pm * 256 + wr * 64 + fr, col0 = u.pn * 256 + wc * 32 + 8 * fq;
#pragma unroll
        for (int ai = 0; ai < 2; ++ai) {
            f32x4 xv[4][2][2];
            if (xin_f) {
#pragma unroll
                for (int m = 0; m < 4; ++m)
#pragma unroll
                    for (int bj = 0; bj < 2; ++bj) { const size_t off = (size_t)(row0 + ai * 128 + m * 16) * DM + col0 + bj * 128; xv[m][bj][0] = *(const f32x4*)(xin_f + off); xv[m][bj][1] = *(const f32x4*)(xin_f + off + 4); }
            } else {
                u32x4 xb_[4][2];
#pragma unroll
                for (int m = 0; m < 4; ++m)
#pragma unroll
                    for (int bj = 0; bj < 2; ++bj) xb_[m][bj] = *(const u32x4*)(xbf + (size_t)(row0 + ai * 128 + m * 16) * DM + col0 + bj * 128);
#pragma unroll
                for (int m = 0; m < 4; ++m)
#pragma unroll
                    for (int bj = 0; bj < 2; ++bj) { const u32x4 w = xb_[m][bj];
                        xv[m][bj][0] = (f32x4){bf_lo(w.x), bf_hi(w.x), bf_lo(w.y), bf_hi(w.y)}; xv[m][bj][1] = (f32x4){bf_lo(w.z), bf_hi(w.z), bf_lo(w.w), bf_hi(w.w)}; }
            }
#pragma unroll
            for (int m = 0; m < 4; ++m) {
                const int row = row0 + ai * 128 + m * 16; float sq = 0.f;
#pragma unroll
                for (int bj = 0; bj < 2; ++bj) {
                    const size_t off = (size_t)row * DM + col0 + bj * 128;
                    const f32x4 x0 = xv[m][bj][0] + acc[ai][bj][m][0], x1 = xv[m][bj][1] + acc[ai][bj][m][1];
                    sq += (x0[0] * x0[0] + x0[1] * x0[1]) + (x0[2] * x0[2] + x0[3] * x0[3]) + (x1[0] * x1[0] + x1[1] * x1[1]) + (x1[2] * x1[2] + x1[3] * x1[3]);
                    if (xout_f) { *(f32x4*)(xout_f + off) = x0; *(f32x4*)(xout_f + off + 4) = x1; }
                    else { u32x4 w; w.x = cvt_pk_bf16(x0[0], x0[1]); w.y = cvt_pk_bf16(x0[2], x0[3]); w.z = cvt_pk_bf16(x1[0], x1[1]); w.w = cvt_pk_bf16(x1[2], x1[3]); *(u32x4*)(xbf + off) = w; }
                }
                sq += shfl_idx_(sq, (fq * 16 + fr) ^ 16); sq += shfl_idx_(sq, (fq * 16 + fr) ^ 32);
                if (fq == 0) ssqx[(size_t)row * 16 + u.pn * 4 + wc] = sq;
            }
            asm volatile("" ::: "memory");
        }
    }
};

struct TrJob { const float* src; const float* scale; bf16_t* dst; int C, ldd, coff, r0, c0; };
__device__ __forceinline__ TrJob tr_decode(const Params& p, int t) {
    unsigned char* ws = p.ws;
    const int l = t / 2624; int q = t % 2624; TrJob j;
    if (q < 1792) { j.src = p.w_in + (size_t)l * DM * NIN; j.C = NIN; j.scale = p.norm_g + l * DM; j.ldd = DM; j.coff = 0; j.r0 = (q / 112) * 64; j.c0 = (q % 112) * 64;
        const int n = j.c0; int d0 = n;
        if (n < 1024) d0 = (n >> 7) * 256 + (n & 127); else if (n < 2048) d0 = 2048 + (n - 1024); else if (n < 3072) d0 = ((n - 2048) >> 7) * 256 + 128 + ((n - 2048) & 127);
        else if (n >= 6144) d0 = 5120 + ((n - 6144) >> 7) * 256 + 128 + ((n - 6144) & 127); else if (n >= 5120) d0 = 5120 + ((n - 5120) >> 7) * 256 + ((n - 5120) & 127);
        j.dst = (bf16_t*)(ws + WS_WIN) + (size_t)l * NIN * DM + (ptrdiff_t)(d0 - j.c0) * DM; return j; }
    q -= 1792; j.scale = nullptr;
    if (q < 256) { j.src = p.w_proj_a + (size_t)l * DM * DM; j.C = DM; j.dst = (bf16_t*)(ws + WS_WP) + (size_t)l * DM * 2048; j.ldd = 2048; j.coff = 0; j.r0 = (q / 16) * 64; j.c0 = (q % 16) * 64; return j; }
    q -= 256;
    if (q < 256) { j.src = p.w_proj_b + (size_t)l * DM * DM; j.C = DM; j.dst = (bf16_t*)(ws + WS_WP) + (size_t)l * DM * 2048; j.ldd = 2048; j.coff = 1024; j.r0 = (q / 16) * 64; j.c0 = (q % 16) * 64; return j; }
    q -= 256;
    if (q < 256) { j.src = p.w_out + (size_t)l * DM * DM; j.C = DM; j.dst = (bf16_t*)(ws + WS_WO) + (size_t)l * DM * DM; j.ldd = DM; j.coff = 0; j.r0 = (q / 16) * 64; j.c0 = (q % 16) * 64; return j; }
    q -= 256;
    const bool ig = q >= 32; if (ig) q -= 32;
    const int h = q >> 2, tt = q & 3;
    j.src = (ig ? p.w_igate : p.w_rgate) + ((size_t)l * 8 + h) * 16384; j.C = 128; j.dst = (bf16_t*)(ws + (ig ? WS_WIT : WS_WRT)) + ((size_t)l * 8 + h) * 16384; j.ldd = 128; j.coff = 0; j.r0 = (tt >> 1) * 64; j.c0 = (tt & 1) * 64;
    return j;
}

__device__ void phase_prep(const Params& p, LAS unsigned char* lds, int wid_s) {
    int tid_ = wid_s * 64 + lane_id_(); asm volatile("" : "+v"(tid_));
    const int tid = tid_, G = gridDim.x;
    unsigned char* ws = p.ws;
    LAS float* tile = (LAS float*)lds;
    {
        const int NT = DEPTH * 2624;
        const int lr = tid >> 4, c4 = (tid & 15) * 4;
        int t = blockIdx.x;
        TrJob job; f32x4 v0, v1; float s0 = 1.f, s1 = 1.f;
        if (t < NT) { job = tr_decode(p, t);
            v0 = *(const f32x4*)(job.src + (size_t)(job.r0 + lr) * job.C + job.c0 + c4); v1 = *(const f32x4*)(job.src + (size_t)(job.r0 + 32 + lr) * job.C + job.c0 + c4);
            if (job.scale) { s0 = job.scale[job.r0 + lr]; s1 = job.scale[job.r0 + 32 + lr]; } }
        for (; t < NT; t += G) {
            TrJob nxt = job; f32x4 n0 = v0, n1 = v1; float ns0 = 1.f, ns1 = 1.f;
            if (t + G < NT) { nxt = tr_decode(p, t + G);
                n0 = *(const f32x4*)(nxt.src + (size_t)(nxt.r0 + lr) * nxt.C + nxt.c0 + c4); n1 = *(const f32x4*)(nxt.src + (size_t)(nxt.r0 + 32 + lr) * nxt.C + nxt.c0 + c4);
                if (nxt.scale) { ns0 = nxt.scale[nxt.r0 + lr]; ns1 = nxt.scale[nxt.r0 + 32 + lr]; } }
            tile[(c4 + 0) * 65 + lr] = v0[0] * s0; tile[(c4 + 1) * 65 + lr] = v0[1] * s0; tile[(c4 + 2) * 65 + lr] = v0[2] * s0; tile[(c4 + 3) * 65 + lr] = v0[3] * s0;
            tile[(c4 + 0) * 65 + 32 + lr] = v1[0] * s1; tile[(c4 + 1) * 65 + 32 + lr] = v1[1] * s1; tile[(c4 + 2) * 65 + 32 + lr] = v1[2] * s1; tile[(c4 + 3) * 65 + 32 + lr] = v1[3] * s1;
            __syncthreads();
            const int c = tid >> 3, r8 = (tid & 7) * 8;
            float f[8];
#pragma unroll
            for (int j = 0; j < 8; ++j) f[j] = tile[c * 65 + r8 + j];
            u32x4 w; w.x = cvt_pk_bf16(f[0], f[1]); w.y = cvt_pk_bf16(f[2], f[3]); w.z = cvt_pk_bf16(f[4], f[5]); w.w = cvt_pk_bf16(f[6], f[7]);
            *(u32x4*)(job.dst + (size_t)(job.c0 + c) * job.ldd + job.coff + job.r0 + r8) = w;
            __syncthreads();
            job = nxt; v0 = n0; v1 = n1; s0 = ns0; s1 = ns1;
        }
    }
    for (int e = blockIdx.x * 512 + tid; e < DEPTH * 8 * 128 * 128 / 8; e += G * 512) {
        const int s8 = (e & 15) * 8, t = (e >> 4) & 127;
        const f32x4 a = *(const f32x4*)(p.w_spatial + (size_t)e * 8), b = *(const f32x4*)(p.w_spatial + (size_t)e * 8 + 4);
        float f[8] = {a[0], a[1], a[2], a[3], b[0], b[1], b[2], b[3]};
#pragma unroll
        for (int j = 0; j < 8; ++j) f[j] = (s8 + j <= t) ? f[j] : 0.f;
        u32x4 w; w.x = cvt_pk_bf16(f[0], f[1]); w.y = cvt_pk_bf16(f[2], f[3]); w.z = cvt_pk_bf16(f[4], f[5]); w.w = cvt_pk_bf16(f[6], f[7]);
        *(u32x4*)((bf16_t*)(ws + WS_WSB) + (size_t)e * 8) = w;
    }
    {
        const int wave = tid >> 6, lane = tid & 63;
        bf16_t* xbf = (bf16_t*)(ws + WS_XBF); float* ssqx = (float*)(ws + WS_SSQX);
        for (int row = (blockIdx.x * 8 + wave) * 2; row < MTOT; row += G * 16) {
            f32x4 v[2][4];
#pragma unroll
            for (int r = 0; r < 2; ++r)
#pragma unroll
                for (int i = 0; i < 4; ++i) v[r][i] = *(const f32x4*)(p.x + (size_t)(row + r) * DM + i * 256 + lane * 4);
#pragma unroll
            for (int r = 0; r < 2; ++r) {
                float sq = 0.f;
#pragma unroll
                for (int i = 0; i < 4; ++i) {
                    sq += (v[r][i][0] * v[r][i][0] + v[r][i][1] * v[r][i][1]) + (v[r][i][2] * v[r][i][2] + v[r][i][3] * v[r][i][3]);
                    u32x2 w; w.x = cvt_pk_bf16(v[r][i][0], v[r][i][1]); w.y = cvt_pk_bf16(v[r][i][2], v[r][i][3]);
                    *(u32x2*)(xbf + (size_t)(row + r) * DM + i * 256 + lane * 4) = w;
                }
#pragma unroll
                for (int d = 1; d < 64; d <<= 1) sq += shfl_idx_(sq, lane ^ d);
                if (lane < 16) ssqx[(size_t)(row + r) * 16 + lane] = (lane == 0) ? sq : 0.f;
            }
        }
    }
    for (int e = blockIdx.x * 512 + tid; e < NBITEM * 8; e += G * 512) ((unsigned*)(ws + WS_FLG))[e] = 0u;
}

__device__ __forceinline__ void mixerA_phase(const Params& p, LAS unsigned char* lds, int l_in, int wid_s) {
    int tid_ = wid_s * 64 + lane_id_(); asm volatile("" : "+v"(tid_));
    int l = l_in; asm volatile("" : "+s"(l));
    const int tid = tid_, wid = tid >> 6, lane = tid & 63, fr = lane & 15, fq = lane >> 4;
    const int G = gridDim.x;
    unsigned char* ws = p.ws;
    const bf16_t* gu = (const bf16_t*)(ws + WS_PROJ); const bf16_t* gv = gu + (size_t)MG * DM;
    const float* ssqv = (const float*)(ws + WS_SSQV);
    bf16_t* ybuf = (bf16_t*)(ws + WS_Y);
    LAS bf16_t* sVT = (LAS bf16_t*)lds;
    const int tok = tid >> 2, cl = tid & 3;
    const int c0 = wid * 16;
    const int Ge = G & ~7;
    if ((int)blockIdx.x >= Ge) return;
    const int gi = blockIdx.x & 7;
    const int cch = gi * 128 + c0 + 4 * fq;
    bf16x8 wf[20]; f32x4 vg; float bs[8];
    {
        const bf16_t* wsb = (const bf16_t*)(ws + WS_WSB) + ((size_t)l * 8 + gi) * 16384;
        int n = 0;
#pragma unroll
        for (int i = 0; i < 8; ++i)
#pragma unroll
            for (int ks = 0; ks <= (i >> 1); ++ks) { wf[n] = *(const bf16x8*)(wsb + (16 * i + fr) * 128 + ks * 32 + 8 * fq); ++n; }
        vg = *(const f32x4*)(p.v_norm_g + l * DM + cch);
#pragma unroll
        for (int i = 0; i < 8; ++i) bs[i] = p.b_spatial[((size_t)l * 8 + gi) * 128 + 16 * i + fr];
    }
    u32x4 pv[4]; f32x4 pq[4];
#define A_LOAD(it_) do { const int rb_ = ((it_) >> 3) * 128, gi_ = (it_) & 7; \
        _Pragma("unroll") for (int i_ = 0; i_ < 4; ++i_) { pv[i_] = *(const u32x4*)(gv + (size_t)(rb_ + tok) * DM + gi_ * 128 + (4 * i_ + cl) * 8); pq[i_] = *(const f32x4*)(ssqv + (size_t)(rb_ + tok) * 16 + 4 * i_); } } while (0)
    int it = blockIdx.x;
    if (it < NAITEM) A_LOAD(it);
    for (; it < NAITEM; it += Ge) {
        const int chunk = it >> 3, rowbase = chunk * 128;
        __syncthreads();
        {
            const f32x4 a = pq[0], b = pq[1], c = pq[2], d = pq[3];
            const float ssum = ((a[0] + a[1]) + (a[2] + a[3])) + ((b[0] + b[1]) + (b[2] + b[3])) + ((c[0] + c[1]) + (c[2] + c[3])) + ((d[0] + d[1]) + (d[2] + d[3]));
            const float rs = __builtin_amdgcn_rsqf(ssum * (1.0f / DM) + EPS);
#pragma unroll
            for (int i = 0; i < 4; ++i) {
                const int c8 = 4 * i + cl;
#pragma unroll
                for (int k = 0; k < 4; ++k) {
                    const unsigned pk = cvt_pk_bf16(bf_lo(pv[i][k]) * rs, bf_hi(pv[i][k]) * rs);
                    sVT[(c8 * 8 + 2 * k) * 136 + tok] = (bf16_t)(pk & 0xffffu);
                    sVT[(c8 * 8 + 2 * k + 1) * 136 + tok] = (bf16_t)(pk >> 16);
                }
            }
        }
        __syncthreads();
        if (it + Ge < NAITEM) A_LOAD(it + Ge);
        u32x2 uu[8];
#pragma unroll
        for (int i = 0; i < 8; ++i) uu[i] = *(const u32x2*)(gu + (size_t)(rowbase + 16 * i + fr) * DM + cch);
        bf16x8 vf[4];
#pragma unroll
        for (int ks = 0; ks < 4; ++ks) vf[ks] = *(const LAS bf16x8*)(sVT + (c0 + fr) * 136 + ks * 32 + 8 * fq);
        int n = 0;
#pragma unroll
        for (int i = 0; i < 8; ++i) {
            f32x4 acc = (f32x4){0.f, 0.f, 0.f, 0.f};
#pragma unroll
            for (int ks = 0; ks <= (i >> 1); ++ks) { acc = __builtin_amdgcn_mfma_f32_16x16x32_bf16(vf[ks], wf[n], acc, 0, 0, 0); ++n; }
            const int t = 16 * i + fr;
            const float y0 = bf_lo(uu[i].x) * (vg[0] * acc[0] + bs[i]), y1 = bf_hi(uu[i].x) * (vg[1] * acc[1] + bs[i]);
            const float y2 = bf_lo(uu[i].y) * (vg[2] * acc[2] + bs[i]), y3 = bf_hi(uu[i].y) * (vg[3] * acc[3] + bs[i]);
            u32x2 o; o.x = cvt_pk_bf16(y0, y1); o.y = cvt_pk_bf16(y2, y3);
            *(u32x2*)(ybuf + (size_t)(rowbase + t) * 2048 + cch) = o;
        }
    }
#undef A_LOAD
}

#define DPP_SHR(v, ident, d) __uint_as_float((unsigned)__builtin_amdgcn_update_dpp((int)__float_as_uint(ident), (int)__float_as_uint(v), 0x110 + (d), 0xf, 0xf, false))

constexpr int LSB = 256, NSB = SEQ / LSB, XB_OFF1 = LSB * 136 * 2, CW_OFF = 2 * XB_OFF1, AGG_OFF = CW_OFF + 2560, XBAR_LDS_OFF = AGG_OFF + 1024;
__device__ __forceinline__ void mixerB_phase(const Params& p, LAS unsigned char* lds, int l_in, int wid_s) {
    int tid_ = wid_s * 64 + lane_id_(); asm volatile("" : "+v"(tid_));
    int l = l_in; asm volatile("" : "+s"(l));
    const int tid = tid_, wid = __builtin_amdgcn_readfirstlane(tid >> 6), lane = tid & 63, fr = lane & 15, fq = lane >> 4;
    const int G = gridDim.x;
    unsigned char* ws = p.ws;
    const bf16_t* xb = (const bf16_t*)(ws + WS_PROJ) + (size_t)3 * MG * DM; const bf16_t* zb = (const bf16_t*)(ws + WS_PROJ) + (size_t)4 * MG * DM;
    bf16_t* ybuf = (bf16_t*)(ws + WS_Y);
    LAS float* sCW = (LAS float*)(lds + CW_OFF);
    LAS float* sAgg = (LAS float*)(lds + AGG_OFF);
    const int c8 = (tid & 15) * 8, t8 = (tid >> 4) * 8;
    const int chh = wid & 1, tq = wid >> 1;
    for (int task = blockIdx.x; task < BG * 8 * 4; task += G) {
        const int bh = task & (BG * 8 - 1), cq = task / (BG * 8), bl = bh >> 3, h = bh & 7;
        const int j0 = cq * 32 + chh * 16, chl = h * 128 + j0 + 4 * fq;
        __syncthreads();
        for (int e = tid; e < 640; e += 512) { const int k = e >> 7, c = e & 127; sCW[e] = (k < 4) ? p.conv_w[((size_t)l * 4 + k) * DM + h * 128 + c] : p.conv_b[(size_t)l * DM + h * 128 + c]; }
        bf16x8 wrf[4], wif[4]; f32x4 br, bi, nsp;
        {
            const bf16_t* wr_ = (const bf16_t*)(ws + WS_WRT) + ((size_t)l * 8 + h) * 16384 + (j0 + fr) * 128 + 8 * fq;
            const bf16_t* wi_ = (const bf16_t*)(ws + WS_WIT) + ((size_t)l * 8 + h) * 16384 + (j0 + fr) * 128 + 8 * fq;
#pragma unroll
            for (int ks = 0; ks < 4; ++ks) { wrf[ks] = *(const bf16x8*)(wr_ + ks * 32); wif[ks] = *(const bf16x8*)(wi_ + ks * 32); }
            br = *(const f32x4*)(p.b_rgate + (size_t)l * DM + chl); bi = *(const f32x4*)(p.b_igate + (size_t)l * DM + chl);
            const f32x4 lam = *(const f32x4*)(p.lru_lambda + (size_t)l * DM + chl);
#pragma unroll
            for (int r = 0; r < 4; ++r) { const float z = -lam[r]; nsp[r] = -8.0f * (fmaxf(z, 0.f) + log1pf(expf(-fabsf(z)))); }
        }
        u32x4 xr[11];
#define XB_LOAD(seg_) do { const int rb_ = bl * SEQ + (seg_) * LSB, ch_ = h * 128 + c8; \
        _Pragma("unroll") for (int r_ = 0; r_ < 11; ++r_) { const int t_ = t8 - 3 + r_; xr[r_] = (u32x4){0u, 0u, 0u, 0u}; \
            if (t_ >= 0 || (seg_) > 0) xr[r_] = *(const u32x4*)(xb + (size_t)(rb_ + t_) * DM + ch_); } } while (0)
        XB_LOAD(0);
        float S[4] = {0.f, 0.f, 0.f, 0.f};
        __syncthreads();
        for (int seg = 0; seg < NSB; ++seg) {
            const int rowbase = bl * SEQ + seg * LSB;
            LAS bf16_t* sXb = (LAS bf16_t*)(lds + (seg & 1) * XB_OFF1);
            {
                float cw[5][8];
#pragma unroll
                for (int k = 0; k < 5; ++k) { const f32x4 a = *(const LAS f32x4*)(sCW + k * 128 + c8), b = *(const LAS f32x4*)(sCW + k * 128 + c8 + 4);
                    cw[k][0] = a[0]; cw[k][1] = a[1]; cw[k][2] = a[2]; cw[k][3] = a[3]; cw[k][4] = b[0]; cw[k][5] = b[1]; cw[k][6] = b[2]; cw[k][7] = b[3]; }
#pragma unroll
                for (int tt = 0; tt < 8; ++tt) {
                    float o8[8];
#pragma unroll
                    for (int k = 0; k < 4; ++k) {
                        o8[2 * k]     = cw[4][2 * k]     + cw[0][2 * k]     * bf_lo(xr[tt][k]) + cw[1][2 * k]     * bf_lo(xr[tt + 1][k]) + cw[2][2 * k]     * bf_lo(xr[tt + 2][k]) + cw[3][2 * k]     * bf_lo(xr[tt + 3][k]);
                        o8[2 * k + 1] = cw[4][2 * k + 1] + cw[0][2 * k + 1] * bf_hi(xr[tt][k]) + cw[1][2 * k + 1] * bf_hi(xr[tt + 1][k]) + cw[2][2 * k + 1] * bf_hi(xr[tt + 2][k]) + cw[3][2 * k + 1] * bf_hi(xr[tt + 3][k]);
                    }
                    u32x4 w; w.x = cvt_pk_bf16(o8[0], o8[1]); w.y = cvt_pk_bf16(o8[2], o8[3]); w.z = cvt_pk_bf16(o8[4], o8[5]); w.w = cvt_pk_bf16(o8[6], o8[7]);
                    *(LAS u32x4*)(sXb + (t8 + tt) * 136 + c8) = w;
                }
            }
            __syncthreads();
            if (seg + 1 < NSB) XB_LOAD(seg + 1);
            u32x2 zz[4];
#pragma unroll
            for (int tt = 0; tt < 4; ++tt) zz[tt] = *(const u32x2*)(zb + (size_t)(rowbase + 64 * tq + 16 * tt + fr) * DM + chl);
            float Pt[4][4], Ht[4][4];
            float Pc[4] = {1.f, 1.f, 1.f, 1.f}, Hc[4] = {0.f, 0.f, 0.f, 0.f};
#pragma unroll
            for (int tt = 0; tt < 4; ++tt) {
                const int trow = 64 * tq + 16 * tt + fr;
                f32x4 aR = (f32x4){0.f, 0.f, 0.f, 0.f}, aI = (f32x4){0.f, 0.f, 0.f, 0.f};
#pragma unroll
                for (int ks = 0; ks < 4; ++ks) {
                    const bf16x8 xf = *(const LAS bf16x8*)(sXb + trow * 136 + ks * 32 + 8 * fq);
                    aR = __builtin_amdgcn_mfma_f32_16x16x32_bf16(wrf[ks], xf, aR, 0, 0, 0);
                    aI = __builtin_amdgcn_mfma_f32_16x16x32_bf16(wif[ks], xf, aI, 0, 0, 0);
                }
                const u32x2 xcw = *(const LAS u32x2*)(sXb + trow * 136 + j0 + 4 * fq);
                const f32x4 xc = (f32x4){bf_lo(xcw.x), bf_hi(xcw.x), bf_lo(xcw.y), bf_hi(xcw.y)};
#pragma unroll
                for (int r = 0; r < 4; ++r) {
                    const float rg = sigmoidf_(aR[r] + br[r]), ig = sigmoidf_(aI[r] + bi[r]);
                    const float la = nsp[r] * rg;
                    const float a = fast_exp2(1.4426950409f * la);
                    const float x2 = 2.0f * la;
                    const float em = x2 * (1.0f + x2 * (0.5f + x2 * (0.16666667f + x2 * (0.041666668f + x2 * (0.0083333338f + x2 * 0.0013888889f)))));
                    const float g2 = (x2 > -0.25f) ? -em : 1.0f - a * a;
                    float A = a, Bv = __builtin_amdgcn_sqrtf(fmaxf(g2, 0.f)) * (ig * xc[r]);
#define SCAN_STEP(d) { const float Ap = DPP_SHR(A, 1.0f, d), Bp = DPP_SHR(Bv, 0.0f, d); Bv = A * Bp + Bv; A = A * Ap; }
                    SCAN_STEP(1) SCAN_STEP(2) SCAN_STEP(4) SCAN_STEP(8)
#undef SCAN_STEP
                    const float P = A * Pc[r], H = A * Hc[r] + Bv;
                    Pt[tt][r] = P; Ht[tt][r] = H;
                    Pc[r] = shfl_idx_(P, lane | 15); Hc[r] = shfl_idx_(H, lane | 15);
                }
            }
            if (fr == 0) {
                LAS float* q = sAgg + ((tq * 2 + chh) * 16 + 4 * fq) * 2;
                *(LAS f32x4*)q = (f32x4){Pc[0], Hc[0], Pc[1], Hc[1]}; *(LAS f32x4*)(q + 4) = (f32x4){Pc[2], Hc[2], Pc[3], Hc[3]};
            }
            __syncthreads();
            float carry[4] = {S[0], S[1], S[2], S[3]};
#pragma unroll
            for (int qd = 0; qd < 4; ++qd) {
                const LAS float* q = sAgg + ((qd * 2 + chh) * 16 + 4 * fq) * 2;
                const f32x4 a0 = *(const LAS f32x4*)q, a1 = *(const LAS f32x4*)(q + 4);
                if (qd == tq) { carry[0] = S[0]; carry[1] = S[1]; carry[2] = S[2]; carry[3] = S[3]; }
                S[0] = a0[0] * S[0] + a0[1]; S[1] = a0[2] * S[1] + a0[3]; S[2] = a1[0] * S[2] + a1[1]; S[3] = a1[2] * S[3] + a1[3];
            }
#pragma unroll
            for (int tt = 0; tt < 4; ++tt) {
                const int t = 64 * tq + 16 * tt + fr;
                const float y0 = (Ht[tt][0] + Pt[tt][0] * carry[0]) * bf_lo(zz[tt].x), y1 = (Ht[tt][1] + Pt[tt][1] * carry[1]) * bf_hi(zz[tt].x);
                const float y2 = (Ht[tt][2] + Pt[tt][2] * carry[2]) * bf_lo(zz[tt].y), y3 = (Ht[tt][3] + Pt[tt][3] * carry[3]) * bf_hi(zz[tt].y);
                u32x2 ov; ov.x = cvt_pk_bf16(y0, y1); ov.y = cvt_pk_bf16(y2, y3);
                *(u32x2*)(ybuf + (size_t)(rowbase + t) * 2048 + 1024 + chl) = ov;
            }
        }
#undef XB_LOAD
    }
}

__device__ void phase_final(const Params& p, int wid_s) {
    int tid_ = wid_s * 64 + lane_id_(); asm volatile("" : "+v"(tid_));
    const int tid = tid_, wave = tid >> 6, lane = tid & 63, G = gridDim.x;
    const float* ssqx = (const float*)(p.ws + WS_SSQX);
    f32x4 gv[4];
#pragma unroll
    for (int i = 0; i < 4; ++i) gv[i] = *(const f32x4*)(p.final_g + i * 256 + lane * 4);
    for (int row = blockIdx.x * 8 + wave; row < MTOT; row += G * 8) {
        float s = (lane < 16) ? ssqx[(size_t)row * 16 + lane] : 0.f;
#pragma unroll
        for (int d = 1; d < 16; d <<= 1) s += shfl_idx_(s, lane ^ d);
        s = shfl_idx_(s, lane & 0);
        const float rstd = __builtin_amdgcn_rsqf(s * (1.0f / DM) + EPS);
        float* xr = p.out + (size_t)row * DM; const bf16_t* xb = (const bf16_t*)(p.ws + WS_XBF) + (size_t)row * DM;
        u32x2 w[4];
#pragma unroll
        for (int i = 0; i < 4; ++i) w[i] = *(const u32x2*)(xb + i * 256 + lane * 4);
#pragma unroll
        for (int i = 0; i < 4; ++i) { f32x4 v = (f32x4){bf_lo(w[i].x), bf_hi(w[i].x), bf_lo(w[i].y), bf_hi(w[i].y)}; v = v * rstd * gv[i]; *(f32x4*)(xr + i * 256 + lane * 4) = v; }
    }
}

#define XB_TMO      128
#define XB_XCNT(j)  (256  + 64 * (j))
#define XB_XSUB(j)  (1280 + 64 * (j))
#define XB_XGEN(j)  (2304 + 64 * (j))
#define XB_TOP      3328
#define XB_TOPGEN   3392
#define XCD_BAR_WORDS 3456
#define XB_SPIN_CAP (1u << 18)
__device__ __forceinline__ unsigned xb_ld(unsigned* p)              { return __hip_atomic_load(p, __ATOMIC_RELAXED, __HIP_MEMORY_SCOPE_AGENT); }
__device__ __forceinline__ unsigned xb_add(unsigned* p, unsigned v) { return __hip_atomic_fetch_add(p, v, __ATOMIC_RELAXED, __HIP_MEMORY_SCOPE_AGENT); }
__device__ __forceinline__ unsigned xb_xcc_id() { return (unsigned)__builtin_amdgcn_s_getreg((3 << 11) | 20) & 0xFu; }
#define XB_SPIN(cond, bar) do { unsigned _sp = 0; while (cond) { __builtin_amdgcn_s_sleep(1); \
    if ((++_sp & 255u) == 0u) { if (xb_ld(&(bar)[XB_TMO])) break; if (_sp > XB_SPIN_CAP) { atomicAdd(&(bar)[XB_TMO], 1u); break; } } } } while (0)
struct XcdBarrier { unsigned* bar; unsigned x; volatile LAS unsigned* st; };
__device__ __forceinline__ XcdBarrier xcd_barrier_post(unsigned* bar, volatile LAS unsigned* st, int wid_s) {
    XcdBarrier b; b.bar = bar; b.x = xb_xcc_id(); b.st = st;
    if (wid_s == 0 && lane_id_() == 0) (void)xb_add(&bar[XB_XCNT(b.x)], 1u);
    return b;
}
__device__ __forceinline__ void xcd_barrier_complete(unsigned* bar, unsigned x, unsigned& nloc, unsigned& nx) {
    const unsigned G = gridDim.x * gridDim.y * gridDim.z;
    unsigned sum, cnt, mine, sp = 0u;
    for (;;) {
        sum = 0u; cnt = 0u; mine = 0u;
#pragma unroll
        for (unsigned j = 0; j < 16; ++j) { const unsigned c = xb_ld(&bar[XB_XCNT(j)]); sum += c; cnt += (c > 0u) ? 1u : 0u; mine = (j == x) ? c : mine; }
        if (sum == G) break;
        __builtin_amdgcn_s_sleep(1);
        if ((++sp & 255u) == 0u) { if (xb_ld(&bar[XB_TMO])) break; if (sp > XB_SPIN_CAP) { atomicAdd(&bar[XB_TMO], 1u); break; } }
    }
    nloc = mine > 0u ? mine : 1u; nx = cnt > 0u ? cnt : 1u;
}
__device__ __forceinline__ void xcd_barrier(const XcdBarrier& b, int wid_s) {
    asm volatile("s_waitcnt vmcnt(0)" ::: "memory");
    __syncthreads();
    if (wid_s == 0 && lane_id_() == 0) {
        unsigned* bar = b.bar;
        __builtin_amdgcn_s_waitcnt(0);
        unsigned nloc = b.st[0], nx = b.st[1];
        if (nloc == 0u) { xcd_barrier_complete(bar, b.x, nloc, nx); b.st[0] = nloc; b.st[1] = nx; }
        const unsigned old = xb_add(&bar[XB_XSUB(b.x)], 1u);
        const unsigned gen = old / nloc;
        if (old + 1u == (gen + 1u) * nloc) {
            __builtin_amdgcn_fence(__ATOMIC_RELEASE, "agent");
            asm volatile("s_waitcnt vmcnt(0)" ::: "memory");
            const unsigned og = xb_add(&bar[XB_TOP], 1u);
            const unsigned tg = og / nx;
            if (og + 1u == (tg + 1u) * nx) xb_add(&bar[XB_TOPGEN], 1u);
            else XB_SPIN(xb_ld(&bar[XB_TOPGEN]) == tg, bar);
            __builtin_amdgcn_fence(__ATOMIC_ACQUIRE, "agent");
            xb_add(&bar[XB_XGEN(b.x)], 1u);
            asm volatile("s_waitcnt vmcnt(0)" ::: "memory");
        } else {
            XB_SPIN(xb_ld(&bar[XB_XGEN(b.x)]) == gen, bar);
            __builtin_amdgcn_fence(__ATOMIC_ACQUIRE, "agent");
            asm volatile("s_waitcnt vmcnt(0)" ::: "memory");
        }
    }
    __syncthreads();
}

__global__ void __launch_bounds__(512, 2) mega_fwd(Params p) {
    extern __shared__ __attribute__((aligned(16))) unsigned char lds_raw[];
    LAS unsigned char* lds = (LAS unsigned char*)lds_raw;
    cg::grid_group grid = cg::this_grid();
    unsigned char* ws = p.ws;
    const int G = gridDim.x;
    const int wid_s = __builtin_amdgcn_readfirstlane((int)threadIdx.x >> 6);
    if (threadIdx.x < 4) ((LAS unsigned*)(lds + XBAR_LDS_OFF))[threadIdx.x] = 0u;
    __syncthreads();
    const XcdBarrier xbar = xcd_barrier_post((unsigned*)(ws + WS_BAR), (volatile LAS unsigned*)(lds + XBAR_LDS_OFF), wid_s);

#ifndef PM
#define PM 0xff
#endif
    if (PM & 1) phase_prep(p, lds, wid_s);
    grid.sync();

    for (int l = 0; l < DEPTH; ++l) {
        for (int grp = 0; grp < NGRP; ++grp) {
            const size_t r0 = (size_t)grp * MG;
            if (PM & 2) {
                pg8::Gemm g{(const bf16_t*)(ws + WS_XBF) + r0 * DM, (const bf16_t*)(ws + WS_WIN) + (size_t)l * NIN * DM, MG, NIN, DM};
                pg8::StaticOrder S; S.init(MG, NIN, G, (int)blockIdx.x);
                Epi1 E{(bf16_t*)(ws + WS_PROJ), (const float*)(ws + WS_SSQX) + r0 * 16, (float*)(ws + WS_SSQV), p.b_merge + (size_t)l * 2 * DM};
                pg8::gemm_phase<Epi1>(lds, g, S, E, wid_s);
#ifdef REPG1
                pg8::gemm_phase<Epi1>(lds, g, S, E, wid_s);
#endif
            }
            xcd_barrier(xbar, wid_s);
            if (PM & 4) {
                const unsigned epoch = (unsigned)(l * NGRP + grp + 1);
#ifndef REPB
#define REPB 1
#define REPA 1
#endif
                for (int rep = 0; rep < REPB; ++rep)
                mixerB_phase(p, lds, l, wid_s);
                for (int rep = 0; rep < REPA; ++rep)
                mixerA_phase(p, lds, l, wid_s);
                __syncthreads();
            }
            xcd_barrier(xbar, wid_s);
            if (PM & 8) {
                pg8::Gemm g{(const bf16_t*)(ws + WS_Y), (const bf16_t*)(ws + WS_WP) + (size_t)l * DM * 2048, MG, DM, 2048};
                pg8::StaticOrder S; S.init(MG, DM, G, (int)blockIdx.x);
                Epi2 E{(const bf16_t*)(ws + WS_PROJ) + (size_t)5 * MG * DM, (const bf16_t*)(ws + WS_PROJ) + (size_t)6 * MG * DM, (bf16_t*)(ws + WS_MB)};
                pg8::gemm_phase<Epi2>(lds, g, S, E, wid_s);
#ifdef REPG2
                pg8::gemm_phase<Epi2>(lds, g, S, E, wid_s);
#endif
            }
            xcd_barrier(xbar, wid_s);
            if (PM & 16) {
                pg8::Gemm g{(const bf16_t*)(ws + WS_MB), (const bf16_t*)(ws + WS_WO) + (size_t)l * DM * DM, MG, DM, DM};
                pg8::StaticOrder S; S.init(MG, DM, G, (int)blockIdx.x);
                Epi3 E{l == 0 ? p.x + r0 * DM : nullptr, nullptr, (bf16_t*)(ws + WS_XBF) + r0 * DM, (float*)(ws + WS_SSQX) + r0 * 16};
                pg8::gemm_phase<Epi3>(lds, g, S, E, wid_s);
            }
            if (NGRP == 1) xcd_barrier(xbar, wid_s);
        }
    }
    xcd_barrier(xbar, wid_s);
    if (PM & 32) phase_final(p, wid_s);
}

extern "C" void kernel_launch(void* const* d_in, const int* in_sizes, int n_in, void* d_out, int out_size, void* d_ws, size_t ws_size, hipStream_t stream) {
    static int grid_blocks = 0;
    if (grid_blocks == 0) {
        if (ws_size < WS_END) { fprintf(stderr, "kernel_launch: workspace too small (%zu < %zu)\n", ws_size, (size_t)WS_END); grid_blocks = -1; return; }
        int dev = 0, cus = 0, per_cu = 0;
        hipGetDevice(&dev);
        hipDeviceGetAttribute(&cus, hipDeviceAttributeMultiprocessorCount, dev);
        hipFuncSetAttribute((const void*)mega_fwd, hipFuncAttributeMaxDynamicSharedMemorySize, LDS_BYTES);
        hipOccupancyMaxActiveBlocksPerMultiprocessor(&per_cu, (const void*)mega_fwd, 512, LDS_BYTES);
        if (per_cu < 1) per_cu = 1;
        grid_blocks = cus * 1;
        fprintf(stderr, "kernel_launch: cus %d per_cu %d grid %d\n", cus, per_cu, grid_blocks);
    }
    if (grid_blocks < 0) return;
    Params p{};
    p.x = (const float*)d_in[0]; p.norm_g = (const float*)d_in[1]; p.w_in = (const float*)d_in[2]; p.b_merge = (const float*)d_in[3]; p.v_norm_g = (const float*)d_in[4];
    p.w_spatial = (const float*)d_in[5]; p.b_spatial = (const float*)d_in[6]; p.conv_w = (const float*)d_in[7]; p.conv_b = (const float*)d_in[8];
    p.w_rgate = (const float*)d_in[9]; p.b_rgate = (const float*)d_in[10]; p.w_igate = (const float*)d_in[11]; p.b_igate = (const float*)d_in[12]; p.lru_lambda = (const float*)d_in[13];
    p.w_proj_a = (const float*)d_in[14]; p.w_proj_b = (const float*)d_in[15]; p.w_out = (const float*)d_in[16]; p.final_g = (const float*)d_in[17];
    p.out = (float*)d_out; p.ws = (unsigned char*)d_ws;
    hipMemsetAsync((unsigned char*)d_ws + WS_BAR, 0, 16384, stream);
    void* args[] = {&p};
    hipError_t e = hipLaunchCooperativeKernel((const void*)mega_fwd, dim3(grid_blocks), dim3(512), args, LDS_BYTES, stream);
    if (e != hipSuccess) fprintf(stderr, "cooperative launch failed: %s (grid %d)\n", hipGetErrorString(e), grid_blocks);
}
```

```cpp
#include <hip/hip_runtime.h>
#include <hip/hip_cooperative_groups.h>
#include <cstdio>
namespace cg = cooperative_groups;

#define LAS __attribute__((address_space(3)))
typedef unsigned short bf16_t;
typedef short bf16x8 __attribute__((ext_vector_type(8)));
typedef float f32x4 __attribute__((ext_vector_type(4)));
typedef unsigned u32x4 __attribute__((ext_vector_type(4)));
typedef unsigned u32x2 __attribute__((ext_vector_type(2)));
typedef float f32x2 __attribute__((ext_vector_type(2)));

constexpr int DM = 1024, NBATCH = 16, SEQ = 4096, MTOT = NBATCH * SEQ, DEPTH = 4, NIN = 7168;
constexpr int NGRP = 2, MG = MTOT / NGRP, BG = NBATCH / NGRP;
constexpr int LSEG = 128, NSEG = SEQ / LSEG;
constexpr int NBITEM = BG * 8 * NSEG, NAITEM = (MG / 128) * 8;
constexpr float EPS = 1e-6f;
constexpr int LDS_BYTES = 142848 + 16;

constexpr size_t WS_WIN = 0;
constexpr size_t WS_WP = WS_WIN + (size_t)DEPTH * NIN * DM * 2;
constexpr size_t WS_WO = WS_WP + (size_t)DEPTH * DM * 2048 * 2;
constexpr size_t WS_WSB = WS_WO + (size_t)DEPTH * DM * DM * 2;
constexpr size_t WS_WRT = WS_WSB + (size_t)DEPTH * 8 * 128 * 128 * 2;
constexpr size_t WS_WIT = WS_WRT + (size_t)DEPTH * 8 * 128 * 128 * 2;
constexpr size_t WS_XBF = WS_WIT + (size_t)DEPTH * 8 * 128 * 128 * 2;
constexpr size_t WS_SSQX = WS_XBF + (size_t)MTOT * DM * 2;
constexpr size_t WS_SSQV = WS_SSQX + (size_t)MTOT * 16 * 4;
constexpr size_t WS_PROJ = WS_SSQV + (size_t)MG * 16 * 4;
constexpr size_t WS_Y = WS_PROJ + (size_t)7 * MG * DM * 2;
constexpr size_t WS_MB = WS_Y + (size_t)MG * 2048 * 2;
constexpr size_t WS_PAY = WS_MB + (size_t)MG * DM * 2;
constexpr size_t WS_PAYP = WS_PAY + (size_t)NBITEM * 8 * 16 * 8;
constexpr size_t WS_FLG = WS_PAYP + (size_t)NBITEM * 8 * 16 * 4;
constexpr size_t WS_BAR = WS_FLG + (size_t)NBITEM * 8 * 4;
constexpr size_t WS_END = WS_BAR + 16384;

struct Params {
    const float* x; const float* norm_g; const float* w_in; const float* b_merge; const float* v_norm_g; const float* w_spatial; const float* b_spatial;
    const float* conv_w; const float* conv_b; const float* w_rgate; const float* b_rgate; const float* w_igate; const float* b_igate; const float* lru_lambda;
    const float* w_proj_a; const float* w_proj_b; const float* w_out; const float* final_g;
    float* out; unsigned char* ws;
};

__device__ __forceinline__ float shfl_idx_(float v, int src_lane) { return __uint_as_float((unsigned)__builtin_amdgcn_ds_bpermute(src_lane << 2, (int)__float_as_uint(v))); }
__device__ __forceinline__ int lane_id_() { return (int)__builtin_amdgcn_mbcnt_hi(~0u, __builtin_amdgcn_mbcnt_lo(~0u, 0u)); }
__device__ __forceinline__ unsigned cvt_pk_bf16(float lo, float hi) { unsigned r; asm volatile("v_cvt_pk_bf16_f32 %0, %1, %2" : "=v"(r) : "v"(lo), "v"(hi)); return r; }
__device__ __forceinline__ float bf_lo(unsigned w) { return __uint_as_float(w << 16); }
__device__ __forceinline__ float bf_hi(unsigned w) { return __uint_as_float(w & 0xffff0000u); }
__device__ __forceinline__ float fast_rcp(float x) { return __builtin_amdgcn_rcpf(x); }
__device__ __forceinline__ float fast_exp2(float x) { return __builtin_amdgcn_exp2f(x); }
__device__ __forceinline__ float sigmoidf_(float x) { return fast_rcp(1.0f + fast_exp2(-1.4426950409f * x)); }

namespace pg8 {
constexpr int BM = 256, BK = 64, HALF = 128, HTB = HALF * BK * 2, STAGE_BYTES = 8 * HTB, NXCD = 8, WGM = 8;
__host__ __device__ __forceinline__ int lds_byte(int r, int c) { const int st = (r >> 4) * 2 + (c >> 5), rr = r & 15, cc = c & 31, ob = rr * 64 + cc * 2; return st * 1024 + (ob ^ (((ob >> 9) & 1) << 5)); }
__host__ __device__ __forceinline__ void stage_rc(int b, int& R, int& C) { const int st = b / 1024, sb = b % 1024, swz = sb ^ (((sb >> 9) & 1) << 5); R = (st >> 1) * 16 + swz / 64; C = (st & 1) * 32 + (swz % 64) / 2; }
__host__ __device__ __forceinline__ int perm32(int rho) { const int n = rho >> 4, i = rho & 15; return 8 * (i >> 2) + 4 * n + (i & 3); }
struct Unit { int pm, pn; };
struct Gemm { const bf16_t* A; const bf16_t* Bt; int M, N, K; };
struct StaticOrder {
    int nM, nN, nwg, G, c;
    __device__ void init(int M, int N, int G_, int c_) { nM = M / BM; nN = N / BM; nwg = nM * nN; G = G_; c = c_; }
    __device__ bool next(int i, Unit& u) const {
        const long L = (long)i * G + c; if (L >= nwg) return false;
        int wgid = (int)L; { const int q = nwg / NXCD, r = nwg % NXCD, xcd = wgid % NXCD, off = wgid / NXCD; wgid = (xcd < r ? xcd * (q + 1) : r * (q + 1) + (xcd - r) * q) + off; }
        const int nig = WGM * nN, gid = wgid / nig, fm = gid * WGM, gsz = (nM - fm) < WGM ? (nM - fm) : WGM;
        u.pm = fm + ((wgid % nig) % gsz); u.pn = (wgid % nig) / gsz; return true;
    }
};
template <class Epi>
__device__ __forceinline__ void gemm_phase(LAS unsigned char* lds, const Gemm g, const StaticOrder& S, const Epi& E, int wid_s) {
    int tid_ = wid_s * 64 + lane_id_(); asm volatile("" : "+v"(tid_));
    const int tid = tid_, wid = __builtin_amdgcn_readfirstlane(tid >> 6), lane = tid & 63, wr = wid >> 2, wc = wid & 3, fr = lane & 15, fq = lane >> 4;
    const int K = g.K, nt = K / BK;
    unsigned voffA[2], voffB[2];
#pragma unroll
    for (int i = 0; i < 2; ++i) { int R, C; stage_rc(tid * 16 + i * 8192, R, C); const int Rb = ((R & ~31) + perm32(R & 31));
        voffA[i] = (unsigned)(R * K + C) * 2u; voffB[i] = (unsigned)(Rb * K + C) * 2u; }
    const size_t kstep = (size_t)(BK * 2);
    const size_t hstep = (size_t)HALF * K * 2;
    const size_t tstep = 2 * hstep;
    const unsigned ldsw = (unsigned)wid * 1024u;
    const int aoff = lds_byte(wr * 64 + fr, fq * 8), boff = lds_byte(wc * 32 + fr, fq * 8);
#define PG8_SA(b, h) (((b) * 2 + (h)) * HTB)
#define PG8_SB(b, h) ((4 + (b) * 2 + (h)) * HTB)
#define PG8_STAGE(bufoff, gbase, voff) do { _Pragma("unroll") for (int _i = 0; _i < 2; ++_i) \
        __builtin_amdgcn_global_load_lds((const unsigned*)((const char*)(gbase) + (voff)[_i]), (LAS unsigned*)(lds + (bufoff) + ldsw + _i * 8192), 16, 0, 0); } while (0)
#define PG8_LDA(dst, b, h) do { _Pragma("unroll") for (int m = 0; m < 4; ++m) _Pragma("unroll") for (int k = 0; k < 2; ++k) dst[m][k] = *(const LAS bf16x8*)(lds + PG8_SA(b, h) + aoff + m * 2048 + k * 1024); } while (0)
#define PG8_LDB(dst, b, h) do { _Pragma("unroll") for (int n = 0; n < 2; ++n) _Pragma("unroll") for (int k = 0; k < 2; ++k) dst[n][k] = *(const LAS bf16x8*)(lds + PG8_SB(b, h) + boff + n * 2048 + k * 1024); } while (0)
#define PG8_MMA(ai, bj, At, Bt) do { __builtin_amdgcn_s_setprio(1); _Pragma("unroll") for (int m = 0; m < 4; ++m) _Pragma("unroll") for (int n = 0; n < 2; ++n) _Pragma("unroll") for (int k = 0; k < 2; ++k) \
        acc[ai][bj][m][n] = __builtin_amdgcn_mfma_f32_16x16x32_bf16(Bt[n][k], At[m][k], acc[ai][bj][m][n], 0, 0, 0); __builtin_amdgcn_s_setprio(0); } while (0)
#define PG8_WAIT_V(n) asm volatile("s_waitcnt vmcnt(" #n ")" ::: "memory")
#define PG8_WAIT_L(n) asm volatile("s_waitcnt lgkmcnt(" #n ")" ::: "memory")
#define PG8_BAR __builtin_amdgcn_s_barrier()
#define PG8_SCHED __builtin_amdgcn_sched_barrier(0)
    Unit cur, nxt; int ui = 0;
    if (!S.next(0, cur)) return;
    float est[8]; int est_pm = -1;
#pragma unroll
    for (int i = 0; i < 8; ++i) est[i] = 0.f;
    f32x4 acc[2][2][4][2];
#pragma unroll
    for (int a = 0; a < 2; ++a)
#pragma unroll
        for (int b = 0; b < 2; ++b)
#pragma unroll
            for (int m = 0; m < 4; ++m)
#pragma unroll
                for (int n = 0; n < 2; ++n) acc[a][b][m][n] = (f32x4){0.f, 0.f, 0.f, 0.f};
    bf16x8 At[4][2], B0[2][2], B1[2][2];
    const char* cA = (const char*)g.A + (size_t)cur.pm * tstep; const char* cB = (const char*)g.Bt + (size_t)cur.pn * tstep;
    PG8_STAGE(PG8_SB(0, 0), cB, voffB); PG8_STAGE(PG8_SB(0, 1), cB + hstep, voffB); PG8_STAGE(PG8_SA(0, 0), cA, voffA); PG8_STAGE(PG8_SA(0, 1), cA + hstep, voffA);
    if (wr == 1) PG8_BAR;
    PG8_WAIT_V(2); PG8_BAR;
    PG8_STAGE(PG8_SB(1, 0), cB + kstep, voffB); PG8_STAGE(PG8_SA(1, 0), cA + kstep, voffA); PG8_STAGE(PG8_SB(1, 1), cB + hstep + kstep, voffB);
    PG8_WAIT_V(6); PG8_BAR;
    for (;;) {
        const bool has_next = S.next(ui + 1, nxt);
        const char* nA = has_next ? (const char*)g.A + (size_t)nxt.pm * tstep : cA; const char* nB = has_next ? (const char*)g.Bt + (size_t)nxt.pn * tstep : cB;
        for (int t = 0; t < nt; t += 2) {
            const bool last = (t == nt - 2);
            const char* a1 = cA + (size_t)(t + 1) * kstep;
            const char* a2 = last ? nA : cA + (size_t)(t + 2) * kstep; const char* b2 = last ? nB : cB + (size_t)(t + 2) * kstep;
            const char* a3 = a2 + kstep; const char* b3 = b2 + kstep;
            if constexpr (Epi::HAS_MID) { if (t == nt / 2) E.mid(acc, cur, wr, wc, fr, fq); }
            PG8_LDB(B0, 0, 0); PG8_LDB(B1, 0, 1); PG8_SCHED; PG8_LDA(At, 0, 0); PG8_STAGE(PG8_SA(1, 1), a1 + hstep, voffA);
            PG8_WAIT_V(8); PG8_WAIT_L(0); PG8_BAR; PG8_MMA(0, 0, At, B0); PG8_MMA(0, 1, At, B1); PG8_BAR; PG8_SCHED;
            PG8_LDA(At, 0, 1); PG8_STAGE(PG8_SB(0, 0), b2, voffB); PG8_STAGE(PG8_SB(0, 1), b2 + hstep, voffB); PG8_STAGE(PG8_SA(0, 0), a2, voffA);
            PG8_WAIT_V(8); PG8_WAIT_L(0); PG8_BAR; PG8_MMA(1, 0, At, B0); PG8_MMA(1, 1, At, B1); PG8_BAR; PG8_SCHED;
            PG8_LDB(B0, 1, 0); PG8_LDB(B1, 1, 1); PG8_SCHED; PG8_LDA(At, 1, 0); PG8_STAGE(PG8_SA(0, 1), a2 + hstep, voffA);
            PG8_WAIT_V(8); PG8_WAIT_L(0); PG8_BAR; PG8_MMA(0, 0, At, B0); PG8_MMA(0, 1, At, B1); PG8_BAR; PG8_SCHED;
            PG8_LDA(At, 1, 1); PG8_STAGE(PG8_SB(1, 0), b3, voffB); PG8_STAGE(PG8_SB(1, 1), b3 + hstep, voffB); PG8_STAGE(PG8_SA(1, 0), a3, voffA);
            PG8_WAIT_V(8); PG8_WAIT_L(0); PG8_BAR; PG8_MMA(1, 0, At, B0); PG8_MMA(1, 1, At, B1); PG8_BAR; PG8_SCHED;
        }
        if (wr == 0) PG8_BAR;
        E(acc, cur, wr, wc, fr, fq, est, est_pm);
        if (!has_next) break;
#pragma unroll
        for (int a = 0; a < 2; ++a)
#pragma unroll
            for (int b = 0; b < 2; ++b)
#pragma unroll
                for (int m = 0; m < 4; ++m)
#pragma unroll
                    for (int n = 0; n < 2; ++n) acc[a][b][m][n] = (f32x4){0.f, 0.f, 0.f, 0.f};
        cur = nxt; cA = nA; cB = nB; ++ui;
        if (wr == 1) PG8_BAR;
    }
    PG8_WAIT_V(0);
    PG8_BAR;
#undef PG8_SA
#undef PG8_SB
#undef PG8_STAGE
#undef PG8_LDA
#undef PG8_LDB
#undef PG8_MMA
#undef PG8_WAIT_V
#undef PG8_WAIT_L
#undef PG8_BAR
#undef PG8_SCHED
}
}

struct Epi1 {
    static constexpr bool HAS_MID = false;
    bf16_t* proj; const float* ssqx; float* ssqv; const float* bm;
    __device__ __forceinline__ void mid(f32x4 (&)[2][2][4][2], const pg8::Unit&, int, int, int, int) const {}
    __device__ __forceinline__ void operator()(const f32x4 (&acc)[2][2][4][2], const pg8::Unit& u, int wr, int wc, int fr, int fq, float (&est)[8], int& est_pm) const {
        const int pn = u.pn; const bool uz = pn < 8, gg = pn >= 20;
        const int seg = uz ? 0 : (pn < 12 ? 1 : (gg ? 5 : (pn >> 2)));
        const int colt = uz ? pn * 128 : (gg ? (pn - 20) * 128 : (pn & 3) * 256);
        bf16_t* base = proj + (size_t)seg * MG * DM;
        const int row0 = u.pm * 256 + wr * 64 + fr, colw = wc * 32 + 8 * fq;
        const float G1c = -2.3022082f, G3c = -2.3022082f * 0.044715f, S1c = -1.4426950409f;
        const float c1_0 = (seg <= 1) ? G1c : S1c, c3_0 = (seg <= 1) ? G3c : 0.f;
        const float c1_1 = (seg == 1) ? G1c : S1c, c3_1 = (seg == 1) ? G3c : 0.f;
        const bool numx = (seg <= 4), raw = (seg == 3);
        float cb[2][8];
#pragma unroll
        for (int bj = 0; bj < 2; ++bj)
#pragma unroll
            for (int j = 0; j < 8; ++j) cb[bj][j] = gg ? -1.4426950409f * bm[bj * DM + colt + colw + j] : 0.f;
        if (u.pm != est_pm) {
            est_pm = u.pm;
            f32x4 pp[2][4];
#pragma unroll
            for (int ai = 0; ai < 2; ++ai)
#pragma unroll
                for (int m = 0; m < 4; ++m) pp[ai][m] = *(const f32x4*)(ssqx + (size_t)(row0 + ai * 128 + m * 16) * 16 + fq * 4);
#pragma unroll
            for (int ai = 0; ai < 2; ++ai)
#pragma unroll
                for (int m = 0; m < 4; ++m) { float s = (pp[ai][m][0] + pp[ai][m][1]) + (pp[ai][m][2] + pp[ai][m][3]); s += shfl_idx_(s, (fq * 16 + fr) ^ 16); s += shfl_idx_(s, (fq * 16 + fr) ^ 32);
                    est[ai * 4 + m] = __builtin_amdgcn_rsqf(s * (1.0f / DM) + EPS); }
        }
#pragma unroll
        for (int ai = 0; ai < 2; ++ai)
#pragma unroll
            for (int m = 0; m < 4; ++m) {
                const int row = row0 + ai * 128 + m * 16;
                const float rstd = est[ai * 4 + m];
                float sq = 0.f;
                float v[2][8];
#pragma unroll
                for (int bj = 0; bj < 2; ++bj) {
                    const float c1 = bj ? c1_1 : c1_0, c3 = bj ? c3_1 : c3_0;
#pragma unroll
                    for (int n = 0; n < 2; ++n)
#pragma unroll
                        for (int j = 0; j < 4; ++j) v[bj][n * 4 + j] = acc[ai][bj][m][n][j] * rstd;
                    if (!raw) {
#pragma unroll
                        for (int j = 0; j < 8; ++j) { const float x = v[bj][j]; const float arg = x * (c1 + c3 * x * x) + cb[bj][j]; const float r = fast_rcp(1.0f + fast_exp2(arg)); v[bj][j] = numx ? x * r : r; }
                    }
                    if (seg == 1) {
#pragma unroll
                        for (int j = 0; j < 8; ++j) sq += v[bj][j] * v[bj][j];
                    }
                }
                if (uz) {
                    u32x4 w; w.x = cvt_pk_bf16(v[0][0] * v[1][0], v[0][1] * v[1][1]); w.y = cvt_pk_bf16(v[0][2] * v[1][2], v[0][3] * v[1][3]);
                    w.z = cvt_pk_bf16(v[0][4] * v[1][4], v[0][5] * v[1][5]); w.w = cvt_pk_bf16(v[0][6] * v[1][6], v[0][7] * v[1][7]);
                    *(u32x4*)(base + (size_t)row * DM + colt + colw) = w;
                } else if (gg) {
                    float q[8];
#pragma unroll
                    for (int j = 0; j < 8; ++j) q[j] = v[0][j] * fast_rcp(fmaxf(v[1][j], 1e-30f));
                    u32x4 w; w.x = cvt_pk_bf16(q[0], q[1]); w.y = cvt_pk_bf16(q[2], q[3]); w.z = cvt_pk_bf16(q[4], q[5]); w.w = cvt_pk_bf16(q[6], q[7]);
                    *(u32x4*)(base + (size_t)row * DM + colt + colw) = w;
                    u32x4 w2; w2.x = cvt_pk_bf16(v[1][0], v[1][1]); w2.y = cvt_pk_bf16(v[1][2], v[1][3]); w2.z = cvt_pk_bf16(v[1][4], v[1][5]); w2.w = cvt_pk_bf16(v[1][6], v[1][7]);
                    *(u32x4*)(base + (size_t)MG * DM + (size_t)row * DM + colt + colw) = w2;
                } else {
#pragma unroll
                    for (int bj = 0; bj < 2; ++bj) {
                        u32x4 w; w.x = cvt_pk_bf16(v[bj][0], v[bj][1]); w.y = cvt_pk_bf16(v[bj][2], v[bj][3]); w.z = cvt_pk_bf16(v[bj][4], v[bj][5]); w.w = cvt_pk_bf16(v[bj][6], v[bj][7]);
                        *(u32x4*)(base + (size_t)row * DM + colt + bj * 128 + colw) = w;
                    }
                }
                if (seg == 1) { sq += shfl_idx_(sq, (fq * 16 + fr) ^ 16); sq += shfl_idx_(sq, (fq * 16 + fr) ^ 32); if (fq == 0) ssqv[(size_t)row * 16 + (pn & 3) * 4 + wc] = sq; }
            }
    }
};
struct Epi2 {
    static constexpr bool HAS_MID = true;
    const bf16_t* sa; const bf16_t* sb; bf16_t* mout;
    __device__ __forceinline__ void mid(f32x4 (&acc)[2][2][4][2], const pg8::Unit& u, int wr, int wc, int fr, int fq) const {
        int row0 = u.pm * 256 + wr * 64 + fr, col0 = u.pn * 256 + wc * 32 + 8 * fq;
        asm volatile("" : "+v"(row0), "+v"(col0));
#pragma unroll
        for (int ai = 0; ai < 2; ++ai) {
            u32x4 av[4][2];
#pragma unroll
            for (int m = 0; m < 4; ++m)
#pragma unroll
                for (int bj = 0; bj < 2; ++bj) av[m][bj] = *(const u32x4*)(sa + (size_t)(row0 + ai * 128 + m * 16) * DM + col0 + bj * 128);
#pragma unroll
            for (int m = 0; m < 4; ++m)
#pragma unroll
                for (int bj = 0; bj < 2; ++bj) {
#pragma unroll
                    for (int q = 0; q < 4; ++q) { acc[ai][bj][m][q >> 1][(q & 1) * 2] *= bf_lo(av[m][bj][q]); acc[ai][bj][m][q >> 1][(q & 1) * 2 + 1] *= bf_hi(av[m][bj][q]); }
                }
            asm volatile("" ::: "memory");
        }
    }
    __device__ __forceinline__ void operator()(const f32x4 (&acc)[2][2][4][2], const pg8::Unit& u, int wr, int wc, int fr, int fq, float (&)[8], int&) const {
        const int row0 = u.pm * 256 + wr * 64 + fr, col0 = u.pn * 256 + wc * 32 + 8 * fq;
        u32x4 bv[2][4][2];
#pragma unroll
        for (int ai = 0; ai < 2; ++ai)
#pragma unroll
            for (int m = 0; m < 4; ++m)
#pragma unroll
                for (int bj = 0; bj < 2; ++bj) bv[ai][m][bj] = *(const u32x4*)(sb + (size_t)(row0 + ai * 128 + m * 16) * DM + col0 + bj * 128);
#pragma unroll
        for (int ai = 0; ai < 2; ++ai)
#pragma unroll
            for (int m = 0; m < 4; ++m)
#pragma unroll
                for (int bj = 0; bj < 2; ++bj) {
                    const size_t off = (size_t)(row0 + ai * 128 + m * 16) * DM + col0 + bj * 128;
                    const u32x4 b = bv[ai][m][bj];
                    u32x4 w;
#pragma unroll
                    for (int q = 0; q < 4; ++q) w[q] = cvt_pk_bf16(acc[ai][bj][m][q >> 1][(q & 1) * 2] * bf_lo(b[q]), acc[ai][bj][m][q >> 1][(q & 1) * 2 + 1] * bf_hi(b[q]));
                    *(u32x4*)(mout + off) = w;
                }
    }
};
struct Epi3 {
    static constexpr bool HAS_MID = false;
    const float* xin_f; float* xout_f; bf16_t* xbf; float* ssqx;
    __device__ __forceinline__ void mid(f32x4 (&)[2][2][4][2], const pg8::Unit&, int, int, int, int) const {}
    __device__ __forceinline__ void operator()(const f32x4 (&acc)[2][2][4][2], const pg8::Unit& u, int wr, int wc, int fr, int fq, float (&)[8], int&) const {
        const int row0 = u.pm * 256 + wr * 64 + fr, col0 = u.pn * 256 + wc * 32 + 8 * fq;
#pragma unroll
        for (int ai = 0; ai < 2; ++ai) {
            f32x4 xv[4][2][2];
            if (xin_f) {
#pragma unroll
                for (int m = 0; m < 4; ++m)
#pragma unroll
                    for (int bj = 0; bj < 2; ++bj) { const size_t off = (size_t)(row0 + ai * 128 + m * 16) * DM + col0 + bj * 128; xv[m][bj][0] = *(const f32x4*)(xin_f + off); xv[m][bj][1] = *(const f32x4*)(xin_f + off + 4); }
            } else {
                u32x4 xb_[4][2];
#pragma unroll
                for (int m = 0; m < 4; ++m)
#pragma unroll
                    for (int bj = 0; bj < 2; ++bj) xb_[m][bj] = *(const u32x4*)(xbf + (size_t)(row0 + ai * 128 + m * 16) * DM + col0 + bj * 128);
#pragma unroll
                for (int m = 0; m < 4; ++m)
#pragma unroll
                    for (int bj = 0; bj < 2; ++bj) { const u32x4 w = xb_[m][bj];
                        xv[m][bj][0] = (f32x4){bf_lo(w.x), bf_hi(w.x), bf_lo(w.y), bf_hi(w.y)}; xv[m][bj][1] = (f32x4){bf_lo(w.z), bf_hi(w.z), bf_lo(w.w), bf_hi(w.w)}; }
            }
#pragma unroll
            for (int m = 0; m < 4; ++m) {
                const int row = row0 + ai * 128 + m * 16; float sq = 0.f;
#pragma unroll
                for (int bj = 0; bj < 2; ++bj) {
                    const size_t off = (size_t)row * DM + col0 + bj * 128;
                    const f32x4 x0 = xv[m][bj][0] + acc[ai][bj][m][0], x1 = xv[m][bj][1] + acc[ai][bj][m][1];
                    sq += (x0[0] * x0[0] + x0[1] * x0[1]) + (x0[2] * x0[2] + x0[3] * x0[3]) + (x1[0] * x1[0] + x1[1] * x1[1]) + (x1[2] * x1[2] + x1[3] * x1[3]);
                    if (xout_f) { *(f32x4*)(xout_f + off) = x0; *(f32x4*)(xout_f + off + 4) = x1; }
                    else { u32x4 w; w.x = cvt_pk_bf16(x0[0], x0[1]); w.y = cvt_pk_bf16(x0[2], x0[3]); w.z = cvt_pk_bf16(x1[0], x1[1]); w.w = cvt_pk_bf16(x1[2], x1[3]); *(u32x4*)(xbf + off) = w; }
                }
                sq += shfl_idx_(sq, (fq * 16 + fr) ^ 16); sq += shfl_idx_(sq, (fq * 16 + fr) ^ 32);
                if (fq == 0) ssqx[(size_t)row * 16 + u.pn * 4 + wc] = sq;
            }
            asm volatile("" ::: "memory");
        }
    }
};

struct TrJob { const float* src; const float* scale; bf16_t* dst; int C, ldd, coff, r0, c0; };
__device__ __forceinline__ TrJob tr_decode(const Params& p, int t) {
    unsigned char* ws = p.ws;
    const int l = t / 2624; int q = t % 2624; TrJob j;
    if (q < 1792) { j.src = p.w_in + (size_t)l * DM * NIN; j.C = NIN; j.scale = p.norm_g + l * DM; j.ldd = DM; j.coff = 0; j.r0 = (q / 112) * 64; j.c0 = (q % 112) * 64;
        const int n = j.c0; int d0 = n;
        if (n < 1024) d0 = (n >> 7) * 256 + (n & 127); else if (n < 2048) d0 = 2048 + (n - 1024); else if (n < 3072) d0 = ((n - 2048) >> 7) * 256 + 128 + ((n - 2048) & 127);
        else if (n >= 6144) d0 = 5120 + ((n - 6144) >> 7) * 256 + 128 + ((n - 6144) & 127); else if (n >= 5120) d0 = 5120 + ((n - 5120) >> 7) * 256 + ((n - 5120) & 127);
        j.dst = (bf16_t*)(ws + WS_WIN) + (size_t)l * NIN * DM + (ptrdiff_t)(d0 - j.c0) * DM; return j; }
    q -= 1792; j.scale = nullptr;
    if (q < 256) { j.src = p.w_proj_a + (size_t)l * DM * DM; j.C = DM; j.dst = (bf16_t*)(ws + WS_WP) + (size_t)l * DM * 2048; j.ldd = 2048; j.coff = 0; j.r0 = (q / 16) * 64; j.c0 = (q % 16) * 64; return j; }
    q -= 256;
    if (q < 256) { j.src = p.w_proj_b + (size_t)l * DM * DM; j.C = DM; j.dst = (bf16_t*)(ws + WS_WP) + (size_t)l * DM * 2048; j.ldd = 2048; j.coff = 1024; j.r0 = (q / 16) * 64; j.c0 = (q % 16) * 64; return j; }
    q -= 256;
    if (q < 256) { j.src = p.w_out + (size_t)l * DM * DM; j.C = DM; j.dst = (bf16_t*)(ws + WS_WO) + (size_t)l * DM * DM; j.ldd = DM; j.coff = 0; j.r0 = (q / 16) * 64; j.c0 = (q % 16) * 64; return j; }
    q -= 256;
    const bool ig = q >= 32; if (ig) q -= 32;
    const int h = q >> 2, tt = q & 3;
    j.src = (ig ? p.w_igate : p.w_rgate) + ((size_t)l * 8 + h) * 16384; j.C = 128; j.dst = (bf16_t*)(ws + (ig ? WS_WIT : WS_WRT)) + ((size_t)l * 8 + h) * 16384; j.ldd = 128; j.coff = 0; j.r0 = (tt >> 1) * 64; j.c0 = (tt & 1) * 64;
    return j;
}

__device__ void phase_prep(const Params& p, LAS unsigned char* lds, int wid_s) {
    int tid_ = wid_s * 64 + lane_id_(); asm volatile("" : "+v"(tid_));
    const int tid = tid_, G = gridDim.x;
    unsigned char* ws = p.ws;
    LAS float* tile = (LAS float*)lds;
    {
        const int NT = DEPTH * 2624;
        const int lr = tid >> 4, c4 = (tid & 15) * 4;
        int t = blockIdx.x;
        TrJob job; f32x4 v0, v1; float s0 = 1.f, s1 = 1.f;
        if (t < NT) { job = tr_decode(p, t);
            v0 = *(const f32x4*)(job.src + (size_t)(job.r0 + lr) * job.C + job.c0 + c4); v1 = *(const f32x4*)(job.src + (size_t)(job.r0 + 32 + lr) * job.C + job.c0 + c4);
            if (job.scale) { s0 = job.scale[job.r0 + lr]; s1 = job.scale[job.r0 + 32 + lr]; } }
        for (; t < NT; t += G) {
            TrJob nxt = job; f32x4 n0 = v0, n1 = v1; float ns0 = 1.f, ns1 = 1.f;
            if (t + G < NT) { nxt = tr_decode(p, t + G);
                n0 = *(const f32x4*)(nxt.src + (size_t)(nxt.r0 + lr) * nxt.C + nxt.c0 + c4); n1 = *(const f32x4*)(nxt.src + (size_t)(nxt.r0 + 32 + lr) * nxt.C + nxt.c0 + c4);
                if (nxt.scale) { ns0 = nxt.scale[nxt.r0 + lr]; ns1 = nxt.scale[nxt.r0 + 32 + lr]; } }
            tile[(c4 + 0) * 65 + lr] = v0[0] * s0; tile[(c4 + 1) * 65 + lr] = v0[1] * s0; tile[(c4 + 2) * 65 + lr] = v0[2] * s0; tile[(c4 + 3) * 65 + lr] = v0[3] * s0;
            tile[(c4 + 0) * 65 + 32 + lr] = v1[0] * s1; tile[(c4 + 1) * 65 + 32 + lr] = v1[1] * s1; tile[(c4 + 2) * 65 + 32 + lr] = v1[2] * s1; tile[(c4 + 3) * 65 + 32 + lr] = v1[3] * s1;
            __syncthreads();
            const int c = tid >> 3, r8 = (tid & 7) * 8;
            float f[8];
#pragma unroll
            for (int j = 0; j < 8; ++j) f[j] = tile[c * 65 + r8 + j];
            u32x4 w; w.x = cvt_pk_bf16(f[0], f[1]); w.y = cvt_pk_bf16(f[2], f[3]); w.z = cvt_pk_bf16(f[4], f[5]); w.w = cvt_pk_bf16(f[6], f[7]);
            *(u32x4*)(job.dst + (size_t)(job.c0 + c) * job.ldd + job.coff + job.r0 + r8) = w;
            __syncthreads();
            job = nxt; v0 = n0; v1 = n1; s0 = ns0; s1 = ns1;
        }
    }
    for (int e = blockIdx.x * 512 + tid; e < DEPTH * 8 * 128 * 128 / 8; e += G * 512) {
        const int s8 = (e & 15) * 8, t = (e >> 4) & 127;
        const f32x4 a = *(const f32x4*)(p.w_spatial + (size_t)e * 8), b = *(const f32x4*)(p.w_spatial + (size_t)e * 8 + 4);
        float f[8] = {a[0], a[1], a[2], a[3], b[0], b[1], b[2], b[3]};
#pragma unroll
        for (int j = 0; j < 8; ++j) f[j] = (s8 + j <= t) ? f[j] : 0.f;
        u32x4 w; w.x = cvt_pk_bf16(f[0], f[1]); w.y = cvt_pk_bf16(f[2], f[3]); w.z = cvt_pk_bf16(f[4], f[5]); w.w = cvt_pk_bf16(f[6], f[7]);
        *(u32x4*)((bf16_t*)(ws + WS_WSB) + (size_t)e * 8) = w;
    }
    {
        const int wave = tid >> 6, lane = tid & 63;
        bf16_t* xbf = (bf16_t*)(ws + WS_XBF); float* ssqx = (float*)(ws + WS_SSQX);
        for (int row = (blockIdx.x * 8 + wave) * 2; row < MTOT; row += G * 16) {
            f32x4 v[2][4];
#pragma unroll
            for (int r = 0; r < 2; ++r)
#pragma unroll
                for (int i = 0; i < 4; ++i) v[r][i] = *(const f32x4*)(p.x + (size_t)(row + r) * DM + i * 256 + lane * 4);
#pragma unroll
            for (int r = 0; r < 2; ++r) {
                float sq = 0.f;
#pragma unroll
                for (int i = 0; i < 4; ++i) {
                    sq += (v[r][i][0] * v[r][i][0] + v[r][i][1] * v[r][i][1]) + (v[r][i][2] * v[r][i][2] + v[r][i][3] * v[r][i][3]);
                    u32x2 w; w.x = cvt_pk_bf16(v[r][i][0], v[r][i][1]); w.y = cvt_pk_bf16(v[r][i][2], v[r][i][3]);
                    *(u32x2*)(xbf + (size_t)(row + r) * DM + i * 256 + lane * 4) = w;
                }
#pragma unroll
                for (int d = 1; d < 64; d <<= 1) sq += shfl_idx_(sq, lane ^ d);
                if (lane < 16) ssqx[(size_t)(row + r) * 16 + lane] = (lane == 0) ? sq : 0.f;
            }
        }
    }
    for (int e = blockIdx.x * 512 + tid; e < NBITEM * 8; e += G * 512) ((unsigned*)(ws + WS_FLG))[e] = 0u;
}

__device__ __forceinline__ void mixerA_phase(const Params& p, LAS unsigned char* lds, int l_in, int wid_s) {
    int tid_ = wid_s * 64 + lane_id_(); asm volatile("" : "+v"(tid_));
    int l = l_in; asm volatile("" : "+s"(l));
    const int tid = tid_, wid = tid >> 6, lane = tid & 63, fr = lane & 15, fq = lane >> 4;
    const int G = gridDim.x;
    unsigned char* ws = p.ws;
    const bf16_t* gu = (const bf16_t*)(ws + WS_PROJ); const bf16_t* gv = gu + (size_t)MG * DM;
    const float* ssqv = (const float*)(ws + WS_SSQV);
    bf16_t* ybuf = (bf16_t*)(ws + WS_Y);
    LAS bf16_t* sVT = (LAS bf16_t*)lds;
    const int tok = tid >> 2, cl = tid & 3;
    const int c0 = wid * 16;
    const int Ge = G & ~7;
    if ((int)blockIdx.x >= Ge) return;
    const int gi = blockIdx.x & 7;
    const int cch = gi * 128 + c0 + 4 * fq;
    bf16x8 wf[20]; f32x4 vg; float bs[8];
    {
        const bf16_t* wsb = (const bf16_t*)(ws + WS_WSB) + ((size_t)l * 8 + gi) * 16384;
        int n = 0;
#pragma unroll
        for (int i = 0; i < 8; ++i)
#pragma unroll
            for (int ks = 0; ks <= (i >> 1); ++ks) { wf[n] = *(const bf16x8*)(wsb + (16 * i + fr) * 128 + ks * 32 + 8 * fq); ++n; }
        vg = *(const f32x4*)(p.v_norm_g + l * DM + cch);
#pragma unroll
        for (int i = 0; i < 8; ++i) bs[i] = p.b_spatial[((size_t)l * 8 + gi) * 128 + 16 * i + fr];
    }
    u32x4 pv[4]; f32x4 pq[4];
#define A_LOAD(it_) do { const int rb_ = ((it_) >> 3) * 128, gi_ = (it_) & 7; \
        _Pragma("unroll") for (int i_ = 0; i_ < 4; ++i_) { pv[i_] = *(const u32x4*)(gv + (size_t)(rb_ + tok) * DM + gi_ * 128 + (4 * i_ + cl) * 8); pq[i_] = *(const f32x4*)(ssqv + (size_t)(rb_ + tok) * 16 + 4 * i_); } } while (0)
    int it = blockIdx.x;
    if (it < NAITEM) A_LOAD(it);
    for (; it < NAITEM; it += Ge) {
        const int chunk = it >> 3, rowbase = chunk * 128;
        __syncthreads();
        {
            const f32x4 a = pq[0], b = pq[1], c = pq[2], d = pq[3];
            const float ssum = ((a[0] + a[1]) + (a[2] + a[3])) + ((b[0] + b[1]) + (b[2] + b[3])) + ((c[0] + c[1]) + (c[2] + c[3])) + ((d[0] + d[1]) + (d[2] + d[3]));
            const float rs = __builtin_amdgcn_rsqf(ssum * (1.0f / DM) + EPS);
#pragma unroll
            for (int i = 0; i < 4; ++i) {
                const int c8 = 4 * i + cl;
#pragma unroll
                for (int k = 0; k < 4; ++k) {
                    const unsigned pk = cvt_pk_bf16(bf_lo(pv[i][k]) * rs, bf_hi(pv[i][k]) * rs);
                    sVT[(c8 * 8 + 2 * k) * 136 + tok] = (bf16_t)(pk & 0xffffu);
                    sVT[(c8 * 8 + 2 * k + 1) * 136 + tok] = (bf16_t)(pk >> 16);
                }
            }
        }
        __syncthreads();
        if (it + Ge < NAITEM) A_LOAD(it + Ge);
        u32x2 uu[8];
#pragma unroll
        for (int i = 0; i < 8; ++i) uu[i] = *(const u32x2*)(gu + (size_t)(rowbase + 16 * i + fr) * DM + cch);
        bf16x8 vf[4];
#pragma unroll
        for (int ks = 0; ks < 4; ++ks) vf[ks] = *(const LAS bf16x8*)(sVT + (c0 + fr) * 136 + ks * 32 + 8 * fq);
        int n = 0;
#pragma unroll
        for (int i = 0; i < 8; ++i) {
            f32x4 acc = (f32x4){0.f, 0.f, 0.f, 0.f};
#pragma unroll
            for (int ks = 0; ks <= (i >> 1); ++ks) { acc = __builtin_amdgcn_mfma_f32_16x16x32_bf16(vf[ks], wf[n], acc, 0, 0, 0); ++n; }
            const int t = 16 * i + fr;
            const float y0 = bf_lo(uu[i].x) * (vg[0] * acc[0] + bs[i]), y1 = bf_hi(uu[i].x) * (vg[1] * acc[1] + bs[i]);
            const float y2 = bf_lo(uu[i].y) * (vg[2] * acc[2] + bs[i]), y3 = bf_hi(uu[i].y) * (vg[3] * acc[3] + bs[i]);
            u32x2 o; o.x = cvt_pk_bf16(y0, y1); o.y = cvt_pk_bf16(y2, y3);
            *(u32x2*)(ybuf + (size_t)(rowbase + t) * 2048 + cch) = o;
        }
    }
#undef A_LOAD
}

#define DPP_SHR(v, ident, d) __uint_as_float((unsigned)__builtin_amdgcn_update_dpp((int)__float_as_uint(ident), (int)__float_as_uint(v), 0x110 + (d), 0xf, 0xf, false))

constexpr int LSB = 256, NSB = SEQ / LSB, XB_OFF1 = LSB * 136 * 2, CW_OFF = 2 * XB_OFF1, AGG_OFF = CW_OFF + 2560, XBAR_LDS_OFF = AGG_OFF + 1024;
__device__ __forceinline__ void mixerB_phase(const Params& p, LAS unsigned char* lds, int l_in, int wid_s) {
    int tid_ = wid_s * 64 + lane_id_(); asm volatile("" : "+v"(tid_));
    int l = l_in; asm volatile("" : "+s"(l));
    const int tid = tid_, wid = __builtin_amdgcn_readfirstlane(tid >> 6), lane = tid & 63, fr = lane & 15, fq = lane >> 4;
    const int G = gridDim.x;
    unsigned char* ws = p.ws;
    const bf16_t* xb = (const bf16_t*)(ws + WS_PROJ) + (size_t)3 * MG * DM; const bf16_t* zb = (const bf16_t*)(ws + WS_PROJ) + (size_t)4 * MG * DM;
    bf16_t* ybuf = (bf16_t*)(ws + WS_Y);
    LAS float* sCW = (LAS float*)(lds + CW_OFF);
    LAS float* sAgg = (LAS float*)(lds + AGG_OFF);
    const int c8 = (tid & 15) * 8, t8 = (tid >> 4) * 8;
    const int chh = wid & 1, tq = wid >> 1;
    for (int task = blockIdx.x; task < BG * 8 * 4; task += G) {
        const int bh = task & (BG * 8 - 1), cq = task / (BG * 8), bl = bh >> 3, h = bh & 7;
        const int j0 = cq * 32 + chh * 16, chl = h * 128 + j0 + 4 * fq;
        __syncthreads();
        for (int e = tid; e < 640; e += 512) { const int k = e >> 7, c = e & 127; sCW[e] = (k < 4) ? p.conv_w[((size_t)l * 4 + k) * DM + h * 128 + c] : p.conv_b[(size_t)l * DM + h * 128 + c]; }
        bf16x8 wrf[4], wif[4]; f32x4 br, bi, nsp;
        {
            const bf16_t* wr_ = (const bf16_t*)(ws + WS_WRT) + ((size_t)l * 8 + h) * 16384 + (j0 + fr) * 128 + 8 * fq;
            const bf16_t* wi_ = (const bf16_t*)(ws + WS_WIT) + ((size_t)l * 8 + h) * 16384 + (j0 + fr) * 128 + 8 * fq;
#pragma unroll
            for (int ks = 0; ks < 4; ++ks) { wrf[ks] = *(const bf16x8*)(wr_ + ks * 32); wif[ks] = *(const bf16x8*)(wi_ + ks * 32); }
            br = *(const f32x4*)(p.b_rgate + (size_t)l * DM + chl); bi = *(const f32x4*)(p.b_igate + (size_t)l * DM + chl);
            const f32x4 lam = *(const f32x4*)(p.lru_lambda + (size_t)l * DM + chl);
#pragma unroll
            for (int r = 0; r < 4; ++r) { const float z = -lam[r]; nsp[r] = -8.0f * (fmaxf(z, 0.f) + log1pf(expf(-fabsf(z)))); }
        }
        u32x4 xr[11];
#define XB_LOAD(seg_) do { const int rb_ = bl * SEQ + (seg_) * LSB, ch_ = h * 128 + c8; \
        _Pragma("unroll") for (int r_ = 0; r_ < 11; ++r_) { const int t_ = t8 - 3 + r_; xr[r_] = (u32x4){0u, 0u, 0u, 0u}; \
            if (t_ >= 0 || (seg_) > 0) xr[r_] = *(const u32x4*)(xb + (size_t)(rb_ + t_) * DM + ch_); } } while (0)
        XB_LOAD(0);
        float S[4] = {0.f, 0.f, 0.f, 0.f};
        __syncthreads();
        for (int seg = 0; seg < NSB; ++seg) {
            const int rowbase = bl * SEQ + seg * LSB;
            LAS bf16_t* sXb = (LAS bf16_t*)(lds + (seg & 1) * XB_OFF1);
            {
                f32x2 cw2[5][4];
#pragma unroll
                for (int k = 0; k < 5; ++k) { const f32x4 a = *(const LAS f32x4*)(sCW + k * 128 + c8), b = *(const LAS f32x4*)(sCW + k * 128 + c8 + 4);
                    cw2[k][0] = (f32x2){a[0], a[1]}; cw2[k][1] = (f32x2){a[2], a[3]}; cw2[k][2] = (f32x2){b[0], b[1]}; cw2[k][3] = (f32x2){b[2], b[3]}; }
                f32x2 ur[11][4];
#pragma unroll
                for (int r = 0; r < 3; ++r)
#pragma unroll
                    for (int k = 0; k < 4; ++k) ur[r][k] = (f32x2){bf_lo(xr[r][k]), bf_hi(xr[r][k])};
#pragma unroll
                for (int tt = 0; tt < 8; ++tt) {
#pragma unroll
                    for (int k = 0; k < 4; ++k) ur[tt + 3][k] = (f32x2){bf_lo(xr[tt + 3][k]), bf_hi(xr[tt + 3][k])};
                    f32x2 o2[4];
#pragma unroll
                    for (int k = 0; k < 4; ++k) o2[k] = cw2[4][k] + cw2[0][k] * ur[tt][k] + cw2[1][k] * ur[tt + 1][k] + cw2[2][k] * ur[tt + 2][k] + cw2[3][k] * ur[tt + 3][k];
                    u32x4 w; w.x = cvt_pk_bf16(o2[0].x, o2[0].y); w.y = cvt_pk_bf16(o2[1].x, o2[1].y); w.z = cvt_pk_bf16(o2[2].x, o2[2].y); w.w = cvt_pk_bf16(o2[3].x, o2[3].y);
                    *(LAS u32x4*)(sXb + (t8 + tt) * 136 + c8) = w;
                }
            }
            __syncthreads();
            if (seg + 1 < NSB) XB_LOAD(seg + 1);
            u32x2 zz[4];
#pragma unroll
            for (int tt = 0; tt < 4; ++tt) zz[tt] = *(const u32x2*)(zb + (size_t)(rowbase + 64 * tq + 16 * tt + fr) * DM + chl);
            float Pt[4][4], Ht[4][4];
            float Pc[4] = {1.f, 1.f, 1.f, 1.f}, Hc[4] = {0.f, 0.f, 0.f, 0.f};
#pragma unroll
            for (int tt = 0; tt < 4; ++tt) {
                const int trow = 64 * tq + 16 * tt + fr;
                f32x4 aR = (f32x4){0.f, 0.f, 0.f, 0.f}, aI = (f32x4){0.f, 0.f, 0.f, 0.f};
#pragma unroll
                for (int ks = 0; ks < 4; ++ks) {
                    const bf16x8 xf = *(const LAS bf16x8*)(sXb + trow * 136 + ks * 32 + 8 * fq);
                    aR = __builtin_amdgcn_mfma_f32_16x16x32_bf16(wrf[ks], xf, aR, 0, 0, 0);
                    aI = __builtin_amdgcn_mfma_f32_16x16x32_bf16(wif[ks], xf, aI, 0, 0, 0);
                }
                const u32x2 xcw = *(const LAS u32x2*)(sXb + trow * 136 + j0 + 4 * fq);
                const f32x4 xc = (f32x4){bf_lo(xcw.x), bf_hi(xcw.x), bf_lo(xcw.y), bf_hi(xcw.y)};
                float Av[4], Bw[4];
#pragma unroll
                for (int pp = 0; pp < 2; ++pp) {
                    const f32x2 zr = ((f32x2){aR[2 * pp], aR[2 * pp + 1]} + (f32x2){br[2 * pp], br[2 * pp + 1]}) * -1.4426950409f;
                    const f32x2 zi = ((f32x2){aI[2 * pp], aI[2 * pp + 1]} + (f32x2){bi[2 * pp], bi[2 * pp + 1]}) * -1.4426950409f;
                    f32x2 er, ei; er.x = fast_exp2(zr.x); er.y = fast_exp2(zr.y); ei.x = fast_exp2(zi.x); ei.y = fast_exp2(zi.y);
                    const f32x2 dr = er + 1.0f, di = ei + 1.0f;
                    f32x2 rg, ig; rg.x = fast_rcp(dr.x); rg.y = fast_rcp(dr.y); ig.x = fast_rcp(di.x); ig.y = fast_rcp(di.y);
                    const f32x2 la = (f32x2){nsp[2 * pp], nsp[2 * pp + 1]} * rg;
                    const f32x2 la2 = la * 1.4426950409f;
                    f32x2 a; a.x = fast_exp2(la2.x); a.y = fast_exp2(la2.y);
                    const f32x2 x2 = la * 2.0f;
                    const f32x2 em = x2 * (x2 * (x2 * (x2 * (x2 * (x2 * 0.0013888889f + 0.0083333338f) + 0.041666668f) + 0.16666667f) + 0.5f) + 1.0f);
                    const f32x2 ga = a * a * -1.0f + 1.0f;
                    f32x2 g2; g2.x = (x2.x > -0.25f) ? -em.x : ga.x; g2.y = (x2.y > -0.25f) ? -em.y : ga.y;
                    f32x2 sq; sq.x = __builtin_amdgcn_sqrtf(fmaxf(g2.x, 0.f)); sq.y = __builtin_amdgcn_sqrtf(fmaxf(g2.y, 0.f));
                    const f32x2 bv = sq * (ig * (f32x2){xc[2 * pp], xc[2 * pp + 1]});
                    Av[2 * pp] = a.x; Av[2 * pp + 1] = a.y; Bw[2 * pp] = bv.x; Bw[2 * pp + 1] = bv.y;
                }
#pragma unroll
                for (int r = 0; r < 4; ++r) {
                    float A = Av[r], Bv = Bw[r];
#define SCAN_STEP(d) { const float Ap = DPP_SHR(A, 1.0f, d), Bp = DPP_SHR(Bv, 0.0f, d); Bv = A * Bp + Bv; A = A * Ap; }
                    SCAN_STEP(1) SCAN_STEP(2) SCAN_STEP(4) SCAN_STEP(8)
#undef SCAN_STEP
                    const float P = A * Pc[r], H = A * Hc[r] + Bv;
                    Pt[tt][r] = P; Ht[tt][r] = H;
                    Pc[r] = shfl_idx_(P, lane | 15); Hc[r] = shfl_idx_(H, lane | 15);
                }
            }
            if (fr == 0) {
                LAS float* q = sAgg + ((tq * 2 + chh) * 16 + 4 * fq) * 2;
                *(LAS f32x4*)q = (f32x4){Pc[0], Hc[0], Pc[1], Hc[1]}; *(LAS f32x4*)(q + 4) = (f32x4){Pc[2], Hc[2], Pc[3], Hc[3]};
            }
            __syncthreads();
            float carry[4] = {S[0], S[1], S[2], S[3]};
#pragma unroll
            for (int qd = 0; qd < 4; ++qd) {
                const LAS float* q = sAgg + ((qd * 2 + chh) * 16 + 4 * fq) * 2;
                const f32x4 a0 = *(const LAS f32x4*)q, a1 = *(const LAS f32x4*)(q + 4);
                if (qd == tq) { carry[0] = S[0]; carry[1] = S[1]; carry[2] = S[2]; carry[3] = S[3]; }
                S[0] = a0[0] * S[0] + a0[1]; S[1] = a0[2] * S[1] + a0[3]; S[2] = a1[0] * S[2] + a1[1]; S[3] = a1[2] * S[3] + a1[3];
            }
#pragma unroll
            for (int tt = 0; tt < 4; ++tt) {
                const int t = 64 * tq + 16 * tt + fr;
                const float y0 = (Ht[tt][0] + Pt[tt][0] * carry[0]) * bf_lo(zz[tt].x), y1 = (Ht[tt][1] + Pt[tt][1] * carry[1]) * bf_hi(zz[tt].x);
                const float y2 = (Ht[tt][2] + Pt[tt][2] * carry[2]) * bf_lo(zz[tt].y), y3 = (Ht[tt][3] + Pt[tt][3] * carry[3]) * bf_hi(zz[tt].y);
                u32x2 ov; ov.x = cvt_pk_bf16(y0, y1); ov.y = cvt_pk_bf16(y2, y3);
                *(u32x2*)(ybuf + (size_t)(rowbase + t) * 2048 + 1024 + chl) = ov;
            }
        }
#undef XB_LOAD
    }
}

__device__ void phase_final(const Params& p, int wid_s) {
    int tid_ = wid_s * 64 + lane_id_(); asm volatile("" : "+v"(tid_));
    const int tid = tid_, wave = tid >> 6, lane = tid & 63, G = gridDim.x;
    const float* ssqx = (const float*)(p.ws + WS_SSQX);
    f32x4 gv[4];
#pragma unroll
    for (int i = 0; i < 4; ++i) gv[i] = *(const f32x4*)(p.final_g + i * 256 + lane * 4);
    for (int row = blockIdx.x * 8 + wave; row < MTOT; row += G * 8) {
        float s = (lane < 16) ? ssqx[(size_t)row * 16 + lane] : 0.f;
#pragma unroll
        for (int d = 1; d < 16; d <<= 1) s += shfl_idx_(s, lane ^ d);
        s = shfl_idx_(s, lane & 0);
        const float rstd = __builtin_amdgcn_rsqf(s * (1.0f / DM) + EPS);
        float* xr = p.out + (size_t)row * DM; const bf16_t* xb = (const bf16_t*)(p.ws + WS_XBF) + (size_t)row * DM;
        u32x2 w[4];
#pragma unroll
        for (int i = 0; i < 4; ++i) w[i] = *(const u32x2*)(xb + i * 256 + lane * 4);
#pragma unroll
        for (int i = 0; i < 4; ++i) { f32x4 v = (f32x4){bf_lo(w[i].x), bf_hi(w[i].x), bf_lo(w[i].y), bf_hi(w[i].y)}; v = v * rstd * gv[i]; *(f32x4*)(xr + i * 256 + lane * 4) = v; }
    }
}

#define XB_TMO      128
#define XB_XCNT(j)  (256  + 64 * (j))
#define XB_XSUB(j)  (1280 + 64 * (j))
#define XB_XGEN(j)  (2304 + 64 * (j))
#define XB_TOP      3328
#define XB_TOPGEN   3392
#define XCD_BAR_WORDS 3456
#define XB_SPIN_CAP (1u << 18)
__device__ __forceinline__ unsigned xb_ld(unsigned* p)              { return __hip_atomic_load(p, __ATOMIC_RELAXED, __HIP_MEMORY_SCOPE_AGENT); }
__device__ __forceinline__ unsigned xb_add(unsigned* p, unsigned v) { return __hip_atomic_fetch_add(p, v, __ATOMIC_RELAXED, __HIP_MEMORY_SCOPE_AGENT); }
__device__ __forceinline__ unsigned xb_xcc_id() { return (unsigned)__builtin_amdgcn_s_getreg((3 << 11) | 20) & 0xFu; }
#define XB_SPIN(cond, bar) do { unsigned _sp = 0; while (cond) { __builtin_amdgcn_s_sleep(1); \
    if ((++_sp & 255u) == 0u) { if (xb_ld(&(bar)[XB_TMO])) break; if (_sp > XB_SPIN_CAP) { atomicAdd(&(bar)[XB_TMO], 1u); break; } } } } while (0)
struct XcdBarrier { unsigned* bar; unsigned x; volatile LAS unsigned* st; };
__device__ __forceinline__ XcdBarrier xcd_barrier_post(unsigned* bar, volatile LAS unsigned* st, int wid_s) {
    XcdBarrier b; b.bar = bar; b.x = xb_xcc_id(); b.st = st;
    if (wid_s == 0 && lane_id_() == 0) (void)xb_add(&bar[XB_XCNT(b.x)], 1u);
    return b;
}
__device__ __forceinline__ void xcd_barrier_complete(unsigned* bar, unsigned x, unsigned& nloc, unsigned& nx) {
    const unsigned G = gridDim.x * gridDim.y * gridDim.z;
    unsigned sum, cnt, mine, sp = 0u;
    for (;;) {
        sum = 0u; cnt = 0u; mine = 0u;
#pragma unroll
        for (unsigned j = 0; j < 16; ++j) { const unsigned c = xb_ld(&bar[XB_XCNT(j)]); sum += c; cnt += (c > 0u) ? 1u : 0u; mine = (j == x) ? c : mine; }
        if (sum == G) break;
        __builtin_amdgcn_s_sleep(1);
        if ((++sp & 255u) == 0u) { if (xb_ld(&bar[XB_TMO])) break; if (sp > XB_SPIN_CAP) { atomicAdd(&bar[XB_TMO], 1u); break; } }
    }
    nloc = mine > 0u ? mine : 1u; nx = cnt > 0u ? cnt : 1u;
}
__device__ __forceinline__ void xcd_barrier(const XcdBarrier& b, int wid_s) {
    asm volatile("s_waitcnt vmcnt(0)" ::: "memory");
    __syncthreads();
    if (wid_s == 0 && lane_id_() == 0) {
        unsigned* bar = b.bar;
        __builtin_amdgcn_s_waitcnt(0);
        unsigned nloc = b.st[0], nx = b.st[1];
        if (nloc == 0u) { xcd_barrier_complete(bar, b.x, nloc, nx); b.st[0] = nloc; b.st[1] = nx; }
        const unsigned old = xb_add(&bar[XB_XSUB(b.x)], 1u);
        const unsigned gen = old / nloc;
        if (old + 1u == (gen + 1u) * nloc) {
            __builtin_amdgcn_fence(__ATOMIC_RELEASE, "agent");
            asm volatile("s_waitcnt vmcnt(0)" ::: "memory");
            const unsigned og = xb_add(&bar[XB_TOP], 1u);
            const unsigned tg = og / nx;
            if (og + 1u == (tg + 1u) * nx) xb_add(&bar[XB_TOPGEN], 1u);
            else XB_SPIN(xb_ld(&bar[XB_TOPGEN]) == tg, bar);
            __builtin_amdgcn_fence(__ATOMIC_ACQUIRE, "agent");
            xb_add(&bar[XB_XGEN(b.x)], 1u);
            asm volatile("s_waitcnt vmcnt(0)" ::: "memory");
        } else {
            XB_SPIN(xb_ld(&bar[XB_XGEN(b.x)]) == gen, bar);
            __builtin_amdgcn_fence(__ATOMIC_ACQUIRE, "agent");
            asm volatile("s_waitcnt vmcnt(0)" ::: "memory");
        }
    }
    __syncthreads();
}

__global__ void __launch_bounds__(512, 2) mega_fwd(Params p) {
    extern __shared__ __attribute__((aligned(16))) unsigned char lds_raw[];
    LAS unsigned char* lds = (LAS unsigned char*)lds_raw;
    cg::grid_group grid = cg::this_grid();
    unsigned char* ws = p.ws;
    const int G = gridDim.x;
    const int wid_s = __builtin_amdgcn_readfirstlane((int)threadIdx.x >> 6);
    if (threadIdx.x < 4) ((LAS unsigned*)(lds + XBAR_LDS_OFF))[threadIdx.x] = 0u;
    __syncthreads();
    const XcdBarrier xbar = xcd_barrier_post((unsigned*)(ws + WS_BAR), (volatile LAS unsigned*)(lds + XBAR_LDS_OFF), wid_s);

#ifndef PM
#define PM 0xff
#endif
    if (PM & 1) phase_prep(p, lds, wid_s);
    grid.sync();

    for (int l = 0; l < DEPTH; ++l) {
        for (int grp = 0; grp < NGRP; ++grp) {
            const size_t r0 = (size_t)grp * MG;
            if (PM & 2) {
                pg8::Gemm g{(const bf16_t*)(ws + WS_XBF) + r0 * DM, (const bf16_t*)(ws + WS_WIN) + (size_t)l * NIN * DM, MG, NIN, DM};
                pg8::StaticOrder S; S.init(MG, NIN, G, (int)blockIdx.x);
                Epi1 E{(bf16_t*)(ws + WS_PROJ), (const float*)(ws + WS_SSQX) + r0 * 16, (float*)(ws + WS_SSQV), p.b_merge + (size_t)l * 2 * DM};
                pg8::gemm_phase<Epi1>(lds, g, S, E, wid_s);
#ifdef REPG1
                pg8::gemm_phase<Epi1>(lds, g, S, E, wid_s);
#endif
            }
            xcd_barrier(xbar, wid_s);
            if (PM & 4) {
                const unsigned epoch = (unsigned)(l * NGRP + grp + 1);
#ifndef REPB
#define REPB 1
#define REPA 1
#endif
                for (int rep = 0; rep < REPB; ++rep)
                mixerB_phase(p, lds, l, wid_s);
                for (int rep = 0; rep < REPA; ++rep)
                mixerA_phase(p, lds, l, wid_s);
                __syncthreads();
            }
            xcd_barrier(xbar, wid_s);
            if (PM & 8) {
                pg8::Gemm g{(const bf16_t*)(ws + WS_Y), (const bf16_t*)(ws + WS_WP) + (size_t)l * DM * 2048, MG, DM, 2048};
                pg8::StaticOrder S; S.init(MG, DM, G, (int)blockIdx.x);
                Epi2 E{(const bf16_t*)(ws + WS_PROJ) + (size_t)5 * MG * DM, (const bf16_t*)(ws + WS_PROJ) + (size_t)6 * MG * DM, (bf16_t*)(ws + WS_MB)};
                pg8::gemm_phase<Epi2>(lds, g, S, E, wid_s);
#ifdef REPG2
                pg8::gemm_phase<Epi2>(lds, g, S, E, wid_s);
#endif
            }
            xcd_barrier(xbar, wid_s);
            if (PM & 16) {
                pg8::Gemm g{(const bf16_t*)(ws + WS_MB), (const bf16_t*)(ws + WS_WO) + (size_t)l * DM * DM, MG, DM, DM};
                pg8::StaticOrder S; S.init(MG, DM, G, (int)blockIdx.x);
                Epi3 E{l == 0 ? p.x + r0 * DM : nullptr, nullptr, (bf16_t*)(ws + WS_XBF) + r0 * DM, (float*)(ws + WS_SSQX) + r0 * 16};
                pg8::gemm_phase<Epi3>(lds, g, S, E, wid_s);
            }
            if (NGRP == 1) xcd_barrier(xbar, wid_s);
        }
    }
    xcd_barrier(xbar, wid_s);
    if (PM & 32) phase_final(p, wid_s);
}

extern "C" void kernel_launch(void* const* d_in, const int* in_sizes, int n_in, void* d_out, int out_size, void* d_ws, size_t ws_size, hipStream_t stream) {
    static int grid_blocks = 0;
    if (grid_blocks == 0) {
        if (ws_size < WS_END) { fprintf(stderr, "kernel_launch: workspace too small (%zu < %zu)\n", ws_size, (size_t)WS_END); grid_blocks = -1; return; }
        int dev = 0, cus = 0, per_cu = 0;
        hipGetDevice(&dev);
        hipDeviceGetAttribute(&cus, hipDeviceAttributeMultiprocessorCount, dev);
        hipFuncSetAttribute((const void*)mega_fwd, hipFuncAttributeMaxDynamicSharedMemorySize, LDS_BYTES);
        hipOccupancyMaxActiveBlocksPerMultiprocessor(&per_cu, (const void*)mega_fwd, 512, LDS_BYTES);
        if (per_cu < 1) per_cu = 1;
        grid_blocks = cus * 1;
        fprintf(stderr, "kernel_launch: cus %d per_cu %d grid %d\n", cus, per_cu, grid_blocks);
    }
    if (grid_blocks < 0) return;
    Params p{};
    p.x = (const float*)d_in[0]; p.norm_g = (const float*)d_in[1]; p.w_in = (const float*)d_in[2]; p.b_merge = (const float*)d_in[3]; p.v_norm_g = (const float*)d_in[4];
    p.w_spatial = (const float*)d_in[5]; p.b_spatial = (const float*)d_in[6]; p.conv_w = (const float*)d_in[7]; p.conv_b = (const float*)d_in[8];
    p.w_rgate = (const float*)d_in[9]; p.b_rgate = (const float*)d_in[10]; p.w_igate = (const float*)d_in[11]; p.b_igate = (const float*)d_in[12]; p.lru_lambda = (const float*)d_in[13];
    p.w_proj_a = (const float*)d_in[14]; p.w_proj_b = (const float*)d_in[15]; p.w_out = (const float*)d_in[16]; p.final_g = (const float*)d_in[17];
    p.out = (float*)d_out; p.ws = (unsigned char*)d_ws;
    hipMemsetAsync((unsigned char*)d_ws + WS_BAR, 0, 16384, stream);
    void* args[] = {&p};
    hipError_t e = hipLaunchCooperativeKernel((const void*)mega_fwd, dim3(grid_blocks), dim3(512), args, LDS_BYTES, stream);
    if (e != hipSuccess) fprintf(stderr, "cooperative launch failed: %s (grid %d)\n", hipGetErrorString(e), grid_blocks);
}
```

```cpp
#include <hip/hip_runtime.h>
#include <hip/hip_cooperative_groups.h>
#include <cstdio>
namespace cg = cooperative_groups;

#define LAS __attribute__((address_space(3)))
typedef unsigned short bf16_t;
typedef short bf16x8 __attribute__((ext_vector_type(8)));
typedef float f32x4 __attribute__((ext_vector_type(4)));
typedef unsigned u32x4 __attribute__((ext_vector_type(4)));
typedef unsigned u32x2 __attribute__((ext_vector_type(2)));
typedef float f32x2 __attribute__((ext_vector_type(2)));

constexpr int DM = 1024, NBATCH = 16, SEQ = 4096, MTOT = NBATCH * SEQ, DEPTH = 4, NIN = 7168;
constexpr int NGRP = 2, MG = MTOT / NGRP, BG = NBATCH / NGRP;
constexpr int LSEG = 128, NSEG = SEQ / LSEG;
constexpr int NBITEM = BG * 8 * NSEG, NAITEM = (MG / 128) * 8;
constexpr float EPS = 1e-6f;
constexpr int LDS_BYTES = 142848 + 16;

constexpr size_t WS_WIN = 0;
constexpr size_t WS_WP = WS_WIN + (size_t)DEPTH * NIN * DM * 2;
constexpr size_t WS_WO = WS_WP + (size_t)DEPTH * DM * 2048 * 2;
constexpr size_t WS_WSB = WS_WO + (size_t)DEPTH * DM * DM * 2;
constexpr size_t WS_WRT = WS_WSB + (size_t)DEPTH * 8 * 128 * 128 * 2;
constexpr size_t WS_WIT = WS_WRT + (size_t)DEPTH * 8 * 128 * 128 * 2;
constexpr size_t WS_XBF = WS_WIT + (size_t)DEPTH * 8 * 128 * 128 * 2;
constexpr size_t WS_SSQX = WS_XBF + (size_t)MTOT * DM * 2;
constexpr size_t WS_SSQV = WS_SSQX + (size_t)MTOT * 16 * 4;
constexpr size_t WS_PROJ = WS_SSQV + (size_t)MG * 16 * 4;
constexpr size_t WS_Y = WS_PROJ + (size_t)7 * MG * DM * 2;
constexpr size_t WS_MB = WS_Y + (size_t)MG * 2048 * 2;
constexpr size_t WS_PAY = WS_MB + (size_t)MG * DM * 2;
constexpr size_t WS_PAYP = WS_PAY + (size_t)NBITEM * 8 * 16 * 8;
constexpr size_t WS_FLG = WS_PAYP + (size_t)NBITEM * 8 * 16 * 4;
constexpr size_t WS_BAR = WS_FLG + (size_t)NBITEM * 8 * 4;
constexpr size_t WS_END = WS_BAR + 16384;

struct Params {
    const float* x; const float* norm_g; const float* w_in; const float* b_merge; const float* v_norm_g; const float* w_spatial; const float* b_spatial;
    const float* conv_w; const float* conv_b; const float* w_rgate; const float* b_rgate; const float* w_igate; const float* b_igate; const float* lru_lambda;
    const float* w_proj_a; const float* w_proj_b; const float* w_out; const float* final_g;
    float* out; unsigned char* ws;
};

__device__ __forceinline__ float shfl_idx_(float v, int src_lane) { return __uint_as_float((unsigned)__builtin_amdgcn_ds_bpermute(src_lane << 2, (int)__float_as_uint(v))); }
__device__ __forceinline__ int lane_id_() { return (int)__builtin_amdgcn_mbcnt_hi(~0u, __builtin_amdgcn_mbcnt_lo(~0u, 0u)); }
__device__ __forceinline__ unsigned cvt_pk_bf16(float lo, float hi) { unsigned r; asm volatile("v_cvt_pk_bf16_f32 %0, %1, %2" : "=v"(r) : "v"(lo), "v"(hi)); return r; }
__device__ __forceinline__ float bf_lo(unsigned w) { return __uint_as_float(w << 16); }
__device__ __forceinline__ float bf_hi(unsigned w) { return __uint_as_float(w & 0xffff0000u); }
__device__ __forceinline__ float fast_rcp(float x) { return __builtin_amdgcn_rcpf(x); }
__device__ __forceinline__ float fast_exp2(float x) { return __builtin_amdgcn_exp2f(x); }
__device__ __forceinline__ float sigmoidf_(float x) { return fast_rcp(1.0f + fast_exp2(-1.4426950409f * x)); }

namespace pg8 {
constexpr int BM = 256, BK = 64, HALF = 128, HTB = HALF * BK * 2, STAGE_BYTES = 8 * HTB, NXCD = 8, WGM = 8;
__host__ __device__ __forceinline__ int lds_byte(int r, int c) { const int st = (r >> 4) * 2 + (c >> 5), rr = r & 15, cc = c & 31, ob = rr * 64 + cc * 2; return st * 1024 + (ob ^ (((ob >> 9) & 1) << 5)); }
__host__ __device__ __forceinline__ void stage_rc(int b, int& R, int& C) { const int st = b / 1024, sb = b % 1024, swz = sb ^ (((sb >> 9) & 1) << 5); R = (st >> 1) * 16 + swz / 64; C = (st & 1) * 32 + (swz % 64) / 2; }
__host__ __device__ __forceinline__ int perm32(int rho) { const int n = rho >> 4, i = rho & 15; return 8 * (i >> 2) + 4 * n + (i & 3); }
struct Unit { int pm, pn; };
struct Gemm { const bf16_t* A; const bf16_t* Bt; int M, N, K; };
struct StaticOrder {
    int nM, nN, nwg, G, c;
    __device__ void init(int M, int N, int G_, int c_) { nM = M / BM; nN = N / BM; nwg = nM * nN; G = G_; c = c_; }
    __device__ bool next(int i, Unit& u) const {
        const long L = (long)i * G + c; if (L >= nwg) return false;
        int wgid = (int)L; { const int q = nwg / NXCD, r = nwg % NXCD, xcd = wgid % NXCD, off = wgid / NXCD; wgid = (xcd < r ? xcd * (q + 1) : r * (q + 1) + (xcd - r) * q) + off; }
        const int nig = WGM * nN, gid = wgid / nig, fm = gid * WGM, gsz = (nM - fm) < WGM ? (nM - fm) : WGM;
        u.pm = fm + ((wgid % nig) % gsz); u.pn = (wgid % nig) / gsz; return true;
    }
};
template <class Epi>
__device__ __forceinline__ void gemm_phase(LAS unsigned char* lds, const Gemm g, const StaticOrder& S, const Epi& E, int wid_s) {
    int tid_ = wid_s * 64 + lane_id_(); asm volatile("" : "+v"(tid_));
    const int tid = tid_, wid = __builtin_amdgcn_readfirstlane(tid >> 6), lane = tid & 63, wr = wid >> 2, wc = wid & 3, fr = lane & 15, fq = lane >> 4;
    const int K = g.K, nt = K / BK;
    unsigned voffA[2], voffB[2];
#pragma unroll
    for (int i = 0; i < 2; ++i) { int R, C; stage_rc(tid * 16 + i * 8192, R, C); const int Rb = ((R & ~31) + perm32(R & 31));
        voffA[i] = (unsigned)(R * K + C) * 2u; voffB[i] = (unsigned)(Rb * K + C) * 2u; }
    const size_t kstep = (size_t)(BK * 2);
    const size_t hstep = (size_t)HALF * K * 2;
    const size_t tstep = 2 * hstep;
    const unsigned ldsw = (unsigned)wid * 1024u;
    const int aoff = lds_byte(wr * 64 + fr, fq * 8), boff = lds_byte(wc * 32 + fr, fq * 8);
#define PG8_SA(b, h) (((b) * 2 + (h)) * HTB)
#define PG8_SB(b, h) ((4 + (b) * 2 + (h)) * HTB)
#define PG8_STAGE(bufoff, gbase, voff) do { _Pragma("unroll") for (int _i = 0; _i < 2; ++_i) \
        __builtin_amdgcn_global_load_lds((const unsigned*)((const char*)(gbase) + (voff)[_i]), (LAS unsigned*)(lds + (bufoff) + ldsw + _i * 8192), 16, 0, 0); } while (0)
#define PG8_LDA(dst, b, h) do { _Pragma("unroll") for (int m = 0; m < 4; ++m) _Pragma("unroll") for (int k = 0; k < 2; ++k) dst[m][k] = *(const LAS bf16x8*)(lds + PG8_SA(b, h) + aoff + m * 2048 + k * 1024); } while (0)
#define PG8_LDB(dst, b, h) do { _Pragma("unroll") for (int n = 0; n < 2; ++n) _Pragma("unroll") for (int k = 0; k < 2; ++k) dst[n][k] = *(const LAS bf16x8*)(lds + PG8_SB(b, h) + boff + n * 2048 + k * 1024); } while (0)
#define PG8_MMA(ai, bj, At, Bt) do { __builtin_amdgcn_s_setprio(1); _Pragma("unroll") for (int m = 0; m < 4; ++m) _Pragma("unroll") for (int n = 0; n < 2; ++n) _Pragma("unroll") for (int k = 0; k < 2; ++k) \
        acc[ai][bj][m][n] = __builtin_amdgcn_mfma_f32_16x16x32_bf16(Bt[n][k], At[m][k], acc[ai][bj][m][n], 0, 0, 0); __builtin_amdgcn_s_setprio(0); } while (0)
#define PG8_WAIT_V(n) asm volatile("s_waitcnt vmcnt(" #n ")" ::: "memory")
#define PG8_WAIT_L(n) asm volatile("s_waitcnt lgkmcnt(" #n ")" ::: "memory")
#define PG8_BAR __builtin_amdgcn_s_barrier()
#define PG8_SCHED __builtin_amdgcn_sched_barrier(0)
    Unit cur, nxt; int ui = 0;
    if (!S.next(0, cur)) return;
    float est[8]; int est_pm = -1;
#pragma unroll
    for (int i = 0; i < 8; ++i) est[i] = 0.f;
    f32x4 acc[2][2][4][2];
#pragma unroll
    for (int a = 0; a < 2; ++a)
#pragma unroll
        for (int b = 0; b < 2; ++b)
#pragma unroll
            for (int m = 0; m < 4; ++m)
#pragma unroll
                for (int n = 0; n < 2; ++n) acc[a][b][m][n] = (f32x4){0.f, 0.f, 0.f, 0.f};
    bf16x8 At[4][2], B0[2][2], B1[2][2];
    const char* cA = (const char*)g.A + (size_t)cur.pm * tstep; const char* cB = (const char*)g.Bt + (size_t)cur.pn * tstep;
    PG8_STAGE(PG8_SB(0, 0), cB, voffB); PG8_STAGE(PG8_SB(0, 1), cB + hstep, voffB); PG8_STAGE(PG8_SA(0, 0), cA, voffA); PG8_STAGE(PG8_SA(0, 1), cA + hstep, voffA);
    if (wr == 1) PG8_BAR;
    PG8_WAIT_V(2); PG8_BAR;
    PG8_STAGE(PG8_SB(1, 0), cB + kstep, voffB); PG8_STAGE(PG8_SA(1, 0), cA + kstep, voffA); PG8_STAGE(PG8_SB(1, 1), cB + hstep + kstep, voffB);
    PG8_WAIT_V(6); PG8_BAR;
    for (;;) {
        const bool has_next = S.next(ui + 1, nxt);
        const char* nA = has_next ? (const char*)g.A + (size_t)nxt.pm * tstep : cA; const char* nB = has_next ? (const char*)g.Bt + (size_t)nxt.pn * tstep : cB;
        for (int t = 0; t < nt; t += 2) {
            const bool last = (t == nt - 2);
            const char* a1 = cA + (size_t)(t + 1) * kstep;
            const char* a2 = last ? nA : cA + (size_t)(t + 2) * kstep; const char* b2 = last ? nB : cB + (size_t)(t + 2) * kstep;
            const char* a3 = a2 + kstep; const char* b3 = b2 + kstep;
            if constexpr (Epi::HAS_MID) { if (t == nt / 2) E.mid(acc, cur, wr, wc, fr, fq); }
            PG8_LDB(B0, 0, 0); PG8_LDB(B1, 0, 1); PG8_SCHED; PG8_LDA(At, 0, 0); PG8_STAGE(PG8_SA(1, 1), a1 + hstep, voffA);
            PG8_WAIT_V(8); PG8_WAIT_L(0); PG8_BAR; PG8_MMA(0, 0, At, B0); PG8_MMA(0, 1, At, B1); PG8_BAR; PG8_SCHED;
            PG8_LDA(At, 0, 1); PG8_STAGE(PG8_SB(0, 0), b2, voffB); PG8_STAGE(PG8_SB(0, 1), b2 + hstep, voffB); PG8_STAGE(PG8_SA(0, 0), a2, voffA);
            PG8_WAIT_V(8); PG8_WAIT_L(0); PG8_BAR; PG8_MMA(1, 0, At, B0); PG8_MMA(1, 1, At, B1); PG8_BAR; PG8_SCHED;
            PG8_LDB(B0, 1, 0); PG8_LDB(B1, 1, 1); PG8_SCHED; PG8_LDA(At, 1, 0); PG8_STAGE(PG8_SA(0, 1), a2 + hstep, voffA);
            PG8_WAIT_V(8); PG8_WAIT_L(0); PG8_BAR; PG8_MMA(0, 0, At, B0); PG8_MMA(0, 1, At, B1); PG8_BAR; PG8_SCHED;
            PG8_LDA(At, 1, 1); PG8_STAGE(PG8_SB(1, 0), b3, voffB); PG8_STAGE(PG8_SB(1, 1), b3 + hstep, voffB); PG8_STAGE(PG8_SA(1, 0), a3, voffA);
            PG8_WAIT_V(8); PG8_WAIT_L(0); PG8_BAR; PG8_MMA(1, 0, At, B0); PG8_MMA(1, 1, At, B1); PG8_BAR; PG8_SCHED;
        }
        if (wr == 0) PG8_BAR;
        E(acc, cur, wr, wc, fr, fq, est, est_pm);
        if (!has_next) break;
#pragma unroll
        for (int a = 0; a < 2; ++a)
#pragma unroll
            for (int b = 0; b < 2; ++b)
#pragma unroll
                for (int m = 0; m < 4; ++m)
#pragma unroll
                    for (int n = 0; n < 2; ++n) acc[a][b][m][n] = (f32x4){0.f, 0.f, 0.f, 0.f};
        cur = nxt; cA = nA; cB = nB; ++ui;
        if (wr == 1) PG8_BAR;
    }
    PG8_WAIT_V(0);
    PG8_BAR;
#undef PG8_SA
#undef PG8_SB
#undef PG8_STAGE
#undef PG8_LDA
#undef PG8_LDB
#undef PG8_MMA
#undef PG8_WAIT_V
#undef PG8_WAIT_L
#undef PG8_BAR
#undef PG8_SCHED
}
}

struct Epi1 {
    static constexpr bool HAS_MID = false;
    bf16_t* proj; const float* ssqx; float* ssqv; const float* bm;
    __device__ __forceinline__ void mid(f32x4 (&)[2][2][4][2], const pg8::Unit&, int, int, int, int) const {}
    __device__ __forceinline__ void operator()(const f32x4 (&acc)[2][2][4][2], const pg8::Unit& u, int wr, int wc, int fr, int fq, float (&est)[8], int& est_pm) const {
        const int pn = u.pn; const bool uz = pn < 8, gg = pn >= 20;
        const int seg = uz ? 0 : (pn < 12 ? 1 : (gg ? 5 : (pn >> 2)));
        const int colt = uz ? pn * 128 : (gg ? (pn - 20) * 128 : (pn & 3) * 256);
        bf16_t* base = proj + (size_t)seg * MG * DM;
        const int row0 = u.pm * 256 + wr * 64 + fr, colw = wc * 32 + 8 * fq;
        const float G1c = -2.3022082f, G3c = -2.3022082f * 0.044715f, S1c = -1.4426950409f;
        const float c1_0 = (seg <= 1) ? G1c : S1c, c3_0 = (seg <= 1) ? G3c : 0.f;
        const float c1_1 = (seg == 1) ? G1c : S1c, c3_1 = (seg == 1) ? G3c : 0.f;
        const bool numx = (seg <= 4), raw = (seg == 3);
        float cb[2][8];
#pragma unroll
        for (int bj = 0; bj < 2; ++bj)
#pragma unroll
            for (int j = 0; j < 8; ++j) cb[bj][j] = gg ? -1.4426950409f * bm[bj * DM + colt + colw + j] : 0.f;
        if (u.pm != est_pm) {
            est_pm = u.pm;
            f32x4 pp[2][4];
#pragma unroll
            for (int ai = 0; ai < 2; ++ai)
#pragma unroll
                for (int m = 0; m < 4; ++m) pp[ai][m] = *(const f32x4*)(ssqx + (size_t)(row0 + ai * 128 + m * 16) * 16 + fq * 4);
#pragma unroll
            for (int ai = 0; ai < 2; ++ai)
#pragma unroll
                for (int m = 0; m < 4; ++m) { float s = (pp[ai][m][0] + pp[ai][m][1]) + (pp[ai][m][2] + pp[ai][m][3]); s += shfl_idx_(s, (fq * 16 + fr) ^ 16); s += shfl_idx_(s, (fq * 16 + fr) ^ 32);
                    est[ai * 4 + m] = __builtin_amdgcn_rsqf(s * (1.0f / DM) + EPS); }
        }
#pragma unroll
        for (int ai = 0; ai < 2; ++ai)
#pragma unroll
            for (int m = 0; m < 4; ++m) {
                const int row = row0 + ai * 128 + m * 16;
                const float rstd = est[ai * 4 + m];
                float sq = 0.f;
                float v[2][8];
#pragma unroll
                for (int bj = 0; bj < 2; ++bj) {
                    const float c1 = bj ? c1_1 : c1_0, c3 = bj ? c3_1 : c3_0;
#pragma unroll
                    for (int n = 0; n < 2; ++n)
#pragma unroll
                        for (int j = 0; j < 4; ++j) v[bj][n * 4 + j] = acc[ai][bj][m][n][j] * rstd;
                    if (!raw) {
#pragma unroll
                        for (int j = 0; j < 8; ++j) { const float x = v[bj][j]; const float arg = x * (c1 + c3 * x * x) + cb[bj][j]; const float r = fast_rcp(1.0f + fast_exp2(arg)); v[bj][j] = numx ? x * r : r; }
                    }
                    if (seg == 1) {
#pragma unroll
                        for (int j = 0; j < 8; ++j) sq += v[bj][j] * v[bj][j];
                    }
                }
                if (uz) {
                    u32x4 w; w.x = cvt_pk_bf16(v[0][0] * v[1][0], v[0][1] * v[1][1]); w.y = cvt_pk_bf16(v[0][2] * v[1][2], v[0][3] * v[1][3]);
                    w.z = cvt_pk_bf16(v[0][4] * v[1][4], v[0][5] * v[1][5]); w.w = cvt_pk_bf16(v[0][6] * v[1][6], v[0][7] * v[1][7]);
                    *(u32x4*)(base + (size_t)row * DM + colt + colw) = w;
                } else if (gg) {
                    float q[8];
#pragma unroll
                    for (int j = 0; j < 8; ++j) q[j] = v[0][j] * fast_rcp(fmaxf(v[1][j], 1e-30f));
                    u32x4 w; w.x = cvt_pk_bf16(q[0], q[1]); w.y = cvt_pk_bf16(q[2], q[3]); w.z = cvt_pk_bf16(q[4], q[5]); w.w = cvt_pk_bf16(q[6], q[7]);
                    *(u32x4*)(base + (size_t)row * DM + colt + colw) = w;
                    u32x4 w2; w2.x = cvt_pk_bf16(v[1][0], v[1][1]); w2.y = cvt_pk_bf16(v[1][2], v[1][3]); w2.z = cvt_pk_bf16(v[1][4], v[1][5]); w2.w = cvt_pk_bf16(v[1][6], v[1][7]);
                    *(u32x4*)(base + (size_t)MG * DM + (size_t)row * DM + colt + colw) = w2;
                } else {
#pragma unroll
                    for (int bj = 0; bj < 2; ++bj) {
                        u32x4 w; w.x = cvt_pk_bf16(v[bj][0], v[bj][1]); w.y = cvt_pk_bf16(v[bj][2], v[bj][3]); w.z = cvt_pk_bf16(v[bj][4], v[bj][5]); w.w = cvt_pk_bf16(v[bj][6], v[bj][7]);
                        *(u32x4*)(base + (size_t)row * DM + colt + bj * 128 + colw) = w;
                    }
                }
                if (seg == 1) { sq += shfl_idx_(sq, (fq * 16 + fr) ^ 16); sq += shfl_idx_(sq, (fq * 16 + fr) ^ 32); if (fq == 0) ssqv[(size_t)row * 16 + (pn & 3) * 4 + wc] = sq; }
            }
    }
};
struct Epi2 {
    static constexpr bool HAS_MID = true;
    const bf16_t* sa; const bf16_t* sb; bf16_t* mout;
    __device__ __forceinline__ void mid(f32x4 (&acc)[2][2][4][2], const pg8::Unit& u, int wr, int wc, int fr, int fq) const {
        int row0 = u.pm * 256 + wr * 64 + fr, col0 = u.pn * 256 + wc * 32 + 8 * fq;
        asm volatile("" : "+v"(row0), "+v"(col0));
#pragma unroll
        for (int ai = 0; ai < 2; ++ai) {
            u32x4 av[4][2];
#pragma unroll
            for (int m = 0; m < 4; ++m)
#pragma unroll
                for (int bj = 0; bj < 2; ++bj) av[m][bj] = *(const u32x4*)(sa + (size_t)(row0 + ai * 128 + m * 16) * DM + col0 + bj * 128);
#pragma unroll
            for (int m = 0; m < 4; ++m)
#pragma unroll
                for (int bj = 0; bj < 2; ++bj) {
#pragma unroll
                    for (int q = 0; q < 4; ++q) { acc[ai][bj][m][q >> 1][(q & 1) * 2] *= bf_lo(av[m][bj][q]); acc[ai][bj][m][q >> 1][(q & 1) * 2 + 1] *= bf_hi(av[m][bj][q]); }
                }
            asm volatile("" ::: "memory");
        }
    }
    __device__ __forceinline__ void operator()(const f32x4 (&acc)[2][2][4][2], const pg8::Unit& u, int wr, int wc, int fr, int fq, float (&)[8], int&) const {
        const int row0 = u.pm * 256 + wr * 64 + fr, col0 = u.pn * 256 + wc * 32 + 8 * fq;
        u32x4 bv[2][4][2];
#pragma unroll
        for (int ai = 0; ai < 2; ++ai)
#pragma unroll
            for (int m = 0; m < 4; ++m)
#pragma unroll
                for (int bj = 0; bj < 2; ++bj) bv[ai][m][bj] = *(const u32x4*)(sb + (size_t)(row0 + ai * 128 + m * 16) * DM + col0 + bj * 128);
#pragma unroll
        for (int ai = 0; ai < 2; ++ai)
#pragma unroll
            for (int m = 0; m < 4; ++m)
#pragma unroll
                for (int bj = 0; bj < 2; ++bj) {
                    const size_t off = (size_t)(row0 + ai * 128 + m * 16) * DM + col0 + bj * 128;
                    const u32x4 b = bv[ai][m][bj];
                    u32x4 w;
#pragma unroll
                    for (int q = 0; q < 4; ++q) w[q] = cvt_pk_bf16(acc[ai][bj][m][q >> 1][(q & 1) * 2] * bf_lo(b[q]), acc[ai][bj][m][q >> 1][(q & 1) * 2 + 1] * bf_hi(b[q]));
                    *(u32x4*)(mout + off) = w;
                }
    }
};
struct Epi3 {
    static constexpr bool HAS_MID = false;
    const float* xin_f; float* xout_f; bf16_t* xbf; float* ssqx;
    __device__ __forceinline__ void mid(f32x4 (&)[2][2][4][2], const pg8::Unit&, int, int, int, int) const {}
    __device__ __forceinline__ void operator()(const f32x4 (&acc)[2][2][4][2], const pg8::Unit& u, int wr, int wc, int fr, int fq, float (&)[8], int&) const {
        const int row0 = u.pm * 256 + wr * 64 + fr, col0 = u.pn * 256 + wc * 32 + 8 * fq;
#pragma unroll
        for (int ai = 0; ai < 2; ++ai) {
            f32x4 xv[4][2][2];
            if (xin_f) {
#pragma unroll
                for (int m = 0; m < 4; ++m)
#pragma unroll
                    for (int bj = 0; bj < 2; ++bj) { const size_t off = (size_t)(row0 + ai * 128 + m * 16) * DM + col0 + bj * 128; xv[m][bj][0] = *(const f32x4*)(xin_f + off); xv[m][bj][1] = *(const f32x4*)(xin_f + off + 4); }
            } else {
                u32x4 xb_[4][2];
#pragma unroll
                for (int m = 0; m < 4; ++m)
#pragma unroll
                    for (int bj = 0; bj < 2; ++bj) xb_[m][bj] = *(const u32x4*)(xbf + (size_t)(row0 + ai * 128 + m * 16) * DM + col0 + bj * 128);
#pragma unroll
                for (int m = 0; m < 4; ++m)
#pragma unroll
                    for (int bj = 0; bj < 2; ++bj) { const u32x4 w = xb_[m][bj];
                        xv[m][bj][0] = (f32x4){bf_lo(w.x), bf_hi(w.x), bf_lo(w.y), bf_hi(w.y)}; xv[m][bj][1] = (f32x4){bf_lo(w.z), bf_hi(w.z), bf_lo(w.w), bf_hi(w.w)}; }
            }
#pragma unroll
            for (int m = 0; m < 4; ++m) {
                const int row = row0 + ai * 128 + m * 16; float sq = 0.f;
#pragma unroll
                for (int bj = 0; bj < 2; ++bj) {
                    const size_t off = (size_t)row * DM + col0 + bj * 128;
                    const f32x4 x0 = xv[m][bj][0] + acc[ai][bj][m][0], x1 = xv[m][bj][1] + acc[ai][bj][m][1];
                    sq += (x0[0] * x0[0] + x0[1] * x0[1]) + (x0[2] * x0[2] + x0[3] * x0[3]) + (x1[0] * x1[0] + x1[1] * x1[1]) + (x1[2] * x1[2] + x1[3] * x1[3]);
                    if (xout_f) { *(f32x4*)(xout_f + off) = x0; *(f32x4*)(xout_f + off + 4) = x1; }
                    else { u32x4 w; w.x = cvt_pk_bf16(x0[0], x0[1]); w.y = cvt_pk_bf16(x0[2], x0[3]); w.z = cvt_pk_bf16(x1[0], x1[1]); w.w = cvt_pk_bf16(x1[2], x1[3]); *(u32x4*)(xbf + off) = w; }
                }
                sq += shfl_idx_(sq, (fq * 16 + fr) ^ 16); sq += shfl_idx_(sq, (fq * 16 + fr) ^ 32);
                if (fq == 0) ssqx[(size_t)row * 16 + u.pn * 4 + wc] = sq;
            }
            asm volatile("" ::: "memory");
        }
    }
};

struct TrJob { const float* src; const float* scale; bf16_t* dst; int C, ldd, coff, r0, c0; };
__device__ __forceinline__ TrJob tr_decode(const Params& p, int t) {
    unsigned char* ws = p.ws;
    const int l = t / 2624; int q = t % 2624; TrJob j;
    if (q < 1792) { j.src = p.w_in + (size_t)l * DM * NIN; j.C = NIN; j.scale = p.norm_g + l * DM; j.ldd = DM; j.coff = 0; j.r0 = (q / 112) * 64; j.c0 = (q % 112) * 64;
        const int n = j.c0; int d0 = n;
        if (n < 1024) d0 = (n >> 7) * 256 + (n & 127); else if (n < 2048) d0 = 2048 + (n - 1024); else if (n < 3072) d0 = ((n - 2048) >> 7) * 256 + 128 + ((n - 2048) & 127);
        else if (n >= 6144) d0 = 5120 + ((n - 6144) >> 7) * 256 + 128 + ((n - 6144) & 127); else if (n >= 5120) d0 = 5120 + ((n - 5120) >> 7) * 256 + ((n - 5120) & 127);
        j.dst = (bf16_t*)(ws + WS_WIN) + (size_t)l * NIN * DM + (ptrdiff_t)(d0 - j.c0) * DM; return j; }
    q -= 1792; j.scale = nullptr;
    if (q < 256) { j.src = p.w_proj_a + (size_t)l * DM * DM; j.C = DM; j.dst = (bf16_t*)(ws + WS_WP) + (size_t)l * DM * 2048; j.ldd = 2048; j.coff = 0; j.r0 = (q / 16) * 64; j.c0 = (q % 16) * 64; return j; }
    q -= 256;
    if (q < 256) { j.src = p.w_proj_b + (size_t)l * DM * DM; j.C = DM; j.dst = (bf16_t*)(ws + WS_WP) + (size_t)l * DM * 2048; j.ldd = 2048; j.coff = 1024; j.r0 = (q / 16) * 64; j.c0 = (q % 16) * 64; return j; }
    q -= 256;
    if (q < 256) { j.src = p.w_out + (size_t)l * DM * DM; j.C = DM; j.dst = (bf16_t*)(ws + WS_WO) + (size_t)l * DM * DM; j.ldd = DM; j.coff = 0; j.r0 = (q / 16) * 64; j.c0 = (q % 16) * 64; return j; }
    q -= 256;
    const bool ig = q >= 32; if (ig) q -= 32;
    const int h = q >> 2, tt = q & 3;
    j.src = (ig ? p.w_igate : p.w_rgate) + ((size_t)l * 8 + h) * 16384; j.C = 128; j.dst = (bf16_t*)(ws + (ig ? WS_WIT : WS_WRT)) + ((size_t)l * 8 + h) * 16384; j.ldd = 128; j.coff = 0; j.r0 = (tt >> 1) * 64; j.c0 = (tt & 1) * 64;
    return j;
}

__device__ void phase_prep(const Params& p, LAS unsigned char* lds, int wid_s) {
    int tid_ = wid_s * 64 + lane_id_(); asm volatile("" : "+v"(tid_));
    const int tid = tid_, G = gridDim.x;
    unsigned char* ws = p.ws;
    LAS float* tile = (LAS float*)lds;
    {
        const int NT = DEPTH * 2624;
        const int lr = tid >> 4, c4 = (tid & 15) * 4;
        int t = blockIdx.x;
        TrJob job; f32x4 v0, v1; float s0 = 1.f, s1 = 1.f;
        if (t < NT) { job = tr_decode(p, t);
            v0 = *(const f32x4*)(job.src + (size_t)(job.r0 + lr) * job.C + job.c0 + c4); v1 = *(const f32x4*)(job.src + (size_t)(job.r0 + 32 + lr) * job.C + job.c0 + c4);
            if (job.scale) { s0 = job.scale[job.r0 + lr]; s1 = job.scale[job.r0 + 32 + lr]; } }
        for (; t < NT; t += G) {
            TrJob nxt = job; f32x4 n0 = v0, n1 = v1; float ns0 = 1.f, ns1 = 1.f;
            if (t + G < NT) { nxt = tr_decode(p, t + G);
                n0 = *(const f32x4*)(nxt.src + (size_t)(nxt.r0 + lr) * nxt.C + nxt.c0 + c4); n1 = *(const f32x4*)(nxt.src + (size_t)(nxt.r0 + 32 + lr) * nxt.C + nxt.c0 + c4);
                if (nxt.scale) { ns0 = nxt.scale[nxt.r0 + lr]; ns1 = nxt.scale[nxt.r0 + 32 + lr]; } }
            tile[(c4 + 0) * 65 + lr] = v0[0] * s0; tile[(c4 + 1) * 65 + lr] = v0[1] * s0; tile[(c4 + 2) * 65 + lr] = v0[2] * s0; tile[(c4 + 3) * 65 + lr] = v0[3] * s0;
            tile[(c4 + 0) * 65 + 32 + lr] = v1[0] * s1; tile[(c4 + 1) * 65 + 32 + lr] = v1[1] * s1; tile[(c4 + 2) * 65 + 32 + lr] = v1[2] * s1; tile[(c4 + 3) * 65 + 32 + lr] = v1[3] * s1;
            __syncthreads();
            const int c = tid >> 3, r8 = (tid & 7) * 8;
            float f[8];
#pragma unroll
            for (int j = 0; j < 8; ++j) f[j] = tile[c * 65 + r8 + j];
            u32x4 w; w.x = cvt_pk_bf16(f[0], f[1]); w.y = cvt_pk_bf16(f[2], f[3]); w.z = cvt_pk_bf16(f[4], f[5]); w.w = cvt_pk_bf16(f[6], f[7]);
            *(u32x4*)(job.dst + (size_t)(job.c0 + c) * job.ldd + job.coff + job.r0 + r8) = w;
            __syncthreads();
            job = nxt; v0 = n0; v1 = n1; s0 = ns0; s1 = ns1;
        }
    }
    for (int e = blockIdx.x * 512 + tid; e < DEPTH * 8 * 128 * 128 / 8; e += G * 512) {
        const int s8 = (e & 15) * 8, t = (e >> 4) & 127;
        const f32x4 a = *(const f32x4*)(p.w_spatial + (size_t)e * 8), b = *(const f32x4*)(p.w_spatial + (size_t)e * 8 + 4);
        float f[8] = {a[0], a[1], a[2], a[3], b[0], b[1], b[2], b[3]};
#pragma unroll
        for (int j = 0; j < 8; ++j) f[j] = (s8 + j <= t) ? f[j] : 0.f;
        u32x4 w; w.x = cvt_pk_bf16(f[0], f[1]); w.y = cvt_pk_bf16(f[2], f[3]); w.z = cvt_pk_bf16(f[4], f[5]); w.w = cvt_pk_bf16(f[6], f[7]);
        *(u32x4*)((bf16_t*)(ws + WS_WSB) + (size_t)e * 8) = w;
    }
    {
        const int wave = tid >> 6, lane = tid & 63;
        bf16_t* xbf = (bf16_t*)(ws + WS_XBF); float* ssqx = (float*)(ws + WS_SSQX);
        for (int row = (blockIdx.x * 8 + wave) * 2; row < MTOT; row += G * 16) {
            f32x4 v[2][4];
#pragma unroll
            for (int r = 0; r < 2; ++r)
#pragma unroll
                for (int i = 0; i < 4; ++i) v[r][i] = *(const f32x4*)(p.x + (size_t)(row + r) * DM + i * 256 + lane * 4);
#pragma unroll
            for (int r = 0; r < 2; ++r) {
                float sq = 0.f;
#pragma unroll
                for (int i = 0; i < 4; ++i) {
                    sq += (v[r][i][0] * v[r][i][0] + v[r][i][1] * v[r][i][1]) + (v[r][i][2] * v[r][i][2] + v[r][i][3] * v[r][i][3]);
                    u32x2 w; w.x = cvt_pk_bf16(v[r][i][0], v[r][i][1]); w.y = cvt_pk_bf16(v[r][i][2], v[r][i][3]);
                    *(u32x2*)(xbf + (size_t)(row + r) * DM + i * 256 + lane * 4) = w;
                }
#pragma unroll
                for (int d = 1; d < 64; d <<= 1) sq += shfl_idx_(sq, lane ^ d);
                if (lane < 16) ssqx[(size_t)(row + r) * 16 + lane] = (lane == 0) ? sq : 0.f;
            }
        }
    }
    for (int e = blockIdx.x * 512 + tid; e < NBITEM * 8; e += G * 512) ((unsigned*)(ws + WS_FLG))[e] = 0u;
}

__device__ __forceinline__ void mixerA_phase(const Params& p, LAS unsigned char* lds, int l_in, int wid_s) {
    int tid_ = wid_s * 64 + lane_id_(); asm volatile("" : "+v"(tid_));
    int l = l_in; asm volatile("" : "+s"(l));
    const int tid = tid_, wid = tid >> 6, lane = tid & 63, fr = lane & 15, fq = lane >> 4;
    const int G = gridDim.x;
    unsigned char* ws = p.ws;
    const bf16_t* gu = (const bf16_t*)(ws + WS_PROJ); const bf16_t* gv = gu + (size_t)MG * DM;
    const float* ssqv = (const float*)(ws + WS_SSQV);
    bf16_t* ybuf = (bf16_t*)(ws + WS_Y);
    LAS bf16_t* sVT = (LAS bf16_t*)lds;
    const int tok = tid >> 2, cl = tid & 3;
    const int c0 = wid * 16;
    const int Ge = G & ~7;
    if ((int)blockIdx.x >= Ge) return;
    const int gi = blockIdx.x & 7;
    const int cch = gi * 128 + c0 + 4 * fq;
    bf16x8 wf[20]; f32x4 vg; float bs[8];
    {
        const bf16_t* wsb = (const bf16_t*)(ws + WS_WSB) + ((size_t)l * 8 + gi) * 16384;
        int n = 0;
#pragma unroll
        for (int i = 0; i < 8; ++i)
#pragma unroll
            for (int ks = 0; ks <= (i >> 1); ++ks) { wf[n] = *(const bf16x8*)(wsb + (16 * i + fr) * 128 + ks * 32 + 8 * fq); ++n; }
        vg = *(const f32x4*)(p.v_norm_g + l * DM + cch);
#pragma unroll
        for (int i = 0; i < 8; ++i) bs[i] = p.b_spatial[((size_t)l * 8 + gi) * 128 + 16 * i + fr];
    }
    u32x4 pv[4]; f32x4 pq[4];
#define A_LOAD(it_) do { const int rb_ = ((it_) >> 3) * 128, gi_ = (it_) & 7; \
        _Pragma("unroll") for (int i_ = 0; i_ < 4; ++i_) { pv[i_] = *(const u32x4*)(gv + (size_t)(rb_ + tok) * DM + gi_ * 128 + (4 * i_ + cl) * 8); pq[i_] = *(const f32x4*)(ssqv + (size_t)(rb_ + tok) * 16 + 4 * i_); } } while (0)
    int it = blockIdx.x;
    if (it < NAITEM) A_LOAD(it);
    for (; it < NAITEM; it += Ge) {
        const int chunk = it >> 3, rowbase = chunk * 128;
        __syncthreads();
        {
            const f32x4 a = pq[0], b = pq[1], c = pq[2], d = pq[3];
            const float ssum = ((a[0] + a[1]) + (a[2] + a[3])) + ((b[0] + b[1]) + (b[2] + b[3])) + ((c[0] + c[1]) + (c[2] + c[3])) + ((d[0] + d[1]) + (d[2] + d[3]));
            const float rs = __builtin_amdgcn_rsqf(ssum * (1.0f / DM) + EPS);
#pragma unroll
            for (int i = 0; i < 4; ++i) {
                const int c8 = 4 * i + cl;
#pragma unroll
                for (int k = 0; k < 4; ++k) {
                    const unsigned pk = cvt_pk_bf16(bf_lo(pv[i][k]) * rs, bf_hi(pv[i][k]) * rs);
                    sVT[(c8 * 8 + 2 * k) * 136 + tok] = (bf16_t)(pk & 0xffffu);
                    sVT[(c8 * 8 + 2 * k + 1) * 136 + tok] = (bf16_t)(pk >> 16);
                }
            }
        }
        __syncthreads();
        if (it + Ge < NAITEM) A_LOAD(it + Ge);
        u32x2 uu[8];
#pragma unroll
        for (int i = 0; i < 8; ++i) uu[i] = *(const u32x2*)(gu + (size_t)(rowbase + 16 * i + fr) * DM + cch);
        bf16x8 vf[4];
#pragma unroll
        for (int ks = 0; ks < 4; ++ks) vf[ks] = *(const LAS bf16x8*)(sVT + (c0 + fr) * 136 + ks * 32 + 8 * fq);
        int n = 0;
#pragma unroll
        for (int i = 0; i < 8; ++i) {
            f32x4 acc = (f32x4){0.f, 0.f, 0.f, 0.f};
#pragma unroll
            for (int ks = 0; ks <= (i >> 1); ++ks) { acc = __builtin_amdgcn_mfma_f32_16x16x32_bf16(vf[ks], wf[n], acc, 0, 0, 0); ++n; }
            const int t = 16 * i + fr;
            const float y0 = bf_lo(uu[i].x) * (vg[0] * acc[0] + bs[i]), y1 = bf_hi(uu[i].x) * (vg[1] * acc[1] + bs[i]);
            const float y2 = bf_lo(uu[i].y) * (vg[2] * acc[2] + bs[i]), y3 = bf_hi(uu[i].y) * (vg[3] * acc[3] + bs[i]);
            u32x2 o; o.x = cvt_pk_bf16(y0, y1); o.y = cvt_pk_bf16(y2, y3);
            *(u32x2*)(ybuf + (size_t)(rowbase + t) * 2048 + cch) = o;
        }
    }
#undef A_LOAD
}

#define DPP_SHR(v, ident, d) __uint_as_float((unsigned)__builtin_amdgcn_update_dpp((int)__float_as_uint(ident), (int)__float_as_uint(v), 0x110 + (d), 0xf, 0xf, false))

constexpr int LSB = 256, NSB = SEQ / LSB, XB_OFF1 = LSB * 136 * 2, CW_OFF = 2 * XB_OFF1, AGG_OFF = CW_OFF + 2560, XBAR_LDS_OFF = AGG_OFF + 1024;
__device__ __forceinline__ void mixerB_phase(const Params& p, LAS unsigned char* lds, int l_in, int wid_s) {
    int tid_ = wid_s * 64 + lane_id_(); asm volatile("" : "+v"(tid_));
    int l = l_in; asm volatile("" : "+s"(l));
    const int tid = tid_, wid = __builtin_amdgcn_readfirstlane(tid >> 6), lane = tid & 63, fr = lane & 15, fq = lane >> 4;
    const int G = gridDim.x;
    unsigned char* ws = p.ws;
    const bf16_t* xb = (const bf16_t*)(ws + WS_PROJ) + (size_t)3 * MG * DM; const bf16_t* zb = (const bf16_t*)(ws + WS_PROJ) + (size_t)4 * MG * DM;
    bf16_t* ybuf = (bf16_t*)(ws + WS_Y);
    LAS float* sCW = (LAS float*)(lds + CW_OFF);
    LAS float* sAgg = (LAS float*)(lds + AGG_OFF);
    const int c8 = (tid & 15) * 8, t8 = (tid >> 4) * 8;
    const int chh = wid & 1, tq = wid >> 1;
    for (int task = blockIdx.x; task < BG * 8 * 4; task += G) {
        const int bh = task & (BG * 8 - 1), cq = task / (BG * 8), bl = bh >> 3, h = bh & 7;
        const int j0 = cq * 32 + chh * 16, chl = h * 128 + j0 + 4 * fq;
        __syncthreads();
        for (int e = tid; e < 640; e += 512) { const int k = e >> 7, c = e & 127; sCW[e] = (k < 4) ? p.conv_w[((size_t)l * 4 + k) * DM + h * 128 + c] : p.conv_b[(size_t)l * DM + h * 128 + c]; }
        bf16x8 wrf[4], wif[4]; f32x4 br, bi, nsp;
        {
            const bf16_t* wr_ = (const bf16_t*)(ws + WS_WRT) + ((size_t)l * 8 + h) * 16384 + (j0 + fr) * 128 + 8 * fq;
            const bf16_t* wi_ = (const bf16_t*)(ws + WS_WIT) + ((size_t)l * 8 + h) * 16384 + (j0 + fr) * 128 + 8 * fq;
#pragma unroll
            for (int ks = 0; ks < 4; ++ks) { wrf[ks] = *(const bf16x8*)(wr_ + ks * 32); wif[ks] = *(const bf16x8*)(wi_ + ks * 32); }
            br = *(const f32x4*)(p.b_rgate + (size_t)l * DM + chl); bi = *(const f32x4*)(p.b_igate + (size_t)l * DM + chl);
            const f32x4 lam = *(const f32x4*)(p.lru_lambda + (size_t)l * DM + chl);
#pragma unroll
            for (int r = 0; r < 4; ++r) { const float z = -lam[r]; nsp[r] = -8.0f * (fmaxf(z, 0.f) + log1pf(expf(-fabsf(z)))); }
        }
        u32x4 xr[11];
#define XB_LOAD(seg_) do { const int rb_ = bl * SEQ + (seg_) * LSB, ch_ = h * 128 + c8; \
        _Pragma("unroll") for (int r_ = 0; r_ < 11; ++r_) { const int t_ = t8 - 3 + r_; xr[r_] = (u32x4){0u, 0u, 0u, 0u}; \
            if (t_ >= 0 || (seg_) > 0) xr[r_] = *(const u32x4*)(xb + (size_t)(rb_ + t_) * DM + ch_); } } while (0)
        XB_LOAD(0);
        float S[4] = {0.f, 0.f, 0.f, 0.f};
        __syncthreads();
        for (int seg = 0; seg < NSB; ++seg) {
            const int rowbase = bl * SEQ + seg * LSB;
            LAS bf16_t* sXb = (LAS bf16_t*)(lds + (seg & 1) * XB_OFF1);
            {
                f32x2 cw2[5][4];
#pragma unroll
                for (int k = 0; k < 5; ++k) { const f32x4 a = *(const LAS f32x4*)(sCW + k * 128 + c8), b = *(const LAS f32x4*)(sCW + k * 128 + c8 + 4);
                    cw2[k][0] = (f32x2){a[0], a[1]}; cw2[k][1] = (f32x2){a[2], a[3]}; cw2[k][2] = (f32x2){b[0], b[1]}; cw2[k][3] = (f32x2){b[2], b[3]}; }
                f32x2 ur[11][4];
#pragma unroll
                for (int r = 0; r < 3; ++r)
#pragma unroll
                    for (int k = 0; k < 4; ++k) ur[r][k] = (f32x2){bf_lo(xr[r][k]), bf_hi(xr[r][k])};
#pragma unroll
                for (int tt = 0; tt < 8; ++tt) {
#pragma unroll
                    for (int k = 0; k < 4; ++k) ur[tt + 3][k] = (f32x2){bf_lo(xr[tt + 3][k]), bf_hi(xr[tt + 3][k])};
                    f32x2 o2[4];
#pragma unroll
                    for (int k = 0; k < 4; ++k) o2[k] = cw2[4][k] + cw2[0][k] * ur[tt][k] + cw2[1][k] * ur[tt + 1][k] + cw2[2][k] * ur[tt + 2][k] + cw2[3][k] * ur[tt + 3][k];
                    u32x4 w; w.x = cvt_pk_bf16(o2[0].x, o2[0].y); w.y = cvt_pk_bf16(o2[1].x, o2[1].y); w.z = cvt_pk_bf16(o2[2].x, o2[2].y); w.w = cvt_pk_bf16(o2[3].x, o2[3].y);
                    *(LAS u32x4*)(sXb + (t8 + tt) * 136 + c8) = w;
                }
            }
            __syncthreads();
            if (seg + 1 < NSB) XB_LOAD(seg + 1);
            u32x2 zz[4];
#pragma unroll
            for (int tt = 0; tt < 4; ++tt) zz[tt] = *(const u32x2*)(zb + (size_t)(rowbase + 64 * tq + 16 * tt + fr) * DM + chl);
            float Pt[4][4], Ht[4][4];
            float Pc[4] = {1.f, 1.f, 1.f, 1.f}, Hc[4] = {0.f, 0.f, 0.f, 0.f};
#pragma unroll
            for (int tt = 0; tt < 4; ++tt) {
                const int trow = 64 * tq + 16 * tt + fr;
                f32x4 aR = (f32x4){0.f, 0.f, 0.f, 0.f}, aI = (f32x4){0.f, 0.f, 0.f, 0.f};
#pragma unroll
                for (int ks = 0; ks < 4; ++ks) {
                    const bf16x8 xf = *(const LAS bf16x8*)(sXb + trow * 136 + ks * 32 + 8 * fq);
                    aR = __builtin_amdgcn_mfma_f32_16x16x32_bf16(wrf[ks], xf, aR, 0, 0, 0);
                    aI = __builtin_amdgcn_mfma_f32_16x16x32_bf16(wif[ks], xf, aI, 0, 0, 0);
                }
                const u32x2 xcw = *(const LAS u32x2*)(sXb + trow * 136 + j0 + 4 * fq);
                const f32x4 xc = (f32x4){bf_lo(xcw.x), bf_hi(xcw.x), bf_lo(xcw.y), bf_hi(xcw.y)};
                float Av[4], Bw[4];
#pragma unroll
                for (int pp = 0; pp < 2; ++pp) {
                    const f32x2 zr = ((f32x2){aR[2 * pp], aR[2 * pp + 1]} + (f32x2){br[2 * pp], br[2 * pp + 1]}) * -1.4426950409f;
                    const f32x2 zi = ((f32x2){aI[2 * pp], aI[2 * pp + 1]} + (f32x2){bi[2 * pp], bi[2 * pp + 1]}) * -1.4426950409f;
                    f32x2 er, ei; er.x = fast_exp2(zr.x); er.y = fast_exp2(zr.y); ei.x = fast_exp2(zi.x); ei.y = fast_exp2(zi.y);
                    const f32x2 dr = er + 1.0f, di = ei + 1.0f;
                    f32x2 rg, ig; rg.x = fast_rcp(dr.x); rg.y = fast_rcp(dr.y); ig.x = fast_rcp(di.x); ig.y = fast_rcp(di.y);
                    const f32x2 la = (f32x2){nsp[2 * pp], nsp[2 * pp + 1]} * rg;
                    const f32x2 la2 = la * 1.4426950409f;
                    f32x2 a; a.x = fast_exp2(la2.x); a.y = fast_exp2(la2.y);
                    const f32x2 x2 = la * 2.0f;
                    const f32x2 em = x2 * (x2 * (x2 * (x2 * (x2 * (x2 * 0.0013888889f + 0.0083333338f) + 0.041666668f) + 0.16666667f) + 0.5f) + 1.0f);
                    const f32x2 ga = a * a * -1.0f + 1.0f;
                    f32x2 g2; g2.x = (x2.x > -0.25f) ? -em.x : ga.x; g2.y = (x2.y > -0.25f) ? -em.y : ga.y;
                    f32x2 sq; sq.x = __builtin_amdgcn_sqrtf(fmaxf(g2.x, 0.f)); sq.y = __builtin_amdgcn_sqrtf(fmaxf(g2.y, 0.f));
                    const f32x2 bv = sq * (ig * (f32x2){xc[2 * pp], xc[2 * pp + 1]});
                    Av[2 * pp] = a.x; Av[2 * pp + 1] = a.y; Bw[2 * pp] = bv.x; Bw[2 * pp + 1] = bv.y;
                }
#define SCAN_STEP(d) asm volatile("s_nop 1\n" \
                    "v_fmac_f32_dpp %0, %0, %4 row_shr:" #d " row_mask:0xf bank_mask:0xf\n v_fmac_f32_dpp %1, %1, %5 row_shr:" #d " row_mask:0xf bank_mask:0xf\n" \
                    "v_fmac_f32_dpp %2, %2, %6 row_shr:" #d " row_mask:0xf bank_mask:0xf\n v_fmac_f32_dpp %3, %3, %7 row_shr:" #d " row_mask:0xf bank_mask:0xf\n" \
                    "v_mul_f32_dpp %4, %4, %4 row_shr:" #d " row_mask:0xf bank_mask:0xf\n v_mul_f32_dpp %5, %5, %5 row_shr:" #d " row_mask:0xf bank_mask:0xf\n" \
                    "v_mul_f32_dpp %6, %6, %6 row_shr:" #d " row_mask:0xf bank_mask:0xf\n v_mul_f32_dpp %7, %7, %7 row_shr:" #d " row_mask:0xf bank_mask:0xf" \
                    : "+v"(Bw[0]), "+v"(Bw[1]), "+v"(Bw[2]), "+v"(Bw[3]), "+v"(Av[0]), "+v"(Av[1]), "+v"(Av[2]), "+v"(Av[3]))
                SCAN_STEP(1); SCAN_STEP(2); SCAN_STEP(4); SCAN_STEP(8);
#undef SCAN_STEP
#pragma unroll
                for (int r = 0; r < 4; ++r) {
                    const float A = Av[r], Bv = Bw[r];
                    const float P = A * Pc[r], H = A * Hc[r] + Bv;
                    Pt[tt][r] = P; Ht[tt][r] = H;
                    Pc[r] = shfl_idx_(P, lane | 15); Hc[r] = shfl_idx_(H, lane | 15);
                }
            }
            if (fr == 0) {
                LAS float* q = sAgg + ((tq * 2 + chh) * 16 + 4 * fq) * 2;
                *(LAS f32x4*)q = (f32x4){Pc[0], Hc[0], Pc[1], Hc[1]}; *(LAS f32x4*)(q + 4) = (f32x4){Pc[2], Hc[2], Pc[3], Hc[3]};
            }
            __syncthreads();
            float carry[4] = {S[0], S[1], S[2], S[3]};
#pragma unroll
            for (int qd = 0; qd < 4; ++qd) {
                const LAS float* q = sAgg + ((qd * 2 + chh) * 16 + 4 * fq) * 2;
                const f32x4 a0 = *(const LAS f32x4*)q, a1 = *(const LAS f32x4*)(q + 4);
                if (qd == tq) { carry[0] = S[0]; carry[1] = S[1]; carry[2] = S[2]; carry[3] = S[3]; }
                S[0] = a0[0] * S[0] + a0[1]; S[1] = a0[2] * S[1] + a0[3]; S[2] = a1[0] * S[2] + a1[1]; S[3] = a1[2] * S[3] + a1[3];
            }
#pragma unroll
            for (int tt = 0; tt < 4; ++tt) {
                const int t = 64 * tq + 16 * tt + fr;
                const float y0 = (Ht[tt][0] + Pt[tt][0] * carry[0]) * bf_lo(zz[tt].x), y1 = (Ht[tt][1] + Pt[tt][1] * carry[1]) * bf_hi(zz[tt].x);
                const float y2 = (Ht[tt][2] + Pt[tt][2] * carry[2]) * bf_lo(zz[tt].y), y3 = (Ht[tt][3] + Pt[tt][3] * carry[3]) * bf_hi(zz[tt].y);
                u32x2 ov; ov.x = cvt_pk_bf16(y0, y1); ov.y = cvt_pk_bf16(y2, y3);
                *(u32x2*)(ybuf + (size_t)(rowbase + t) * 2048 + 1024 + chl) = ov;
            }
        }
#undef XB_LOAD
    }
}

__device__ void phase_final(const Params& p, int wid_s) {
    int tid_ = wid_s * 64 + lane_id_(); asm volatile("" : "+v"(tid_));
    const int tid = tid_, wave = tid >> 6, lane = tid & 63, G = gridDim.x;
    const float* ssqx = (const float*)(p.ws + WS_SSQX);
    f32x4 gv[4];
#pragma unroll
    for (int i = 0; i < 4; ++i) gv[i] = *(const f32x4*)(p.final_g + i * 256 + lane * 4);
    for (int row = blockIdx.x * 8 + wave; row < MTOT; row += G * 8) {
        float s = (lane < 16) ? ssqx[(size_t)row * 16 + lane] : 0.f;
#pragma unroll
        for (int d = 1; d < 16; d <<= 1) s += shfl_idx_(s, lane ^ d);
        s = shfl_idx_(s, lane & 0);
        const float rstd = __builtin_amdgcn_rsqf(s * (1.0f / DM) + EPS);
        float* xr = p.out + (size_t)row * DM; const bf16_t* xb = (const bf16_t*)(p.ws + WS_XBF) + (size_t)row * DM;
        u32x2 w[4];
#pragma unroll
        for (int i = 0; i < 4; ++i) w[i] = *(const u32x2*)(xb + i * 256 + lane * 4);
#pragma unroll
        for (int i = 0; i < 4; ++i) { f32x4 v = (f32x4){bf_lo(w[i].x), bf_hi(w[i].x), bf_lo(w[i].y), bf_hi(w[i].y)}; v = v * rstd * gv[i]; *(f32x4*)(xr + i * 256 + lane * 4) = v; }
    }
}

#define XB_TMO      128
#define XB_XCNT(j)  (256  + 64 * (j))
#define XB_XSUB(j)  (1280 + 64 * (j))
#define XB_XGEN(j)  (2304 + 64 * (j))
#define XB_TOP      3328
#define XB_TOPGEN   3392
#define XCD_BAR_WORDS 3456
#define XB_SPIN_CAP (1u << 18)
__device__ __forceinline__ unsigned xb_ld(unsigned* p)              { return __hip_atomic_load(p, __ATOMIC_RELAXED, __HIP_MEMORY_SCOPE_AGENT); }
__device__ __forceinline__ unsigned xb_add(unsigned* p, unsigned v) { return __hip_atomic_fetch_add(p, v, __ATOMIC_RELAXED, __HIP_MEMORY_SCOPE_AGENT); }
__device__ __forceinline__ unsigned xb_xcc_id() { return (unsigned)__builtin_amdgcn_s_getreg((3 << 11) | 20) & 0xFu; }
#define XB_SPIN(cond, bar) do { unsigned _sp = 0; while (cond) { __builtin_amdgcn_s_sleep(1); \
    if ((++_sp & 255u) == 0u) { if (xb_ld(&(bar)[XB_TMO])) break; if (_sp > XB_SPIN_CAP) { atomicAdd(&(bar)[XB_TMO], 1u); break; } } } } while (0)
struct XcdBarrier { unsigned* bar; unsigned x; volatile LAS unsigned* st; };
__device__ __forceinline__ XcdBarrier xcd_barrier_post(unsigned* bar, volatile LAS unsigned* st, int wid_s) {
    XcdBarrier b; b.bar = bar; b.x = xb_xcc_id(); b.st = st;
    if (wid_s == 0 && lane_id_() == 0) (void)xb_add(&bar[XB_XCNT(b.x)], 1u);
    return b;
}
__device__ __forceinline__ void xcd_barrier_complete(unsigned* bar, unsigned x, unsigned& nloc, unsigned& nx) {
    const unsigned G = gridDim.x * gridDim.y * gridDim.z;
    unsigned sum, cnt, mine, sp = 0u;
    for (;;) {
        sum = 0u; cnt = 0u; mine = 0u;
#pragma unroll
        for (unsigned j = 0; j < 16; ++j) { const unsigned c = xb_ld(&bar[XB_XCNT(j)]); sum += c; cnt += (c > 0u) ? 1u : 0u; mine = (j == x) ? c : mine; }
        if (sum == G) break;
        __builtin_amdgcn_s_sleep(1);
        if ((++sp & 255u) == 0u) { if (xb_ld(&bar[XB_TMO])) break; if (sp > XB_SPIN_CAP) { atomicAdd(&bar[XB_TMO], 1u); break; } }
    }
    nloc = mine > 0u ? mine : 1u; nx = cnt > 0u ? cnt : 1u;
}
__device__ __forceinline__ void xcd_barrier(const XcdBarrier& b, int wid_s) {
    asm volatile("s_waitcnt vmcnt(0)" ::: "memory");
    __syncthreads();
    if (wid_s == 0 && lane_id_() == 0) {
        unsigned* bar = b.bar;
        __builtin_amdgcn_s_waitcnt(0);
        unsigned nloc = b.st[0], nx = b.st[1];
        if (nloc == 0u) { xcd_barrier_complete(bar, b.x, nloc, nx); b.st[0] = nloc; b.st[1] = nx; }
        const unsigned old = xb_add(&bar[XB_XSUB(b.x)], 1u);
        const unsigned gen = old / nloc;
        if (old + 1u == (gen + 1u) * nloc) {
            __builtin_amdgcn_fence(__ATOMIC_RELEASE, "agent");
            asm volatile("s_waitcnt vmcnt(0)" ::: "memory");
            const unsigned og = xb_add(&bar[XB_TOP], 1u);
            const unsigned tg = og / nx;
            if (og + 1u == (tg + 1u) * nx) xb_add(&bar[XB_TOPGEN], 1u);
            else XB_SPIN(xb_ld(&bar[XB_TOPGEN]) == tg, bar);
            __builtin_amdgcn_fence(__ATOMIC_ACQUIRE, "agent");
            xb_add(&bar[XB_XGEN(b.x)], 1u);
            asm volatile("s_waitcnt vmcnt(0)" ::: "memory");
        } else {
            XB_SPIN(xb_ld(&bar[XB_XGEN(b.x)]) == gen, bar);
            __builtin_amdgcn_fence(__ATOMIC_ACQUIRE, "agent");
            asm volatile("s_waitcnt vmcnt(0)" ::: "memory");
        }
    }
    __syncthreads();
}

__global__ void __launch_bounds__(512, 2) mega_fwd(Params p) {
    extern __shared__ __attribute__((aligned(16))) unsigned char lds_raw[];
    LAS unsigned char* lds = (LAS unsigned char*)lds_raw;
    cg::grid_group grid = cg::this_grid();
    unsigned char* ws = p.ws;
    const int G = gridDim.x;
    const int wid_s = __builtin_amdgcn_readfirstlane((int)threadIdx.x >> 6);
    if (threadIdx.x < 4) ((LAS unsigned*)(lds + XBAR_LDS_OFF))[threadIdx.x] = 0u;
    __syncthreads();
    const XcdBarrier xbar = xcd_barrier_post((unsigned*)(ws + WS_BAR), (volatile LAS unsigned*)(lds + XBAR_LDS_OFF), wid_s);

#ifndef PM
#define PM 0xff
#endif
    if (PM & 1) phase_prep(p, lds, wid_s);
    grid.sync();

    for (int l = 0; l < DEPTH; ++l) {
        for (int grp = 0; grp < NGRP; ++grp) {
            const size_t r0 = (size_t)grp * MG;
            if (PM & 2) {
                pg8::Gemm g{(const bf16_t*)(ws + WS_XBF) + r0 * DM, (const bf16_t*)(ws + WS_WIN) + (size_t)l * NIN * DM, MG, NIN, DM};
                pg8::StaticOrder S; S.init(MG, NIN, G, (int)blockIdx.x);
                Epi1 E{(bf16_t*)(ws + WS_PROJ), (const float*)(ws + WS_SSQX) + r0 * 16, (float*)(ws + WS_SSQV), p.b_merge + (size_t)l * 2 * DM};
                pg8::gemm_phase<Epi1>(lds, g, S, E, wid_s);
#ifdef REPG1
                pg8::gemm_phase<Epi1>(lds, g, S, E, wid_s);
#endif
            }
            xcd_barrier(xbar, wid_s);
            if (PM & 4) {
                const unsigned epoch = (unsigned)(l * NGRP + grp + 1);
#ifndef REPB
#define REPB 1
#define REPA 1
#endif
                for (int rep = 0; rep < REPB; ++rep)
                mixerB_phase(p, lds, l, wid_s);
                for (int rep = 0; rep < REPA; ++rep)
                mixerA_phase(p, lds, l, wid_s);
                __syncthreads();
            }
            xcd_barrier(xbar, wid_s);
            if (PM & 8) {
                pg8::Gemm g{(const bf16_t*)(ws + WS_Y), (const bf16_t*)(ws + WS_WP) + (size_t)l * DM * 2048, MG, DM, 2048};
                pg8::StaticOrder S; S.init(MG, DM, G, (int)blockIdx.x);
                Epi2 E{(const bf16_t*)(ws + WS_PROJ) + (size_t)5 * MG * DM, (const bf16_t*)(ws + WS_PROJ) + (size_t)6 * MG * DM, (bf16_t*)(ws + WS_MB)};
                pg8::gemm_phase<Epi2>(lds, g, S, E, wid_s);
#ifdef REPG2
                pg8::gemm_phase<Epi2>(lds, g, S, E, wid_s);
#endif
            }
            xcd_barrier(xbar, wid_s);
            if (PM & 16) {
                pg8::Gemm g{(const bf16_t*)(ws + WS_MB), (const bf16_t*)(ws + WS_WO) + (size_t)l * DM * DM, MG, DM, DM};
                pg8::StaticOrder S; S.init(MG, DM, G, (int)blockIdx.x);
                Epi3 E{l == 0 ? p.x + r0 * DM : nullptr, nullptr, (bf16_t*)(ws + WS_XBF) + r0 * DM, (float*)(ws + WS_SSQX) + r0 * 16};
                pg8::gemm_phase<Epi3>(lds, g, S, E, wid_s);
            }
            if (NGRP == 1) xcd_barrier(xbar, wid_s);
        }
    }
    xcd_barrier(xbar, wid_s);
    if (PM & 32) phase_final(p, wid_s);
}

extern "C" void kernel_launch(void* const* d_in, const int* in_sizes, int n_in, void* d_out, int out_size, void* d_ws, size_t ws_size, hipStream_t stream) {
    static int grid_blocks = 0;
    if (grid_blocks == 0) {
        if (ws_size < WS_END) { fprintf(stderr, "kernel_launch: workspace too small (%zu < %zu)\n", ws_size, (size_t)WS_END); grid_blocks = -1; return; }
        int dev = 0, cus = 0, per_cu = 0;
        hipGetDevice(&dev);
        hipDeviceGetAttribute(&cus, hipDeviceAttributeMultiprocessorCount, dev);
        hipFuncSetAttribute((const void*)mega_fwd, hipFuncAttributeMaxDynamicSharedMemorySize, LDS_BYTES);
        hipOccupancyMaxActiveBlocksPerMultiprocessor(&per_cu, (const void*)mega_fwd, 512, LDS_BYTES);
        if (per_cu < 1) per_cu = 1;
        grid_blocks = cus * 1;
        fprintf(stderr, "kernel_launch: cus %d per_cu %d grid %d\n", cus, per_cu, grid_blocks);
    }
    if (grid_blocks < 0) return;
    Params p{};
    p.x = (const float*)d_in[0]; p.norm_g = (const float*)d_in[1]; p.w_in = (const float*)d_in[2]; p.b_merge = (const float*)d_in[3]; p.v_norm_g = (const float*)d_in[4];
    p.w_spatial = (const float*)d_in[5]; p.b_spatial = (const float*)d_in[6]; p.conv_w = (const float*)d_in[7]; p.conv_b = (const float*)d_in[8];
    p.w_rgate = (const float*)d_in[9]; p.b_rgate = (const float*)d_in[10]; p.w_igate = (const float*)d_in[11]; p.b_igate = (const float*)d_in[12]; p.lru_lambda = (const float*)d_in[13];
    p.w_proj_a = (const float*)d_in[14]; p.w_proj_b = (const float*)d_in[15]; p.w_out = (const float*)d_in[16]; p.final_g = (const float*)d_in[17];
    p.out = (float*)d_out; p.ws = (unsigned char*)d_ws;
    hipMemsetAsync((unsigned char*)d_ws + WS_BAR, 0, 16384, stream);
    void* args[] = {&p};
    hipError_t e = hipLaunchCooperativeKernel((const void*)mega_fwd, dim3(grid_blocks), dim3(512), args, LDS_BYTES, stream);
    if (e != hipSuccess) fprintf(stderr, "cooperative launch failed: %s (grid %d)\n", hipGetErrorString(e), grid_blocks);
}
```

```cpp
#include <hip/hip_runtime.h>
#include <hip/hip_cooperative_groups.h>
#include <cstdio>
namespace cg = cooperative_groups;

#define LAS __attribute__((address_space(3)))
typedef unsigned short bf16_t;
typedef short bf16x8 __attribute__((ext_vector_type(8)));
typedef float f32x4 __attribute__((ext_vector_type(4)));
typedef unsigned u32x4 __attribute__((ext_vector_type(4)));
typedef unsigned u32x2 __attribute__((ext_vector_type(2)));
typedef float f32x2 __attribute__((ext_vector_type(2)));

constexpr int DM = 1024, NBATCH = 16, SEQ = 4096, MTOT = NBATCH * SEQ, DEPTH = 4, NIN = 7168;
constexpr int NGRP = 2, MG = MTOT / NGRP, BG = NBATCH / NGRP;
constexpr int LSEG = 128, NSEG = SEQ / LSEG;
constexpr int NBITEM = BG * 8 * NSEG, NAITEM = (MG / 128) * 8;
constexpr float EPS = 1e-6f;
constexpr int LDS_BYTES = 142848 + 16;

constexpr size_t WS_WIN = 0;
constexpr size_t WS_WP = WS_WIN + (size_t)DEPTH * NIN * DM * 2;
constexpr size_t WS_WO = WS_WP + (size_t)DEPTH * DM * 2048 * 2;
constexpr size_t WS_WSB = WS_WO + (size_t)DEPTH * DM * DM * 2;
constexpr size_t WS_WRT = WS_WSB + (size_t)DEPTH * 8 * 128 * 128 * 2;
constexpr size_t WS_WIT = WS_WRT + (size_t)DEPTH * 8 * 128 * 128 * 2;
constexpr size_t WS_XBF = WS_WIT + (size_t)DEPTH * 8 * 128 * 128 * 2;
constexpr size_t WS_SSQX = WS_XBF + (size_t)MTOT * DM * 2;
constexpr size_t WS_SSQV = WS_SSQX + (size_t)MTOT * 16 * 4;
constexpr size_t WS_PROJ = WS_SSQV + (size_t)MG * 16 * 4;
constexpr size_t WS_Y = WS_PROJ + (size_t)7 * MG * DM * 2;
constexpr size_t WS_MB = WS_Y + (size_t)MG * 2048 * 2;
constexpr size_t WS_PAY = WS_MB + (size_t)MG * DM * 2;
constexpr size_t WS_PAYP = WS_PAY + (size_t)NBITEM * 8 * 16 * 8;
constexpr size_t WS_FLG = WS_PAYP + (size_t)NBITEM * 8 * 16 * 4;
constexpr size_t WS_BAR = WS_FLG + (size_t)NBITEM * 8 * 4;
constexpr size_t WS_END = WS_BAR + 16384;

struct Params {
    const float* x; const float* norm_g; const float* w_in; const float* b_merge; const float* v_norm_g; const float* w_spatial; const float* b_spatial;
    const float* conv_w; const float* conv_b; const float* w_rgate; const float* b_rgate; const float* w_igate; const float* b_igate; const float* lru_lambda;
    const float* w_proj_a; const float* w_proj_b; const float* w_out; const float* final_g;
    float* out; unsigned char* ws;
};

__device__ __forceinline__ float shfl_idx_(float v, int src_lane) { return __uint_as_float((unsigned)__builtin_amdgcn_ds_bpermute(src_lane << 2, (int)__float_as_uint(v))); }
__device__ __forceinline__ int lane_id_() { return (int)__builtin_amdgcn_mbcnt_hi(~0u, __builtin_amdgcn_mbcnt_lo(~0u, 0u)); }
__device__ __forceinline__ unsigned cvt_pk_bf16(float lo, float hi) { unsigned r; asm volatile("v_cvt_pk_bf16_f32 %0, %1, %2" : "=v"(r) : "v"(lo), "v"(hi)); return r; }
__device__ __forceinline__ float bf_lo(unsigned w) { return __uint_as_float(w << 16); }
__device__ __forceinline__ float bf_hi(unsigned w) { return __uint_as_float(w & 0xffff0000u); }
__device__ __forceinline__ float fast_rcp(float x) { return __builtin_amdgcn_rcpf(x); }
__device__ __forceinline__ float fast_exp2(float x) { return __builtin_amdgcn_exp2f(x); }
__device__ __forceinline__ float sigmoidf_(float x) { return fast_rcp(1.0f + fast_exp2(-1.4426950409f * x)); }

namespace pg8 {
constexpr int BM = 256, BK = 64, HALF = 128, HTB = HALF * BK * 2, STAGE_BYTES = 8 * HTB, NXCD = 8, WGM = 8;
__host__ __device__ __forceinline__ int lds_byte(int r, int c) { const int st = (r >> 4) * 2 + (c >> 5), rr = r & 15, cc = c & 31, ob = rr * 64 + cc * 2; return st * 1024 + (ob ^ (((ob >> 9) & 1) << 5)); }
__host__ __device__ __forceinline__ void stage_rc(int b, int& R, int& C) { const int st = b / 1024, sb = b % 1024, swz = sb ^ (((sb >> 9) & 1) << 5); R = (st >> 1) * 16 + swz / 64; C = (st & 1) * 32 + (swz % 64) / 2; }
__host__ __device__ __forceinline__ int perm32(int rho) { const int n = rho >> 4, i = rho & 15; return 8 * (i >> 2) + 4 * n + (i & 3); }
struct Unit { int pm, pn; };
struct Gemm { const bf16_t* A; const bf16_t* Bt; int M, N, K; };
struct StaticOrder {
    int nM, nN, nwg, G, c;
    __device__ void init(int M, int N, int G_, int c_) { nM = M / BM; nN = N / BM; nwg = nM * nN; G = G_; c = c_; }
    __device__ bool next(int i, Unit& u) const {
        const long L = (long)i * G + c; if (L >= nwg) return false;
        int wgid = (int)L; { const int q = nwg / NXCD, r = nwg % NXCD, xcd = wgid % NXCD, off = wgid / NXCD; wgid = (xcd < r ? xcd * (q + 1) : r * (q + 1) + (xcd - r) * q) + off; }
        const int nig = WGM * nN, gid = wgid / nig, fm = gid * WGM, gsz = (nM - fm) < WGM ? (nM - fm) : WGM;
        u.pm = fm + ((wgid % nig) % gsz); u.pn = (wgid % nig) / gsz; return true;
    }
};
template <class Epi>
__device__ __forceinline__ void gemm_phase(LAS unsigned char* lds, const Gemm g, const StaticOrder& S, const Epi& E, int wid_s) {
    int tid_ = wid_s * 64 + lane_id_(); asm volatile("" : "+v"(tid_));
    const int tid = tid_, wid = __builtin_amdgcn_readfirstlane(tid >> 6), lane = tid & 63, wr = wid >> 2, wc = wid & 3, fr = lane & 15, fq = lane >> 4;
    const int K = g.K, nt = K / BK;
    unsigned voffA[2], voffB[2];
#pragma unroll
    for (int i = 0; i < 2; ++i) { int R, C; stage_rc(tid * 16 + i * 8192, R, C); const int Rb = ((R & ~31) + perm32(R & 31));
        voffA[i] = (unsigned)(R * K + C) * 2u; voffB[i] = (unsigned)(Rb * K + C) * 2u; }
    const size_t kstep = (size_t)(BK * 2);
    const size_t hstep = (size_t)HALF * K * 2;
    const size_t tstep = 2 * hstep;
    const unsigned ldsw = (unsigned)wid * 1024u;
    const int aoff = lds_byte(wr * 64 + fr, fq * 8), boff = lds_byte(wc * 32 + fr, fq * 8);
#define PG8_SA(b, h) (((b) * 2 + (h)) * HTB)
#define PG8_SB(b, h) ((4 + (b) * 2 + (h)) * HTB)
#define PG8_STAGE(bufoff, gbase, voff) do { _Pragma("unroll") for (int _i = 0; _i < 2; ++_i) \
        __builtin_amdgcn_global_load_lds((const unsigned*)((const char*)(gbase) + (voff)[_i]), (LAS unsigned*)(lds + (bufoff) + ldsw + _i * 8192), 16, 0, 0); } while (0)
#define PG8_LDA(dst, b, h) do { _Pragma("unroll") for (int m = 0; m < 4; ++m) _Pragma("unroll") for (int k = 0; k < 2; ++k) dst[m][k] = *(const LAS bf16x8*)(lds + PG8_SA(b, h) + aoff + m * 2048 + k * 1024); } while (0)
#define PG8_LDB(dst, b, h) do { _Pragma("unroll") for (int n = 0; n < 2; ++n) _Pragma("unroll") for (int k = 0; k < 2; ++k) dst[n][k] = *(const LAS bf16x8*)(lds + PG8_SB(b, h) + boff + n * 2048 + k * 1024); } while (0)
#define PG8_MMA(ai, bj, At, Bt) do { __builtin_amdgcn_s_setprio(1); _Pragma("unroll") for (int m = 0; m < 4; ++m) _Pragma("unroll") for (int n = 0; n < 2; ++n) _Pragma("unroll") for (int k = 0; k < 2; ++k) \
        acc[ai][bj][m][n] = __builtin_amdgcn_mfma_f32_16x16x32_bf16(Bt[n][k], At[m][k], acc[ai][bj][m][n], 0, 0, 0); __builtin_amdgcn_s_setprio(0); } while (0)
#define PG8_WAIT_V(n) asm volatile("s_waitcnt vmcnt(" #n ")" ::: "memory")
#define PG8_WAIT_L(n) asm volatile("s_waitcnt lgkmcnt(" #n ")" ::: "memory")
#define PG8_BAR __builtin_amdgcn_s_barrier()
#define PG8_SCHED __builtin_amdgcn_sched_barrier(0)
    Unit cur, nxt; int ui = 0;
    if (!S.next(0, cur)) return;
    float est[8]; int est_pm = -1;
#pragma unroll
    for (int i = 0; i < 8; ++i) est[i] = 0.f;
    f32x4 acc[2][2][4][2];
#pragma unroll
    for (int a = 0; a < 2; ++a)
#pragma unroll
        for (int b = 0; b < 2; ++b)
#pragma unroll
            for (int m = 0; m < 4; ++m)
#pragma unroll
                for (int n = 0; n < 2; ++n) acc[a][b][m][n] = (f32x4){0.f, 0.f, 0.f, 0.f};
    bf16x8 At[4][2], B0[2][2], B1[2][2];
    const char* cA = (const char*)g.A + (size_t)cur.pm * tstep; const char* cB = (const char*)g.Bt + (size_t)cur.pn * tstep;
    PG8_STAGE(PG8_SB(0, 0), cB, voffB); PG8_STAGE(PG8_SB(0, 1), cB + hstep, voffB); PG8_STAGE(PG8_SA(0, 0), cA, voffA); PG8_STAGE(PG8_SA(0, 1), cA + hstep, voffA);
    if (wr == 1) PG8_BAR;
    PG8_WAIT_V(2); PG8_BAR;
    PG8_STAGE(PG8_SB(1, 0), cB + kstep, voffB); PG8_STAGE(PG8_SA(1, 0), cA + kstep, voffA); PG8_STAGE(PG8_SB(1, 1), cB + hstep + kstep, voffB);
    PG8_WAIT_V(6); PG8_BAR;
    for (;;) {
        const bool has_next = S.next(ui + 1, nxt);
        const char* nA = has_next ? (const char*)g.A + (size_t)nxt.pm * tstep : cA; const char* nB = has_next ? (const char*)g.Bt + (size_t)nxt.pn * tstep : cB;
        for (int t = 0; t < nt; t += 2) {
            const bool last = (t == nt - 2);
            const char* a1 = cA + (size_t)(t + 1) * kstep;
            const char* a2 = last ? nA : cA + (size_t)(t + 2) * kstep; const char* b2 = last ? nB : cB + (size_t)(t + 2) * kstep;
            const char* a3 = a2 + kstep; const char* b3 = b2 + kstep;
            if constexpr (Epi::HAS_MID) { if (t == nt / 2) E.mid(acc, cur, wr, wc, fr, fq); }
            PG8_LDB(B0, 0, 0); PG8_LDB(B1, 0, 1); PG8_SCHED; PG8_LDA(At, 0, 0); PG8_STAGE(PG8_SA(1, 1), a1 + hstep, voffA);
            PG8_WAIT_V(8); PG8_WAIT_L(0); PG8_BAR; PG8_MMA(0, 0, At, B0); PG8_MMA(0, 1, At, B1); PG8_BAR; PG8_SCHED;
            PG8_LDA(At, 0, 1); PG8_STAGE(PG8_SB(0, 0), b2, voffB); PG8_STAGE(PG8_SB(0, 1), b2 + hstep, voffB); PG8_STAGE(PG8_SA(0, 0), a2, voffA);
            PG8_WAIT_V(8); PG8_WAIT_L(0); PG8_BAR; PG8_MMA(1, 0, At, B0); PG8_MMA(1, 1, At, B1); PG8_BAR; PG8_SCHED;
            PG8_LDB(B0, 1, 0); PG8_LDB(B1, 1, 1); PG8_SCHED; PG8_LDA(At, 1, 0); PG8_STAGE(PG8_SA(0, 1), a2 + hstep, voffA);
            PG8_WAIT_V(8); PG8_WAIT_L(0); PG8_BAR; PG8_MMA(0, 0, At, B0); PG8_MMA(0, 1, At, B1); PG8_BAR; PG8_SCHED;
            PG8_LDA(At, 1, 1); PG8_STAGE(PG8_SB(1, 0), b3, voffB); PG8_STAGE(PG8_SB(1, 1), b3 + hstep, voffB); PG8_STAGE(PG8_SA(1, 0), a3, voffA);
            PG8_WAIT_V(8); PG8_WAIT_L(0); PG8_BAR; PG8_MMA(1, 0, At, B0); PG8_MMA(1, 1, At, B1); PG8_BAR; PG8_SCHED;
        }
        if (wr == 0) PG8_BAR;
        E(acc, cur, wr, wc, fr, fq, est, est_pm);
        if (!has_next) break;
#pragma unroll
        for (int a = 0; a < 2; ++a)
#pragma unroll
            for (int b = 0; b < 2; ++b)
#pragma unroll
                for (int m = 0; m < 4; ++m)
#pragma unroll
                    for (int n = 0; n < 2; ++n) acc[a][b][m][n] = (f32x4){0.f, 0.f, 0.f, 0.f};
        cur = nxt; cA = nA; cB = nB; ++ui;
        if (wr == 1) PG8_BAR;
    }
    PG8_WAIT_V(0);
    PG8_BAR;
#undef PG8_SA
#undef PG8_SB
#undef PG8_STAGE
#undef PG8_LDA
#undef PG8_LDB
#undef PG8_MMA
#undef PG8_WAIT_V
#undef PG8_WAIT_L
#undef PG8_BAR
#undef PG8_SCHED
}
}

struct Epi1 {
    static constexpr bool HAS_MID = false;
    bf16_t* proj; const float* ssqx; float* ssqv; const float* bm;
    __device__ __forceinline__ void mid(f32x4 (&)[2][2][4][2], const pg8::Unit&, int, int, int, int) const {}
    __device__ __forceinline__ void operator()(const f32x4 (&acc)[2][2][4][2], const pg8::Unit& u, int wr, int wc, int fr, int fq, float (&est)[8], int& est_pm) const {
        const int pn = u.pn; const bool uz = pn < 8, gg = pn >= 20;
        const int seg = uz ? 0 : (pn < 12 ? 1 : (gg ? 5 : (pn >> 2)));
        const int colt = uz ? pn * 128 : (gg ? (pn - 20) * 128 : (pn & 3) * 256);
        bf16_t* base = proj + (size_t)seg * MG * DM;
        const int row0 = u.pm * 256 + wr * 64 + fr, colw = wc * 32 + 8 * fq;
        const float G1c = -2.3022082f, G3c = -2.3022082f * 0.044715f, S1c = -1.4426950409f;
        const float c1_0 = (seg <= 1) ? G1c : S1c, c3_0 = (seg <= 1) ? G3c : 0.f;
        const float c1_1 = (seg == 1) ? G1c : S1c, c3_1 = (seg == 1) ? G3c : 0.f;
        const bool numx = (seg <= 4), raw = (seg == 3);
        float cb[2][8];
#pragma unroll
        for (int bj = 0; bj < 2; ++bj)
#pragma unroll
            for (int j = 0; j < 8; ++j) cb[bj][j] = gg ? -1.4426950409f * bm[bj * DM + colt + colw + j] : 0.f;
        if (u.pm != est_pm) {
            est_pm = u.pm;
            f32x4 pp[2][4];
#pragma unroll
            for (int ai = 0; ai < 2; ++ai)
#pragma unroll
                for (int m = 0; m < 4; ++m) pp[ai][m] = *(const f32x4*)(ssqx + (size_t)(row0 + ai * 128 + m * 16) * 16 + fq * 4);
#pragma unroll
            for (int ai = 0; ai < 2; ++ai)
#pragma unroll
                for (int m = 0; m < 4; ++m) { float s = (pp[ai][m][0] + pp[ai][m][1]) + (pp[ai][m][2] + pp[ai][m][3]); s += shfl_idx_(s, (fq * 16 + fr) ^ 16); s += shfl_idx_(s, (fq * 16 + fr) ^ 32);
                    est[ai * 4 + m] = __builtin_amdgcn_rsqf(s * (1.0f / DM) + EPS); }
        }
#pragma unroll
        for (int ai = 0; ai < 2; ++ai)
#pragma unroll
            for (int m = 0; m < 4; ++m) {
                const int row = row0 + ai * 128 + m * 16;
                const float rstd = est[ai * 4 + m];
                float sq = 0.f;
                float v[2][8];
#pragma unroll
                for (int bj = 0; bj < 2; ++bj) {
                    const float c1 = bj ? c1_1 : c1_0, c3 = bj ? c3_1 : c3_0;
#pragma unroll
                    for (int n = 0; n < 2; ++n)
#pragma unroll
                        for (int j = 0; j < 4; ++j) v[bj][n * 4 + j] = acc[ai][bj][m][n][j] * rstd;
                    if (!raw) {
#pragma unroll
                        for (int j = 0; j < 8; ++j) { const float x = v[bj][j]; const float arg = x * (c1 + c3 * x * x) + cb[bj][j]; const float r = fast_rcp(1.0f + fast_exp2(arg)); v[bj][j] = numx ? x * r : r; }
                    }
                    if (seg == 1) {
#pragma unroll
                        for (int j = 0; j < 8; ++j) sq += v[bj][j] * v[bj][j];
                    }
                }
                if (uz) {
                    u32x4 w; w.x = cvt_pk_bf16(v[0][0] * v[1][0], v[0][1] * v[1][1]); w.y = cvt_pk_bf16(v[0][2] * v[1][2], v[0][3] * v[1][3]);
                    w.z = cvt_pk_bf16(v[0][4] * v[1][4], v[0][5] * v[1][5]); w.w = cvt_pk_bf16(v[0][6] * v[1][6], v[0][7] * v[1][7]);
                    *(u32x4*)(base + (size_t)row * DM + colt + colw) = w;
                } else if (gg) {
                    float q[8];
#pragma unroll
                    for (int j = 0; j < 8; ++j) q[j] = v[0][j] * fast_rcp(fmaxf(v[1][j], 1e-30f));
                    u32x4 w; w.x = cvt_pk_bf16(q[0], q[1]); w.y = cvt_pk_bf16(q[2], q[3]); w.z = cvt_pk_bf16(q[4], q[5]); w.w = cvt_pk_bf16(q[6], q[7]);
                    *(u32x4*)(base + (size_t)row * DM + colt + colw) = w;
                    u32x4 w2; w2.x = cvt_pk_bf16(v[1][0], v[1][1]); w2.y = cvt_pk_bf16(v[1][2], v[1][3]); w2.z = cvt_pk_bf16(v[1][4], v[1][5]); w2.w = cvt_pk_bf16(v[1][6], v[1][7]);
                    *(u32x4*)(base + (size_t)MG * DM + (size_t)row * DM + colt + colw) = w2;
                } else {
#pragma unroll
                    for (int bj = 0; bj < 2; ++bj) {
                        u32x4 w; w.x = cvt_pk_bf16(v[bj][0], v[bj][1]); w.y = cvt_pk_bf16(v[bj][2], v[bj][3]); w.z = cvt_pk_bf16(v[bj][4], v[bj][5]); w.w = cvt_pk_bf16(v[bj][6], v[bj][7]);
                        *(u32x4*)(base + (size_t)row * DM + colt + bj * 128 + colw) = w;
                    }
                }
                if (seg == 1) { sq += shfl_idx_(sq, (fq * 16 + fr) ^ 16); sq += shfl_idx_(sq, (fq * 16 + fr) ^ 32); if (fq == 0) ssqv[(size_t)row * 16 + (pn & 3) * 4 + wc] = sq; }
            }
    }
};
struct Epi2 {
    static constexpr bool HAS_MID = true;
    const bf16_t* sa; const bf16_t* sb; bf16_t* mout;
    __device__ __forceinline__ void mid(f32x4 (&acc)[2][2][4][2], const pg8::Unit& u, int wr, int wc, int fr, int fq) const {
        int row0 = u.pm * 256 + wr * 64 + fr, col0 = u.pn * 256 + wc * 32 + 8 * fq;
        asm volatile("" : "+v"(row0), "+v"(col0));
#pragma unroll
        for (int ai = 0; ai < 2; ++ai) {
            u32x4 av[4][2];
#pragma unroll
            for (int m = 0; m < 4; ++m)
#pragma unroll
                for (int bj = 0; bj < 2; ++bj) av[m][bj] = *(const u32x4*)(sa + (size_t)(row0 + ai * 128 + m * 16) * DM + col0 + bj * 128);
#pragma unroll
            for (int m = 0; m < 4; ++m)
#pragma unroll
                for (int bj = 0; bj < 2; ++bj) {
#pragma unroll
                    for (int q = 0; q < 4; ++q) { acc[ai][bj][m][q >> 1][(q & 1) * 2] *= bf_lo(av[m][bj][q]); acc[ai][bj][m][q >> 1][(q & 1) * 2 + 1] *= bf_hi(av[m][bj][q]); }
                }
            asm volatile("" ::: "memory");
        }
    }
    __device__ __forceinline__ void operator()(const f32x4 (&acc)[2][2][4][2], const pg8::Unit& u, int wr, int wc, int fr, int fq, float (&)[8], int&) const {
        const int row0 = u.pm * 256 + wr * 64 + fr, col0 = u.pn * 256 + wc * 32 + 8 * fq;
        u32x4 bv[2][4][2];
#pragma unroll
        for (int ai = 0; ai < 2; ++ai)
#pragma unroll
            for (int m = 0; m < 4; ++m)
#pragma unroll
                for (int bj = 0; bj < 2; ++bj) bv[ai][m][bj] = *(const u32x4*)(sb + (size_t)(row0 + ai * 128 + m * 16) * DM + col0 + bj * 128);
#pragma unroll
        for (int ai = 0; ai < 2; ++ai)
#pragma unroll
            for (int m = 0; m < 4; ++m)
#pragma unroll
                for (int bj = 0; bj < 2; ++bj) {
                    const size_t off = (size_t)(row0 + ai * 128 + m * 16) * DM + col0 + bj * 128;
                    const u32x4 b = bv[ai][m][bj];
                    u32x4 w;
#pragma unroll
                    for (int q = 0; q < 4; ++q) w[q] = cvt_pk_bf16(acc[ai][bj][m][q >> 1][(q & 1) * 2] * bf_lo(b[q]), acc[ai][bj][m][q >> 1][(q & 1) * 2 + 1] * bf_hi(b[q]));
                    *(u32x4*)(mout + off) = w;
                }
    }
};
struct Epi3 {
    static constexpr bool HAS_MID = false;
    const float* xin_f; float* xout_f; bf16_t* xbf; float* ssqx;
    __device__ __forceinline__ void mid(f32x4 (&)[2][2][4][2], const pg8::Unit&, int, int, int, int) const {}
    __device__ __forceinline__ void operator()(const f32x4 (&acc)[2][2][4][2], const pg8::Unit& u, int wr, int wc, int fr, int fq, float (&)[8], int&) const {
        const int row0 = u.pm * 256 + wr * 64 + fr, col0 = u.pn * 256 + wc * 32 + 8 * fq;
#pragma unroll
        for (int ai = 0; ai < 2; ++ai) {
            f32x4 xv[4][2][2];
            if (xin_f) {
#pragma unroll
                for (int m = 0; m < 4; ++m)
#pragma unroll
                    for (int bj = 0; bj < 2; ++bj) { const size_t off = (size_t)(row0 + ai * 128 + m * 16) * DM + col0 + bj * 128; xv[m][bj][0] = *(const f32x4*)(xin_f + off); xv[m][bj][1] = *(const f32x4*)(xin_f + off + 4); }
            } else {
                u32x4 xb_[4][2];
#pragma unroll
                for (int m = 0; m < 4; ++m)
#pragma unroll
                    for (int bj = 0; bj < 2; ++bj) xb_[m][bj] = *(const u32x4*)(xbf + (size_t)(row0 + ai * 128 + m * 16) * DM + col0 + bj * 128);
#pragma unroll
                for (int m = 0; m < 4; ++m)
#pragma unroll
                    for (int bj = 0; bj < 2; ++bj) { const u32x4 w = xb_[m][bj];
                        xv[m][bj][0] = (f32x4){bf_lo(w.x), bf_hi(w.x), bf_lo(w.y), bf_hi(w.y)}; xv[m][bj][1] = (f32x4){bf_lo(w.z), bf_hi(w.z), bf_lo(w.w), bf_hi(w.w)}; }
            }
#pragma unroll
            for (int m = 0; m < 4; ++m) {
                const int row = row0 + ai * 128 + m * 16; float sq = 0.f;
#pragma unroll
                for (int bj = 0; bj < 2; ++bj) {
                    const size_t off = (size_t)row * DM + col0 + bj * 128;
                    const f32x4 x0 = xv[m][bj][0] + acc[ai][bj][m][0], x1 = xv[m][bj][1] + acc[ai][bj][m][1];
                    sq += (x0[0] * x0[0] + x0[1] * x0[1]) + (x0[2] * x0[2] + x0[3] * x0[3]) + (x1[0] * x1[0] + x1[1] * x1[1]) + (x1[2] * x1[2] + x1[3] * x1[3]);
                    if (xout_f) { *(f32x4*)(xout_f + off) = x0; *(f32x4*)(xout_f + off + 4) = x1; }
                    else { u32x4 w; w.x = cvt_pk_bf16(x0[0], x0[1]); w.y = cvt_pk_bf16(x0[2], x0[3]); w.z = cvt_pk_bf16(x1[0], x1[1]); w.w = cvt_pk_bf16(x1[2], x1[3]); *(u32x4*)(xbf + off) = w; }
                }
                sq += shfl_idx_(sq, (fq * 16 + fr) ^ 16); sq += shfl_idx_(sq, (fq * 16 + fr) ^ 32);
                if (fq == 0) ssqx[(size_t)row * 16 + u.pn * 4 + wc] = sq;
            }
            asm volatile("" ::: "memory");
        }
    }
};

struct TrJob { const float* src; const float* scale; bf16_t* dst; int C, ldd, coff, r0, c0; };
__device__ __forceinline__ TrJob tr_decode(const Params& p, int t) {
    unsigned char* ws = p.ws;
    const int l = t / 2624; int q = t % 2624; TrJob j;
    if (q < 1792) { j.src = p.w_in + (size_t)l * DM * NIN; j.C = NIN; j.scale = p.norm_g + l * DM; j.ldd = DM; j.coff = 0; j.r0 = (q / 112) * 64; j.c0 = (q % 112) * 64;
        const int n = j.c0; int d0 = n;
        if (n < 1024) d0 = (n >> 7) * 256 + (n & 127); else if (n < 2048) d0 = 2048 + (n - 1024); else if (n < 3072) d0 = ((n - 2048) >> 7) * 256 + 128 + ((n - 2048) & 127);
        else if (n >= 6144) d0 = 5120 + ((n - 6144) >> 7) * 256 + 128 + ((n - 6144) & 127); else if (n >= 5120) d0 = 5120 + ((n - 5120) >> 7) * 256 + ((n - 5120) & 127);
        j.dst = (bf16_t*)(ws + WS_WIN) + (size_t)l * NIN * DM + (ptrdiff_t)(d0 - j.c0) * DM; return j; }
    q -= 1792; j.scale = nullptr;
    if (q < 256) { j.src = p.w_proj_a + (size_t)l * DM * DM; j.C = DM; j.dst = (bf16_t*)(ws + WS_WP) + (size_t)l * DM * 2048; j.ldd = 2048; j.coff = 0; j.r0 = (q / 16) * 64; j.c0 = (q % 16) * 64; return j; }
    q -= 256;
    if (q < 256) { j.src = p.w_proj_b + (size_t)l * DM * DM; j.C = DM; j.dst = (bf16_t*)(ws + WS_WP) + (size_t)l * DM * 2048; j.ldd = 2048; j.coff = 1024; j.r0 = (q / 16) * 64; j.c0 = (q % 16) * 64; return j; }
    q -= 256;
    if (q < 256) { j.src = p.w_out + (size_t)l * DM * DM; j.C = DM; j.dst = (bf16_t*)(ws + WS_WO) + (size_t)l * DM * DM; j.ldd = DM; j.coff = 0; j.r0 = (q / 16) * 64; j.c0 = (q % 16) * 64; return j; }
    q -= 256;
    const bool ig = q >= 32; if (ig) q -= 32;
    const int h = q >> 2, tt = q & 3;
    j.src = (ig ? p.w_igate : p.w_rgate) + ((size_t)l * 8 + h) * 16384; j.C = 128; j.dst = (bf16_t*)(ws + (ig ? WS_WIT : WS_WRT)) + ((size_t)l * 8 + h) * 16384; j.ldd = 128; j.coff = 0; j.r0 = (tt >> 1) * 64; j.c0 = (tt & 1) * 64;
    return j;
}

__device__ void phase_prep(const Params& p, LAS unsigned char* lds, int wid_s) {
    int tid_ = wid_s * 64 + lane_id_(); asm volatile("" : "+v"(tid_));
    const int tid = tid_, G = gridDim.x;
    unsigned char* ws = p.ws;
    LAS float* tile = (LAS float*)lds;
    {
        const int NT = DEPTH * 2624;
        const int lr = tid >> 4, c4 = (tid & 15) * 4;
        int t = blockIdx.x;
        TrJob job; f32x4 v0, v1; float s0 = 1.f, s1 = 1.f;
        if (t < NT) { job = tr_decode(p, t);
            v0 = *(const f32x4*)(job.src + (size_t)(job.r0 + lr) * job.C + job.c0 + c4); v1 = *(const f32x4*)(job.src + (size_t)(job.r0 + 32 + lr) * job.C + job.c0 + c4);
            if (job.scale) { s0 = job.scale[job.r0 + lr]; s1 = job.scale[job.r0 + 32 + lr]; } }
        for (; t < NT; t += G) {
            TrJob nxt = job; f32x4 n0 = v0, n1 = v1; float ns0 = 1.f, ns1 = 1.f;
            if (t + G < NT) { nxt = tr_decode(p, t + G);
                n0 = *(const f32x4*)(nxt.src + (size_t)(nxt.r0 + lr) * nxt.C + nxt.c0 + c4); n1 = *(const f32x4*)(nxt.src + (size_t)(nxt.r0 + 32 + lr) * nxt.C + nxt.c0 + c4);
                if (nxt.scale) { ns0 = nxt.scale[nxt.r0 + lr]; ns1 = nxt.scale[nxt.r0 + 32 + lr]; } }
            tile[(c4 + 0) * 65 + lr] = v0[0] * s0; tile[(c4 + 1) * 65 + lr] = v0[1] * s0; tile[(c4 + 2) * 65 + lr] = v0[2] * s0; tile[(c4 + 3) * 65 + lr] = v0[3] * s0;
            tile[(c4 + 0) * 65 + 32 + lr] = v1[0] * s1; tile[(c4 + 1) * 65 + 32 + lr] = v1[1] * s1; tile[(c4 + 2) * 65 + 32 + lr] = v1[2] * s1; tile[(c4 + 3) * 65 + 32 + lr] = v1[3] * s1;
            __syncthreads();
            const int c = tid >> 3, r8 = (tid & 7) * 8;
            float f[8];
#pragma unroll
            for (int j = 0; j < 8; ++j) f[j] = tile[c * 65 + r8 + j];
            u32x4 w; w.x = cvt_pk_bf16(f[0], f[1]); w.y = cvt_pk_bf16(f[2], f[3]); w.z = cvt_pk_bf16(f[4], f[5]); w.w = cvt_pk_bf16(f[6], f[7]);
            *(u32x4*)(job.dst + (size_t)(job.c0 + c) * job.ldd + job.coff + job.r0 + r8) = w;
            __syncthreads();
            job = nxt; v0 = n0; v1 = n1; s0 = ns0; s1 = ns1;
        }
    }
    for (int e = blockIdx.x * 512 + tid; e < DEPTH * 8 * 128 * 128 / 8; e += G * 512) {
        const int s8 = (e & 15) * 8, t = (e >> 4) & 127;
        const f32x4 a = *(const f32x4*)(p.w_spatial + (size_t)e * 8), b = *(const f32x4*)(p.w_spatial + (size_t)e * 8 + 4);
        float f[8] = {a[0], a[1], a[2], a[3], b[0], b[1], b[2], b[3]};
#pragma unroll
        for (int j = 0; j < 8; ++j) f[j] = (s8 + j <= t) ? f[j] : 0.f;
        u32x4 w; w.x = cvt_pk_bf16(f[0], f[1]); w.y = cvt_pk_bf16(f[2], f[3]); w.z = cvt_pk_bf16(f[4], f[5]); w.w = cvt_pk_bf16(f[6], f[7]);
        *(u32x4*)((bf16_t*)(ws + WS_WSB) + (size_t)e * 8) = w;
    }
    {
        const int wave = tid >> 6, lane = tid & 63;
        bf16_t* xbf = (bf16_t*)(ws + WS_XBF); float* ssqx = (float*)(ws + WS_SSQX);
        for (int row = (blockIdx.x * 8 + wave) * 2; row < MTOT; row += G * 16) {
            f32x4 v[2][4];
#pragma unroll
            for (int r = 0; r < 2; ++r)
#pragma unroll
                for (int i = 0; i < 4; ++i) v[r][i] = *(const f32x4*)(p.x + (size_t)(row + r) * DM + i * 256 + lane * 4);
#pragma unroll
            for (int r = 0; r < 2; ++r) {
                float sq = 0.f;
#pragma unroll
                for (int i = 0; i < 4; ++i) {
                    sq += (v[r][i][0] * v[r][i][0] + v[r][i][1] * v[r][i][1]) + (v[r][i][2] * v[r][i][2] + v[r][i][3] * v[r][i][3]);
                    u32x2 w; w.x = cvt_pk_bf16(v[r][i][0], v[r][i][1]); w.y = cvt_pk_bf16(v[r][i][2], v[r][i][3]);
                    *(u32x2*)(xbf + (size_t)(row + r) * DM + i * 256 + lane * 4) = w;
                }
#pragma unroll
                for (int d = 1; d < 64; d <<= 1) sq += shfl_idx_(sq, lane ^ d);
                if (lane < 16) ssqx[(size_t)(row + r) * 16 + lane] = (lane == 0) ? sq : 0.f;
            }
        }
    }
    for (int e = blockIdx.x * 512 + tid; e < NBITEM * 8; e += G * 512) ((unsigned*)(ws + WS_FLG))[e] = 0u;
}

__device__ __forceinline__ void mixerA_phase(const Params& p, LAS unsigned char* lds, int l_in, int wid_s) {
    int tid_ = wid_s * 64 + lane_id_(); asm volatile("" : "+v"(tid_));
    int l = l_in; asm volatile("" : "+s"(l));
    const int tid = tid_, wid = tid >> 6, lane = tid & 63, fr = lane & 15, fq = lane >> 4;
    const int G = gridDim.x;
    unsigned char* ws = p.ws;
    const bf16_t* gu = (const bf16_t*)(ws + WS_PROJ); const bf16_t* gv = gu + (size_t)MG * DM;
    const float* ssqv = (const float*)(ws + WS_SSQV);
    bf16_t* ybuf = (bf16_t*)(ws + WS_Y);
    LAS bf16_t* sVT = (LAS bf16_t*)lds;
    const int tok = tid >> 2, cl = tid & 3;
    const int c0 = wid * 16;
    const int Ge = G & ~7;
    if ((int)blockIdx.x >= Ge) return;
    const int gi = blockIdx.x & 7;
    const int cch = gi * 128 + c0 + 4 * fq;
    bf16x8 wf[20]; f32x4 vg; float bs[8];
    {
        const bf16_t* wsb = (const bf16_t*)(ws + WS_WSB) + ((size_t)l * 8 + gi) * 16384;
        int n = 0;
#pragma unroll
        for (int i = 0; i < 8; ++i)
#pragma unroll
            for (int ks = 0; ks <= (i >> 1); ++ks) { wf[n] = *(const bf16x8*)(wsb + (16 * i + fr) * 128 + ks * 32 + 8 * fq); ++n; }
        vg = *(const f32x4*)(p.v_norm_g + l * DM + cch);
#pragma unroll
        for (int i = 0; i < 8; ++i) bs[i] = p.b_spatial[((size_t)l * 8 + gi) * 128 + 16 * i + fr];
    }
    u32x4 pv[4]; f32x4 pq[4];
#define A_LOAD(it_) do { const int rb_ = ((it_) >> 3) * 128, gi_ = (it_) & 7; \
        _Pragma("unroll") for (int i_ = 0; i_ < 4; ++i_) { pv[i_] = *(const u32x4*)(gv + (size_t)(rb_ + tok) * DM + gi_ * 128 + (4 * i_ + cl) * 8); pq[i_] = *(const f32x4*)(ssqv + (size_t)(rb_ + tok) * 16 + 4 * i_); } } while (0)
    int it = blockIdx.x;
    if (it < NAITEM) A_LOAD(it);
    for (; it < NAITEM; it += Ge) {
        const int chunk = it >> 3, rowbase = chunk * 128;
        u32x2 uu[8];
#pragma unroll
        for (int i = 0; i < 8; ++i) uu[i] = *(const u32x2*)(gu + (size_t)(rowbase + 16 * i + fr) * DM + cch);
        __syncthreads();
        {
            const f32x4 a = pq[0], b = pq[1], c = pq[2], d = pq[3];
            const float ssum = ((a[0] + a[1]) + (a[2] + a[3])) + ((b[0] + b[1]) + (b[2] + b[3])) + ((c[0] + c[1]) + (c[2] + c[3])) + ((d[0] + d[1]) + (d[2] + d[3]));
            const float rs = __builtin_amdgcn_rsqf(ssum * (1.0f / DM) + EPS);
#pragma unroll
            for (int i = 0; i < 4; ++i) {
                const int c8 = 4 * i + cl;
#pragma unroll
                for (int k = 0; k < 4; ++k) {
                    const unsigned pk = cvt_pk_bf16(bf_lo(pv[i][k]) * rs, bf_hi(pv[i][k]) * rs);
                    sVT[(c8 * 8 + 2 * k) * 136 + tok] = (bf16_t)(pk & 0xffffu);
                    sVT[(c8 * 8 + 2 * k + 1) * 136 + tok] = (bf16_t)(pk >> 16);
                }
            }
        }
        __syncthreads();
        if (it + Ge < NAITEM) A_LOAD(it + Ge);
        bf16x8 vf[4];
#pragma unroll
        for (int ks = 0; ks < 4; ++ks) vf[ks] = *(const LAS bf16x8*)(sVT + (c0 + fr) * 136 + ks * 32 + 8 * fq);
        int n = 0;
#pragma unroll
        for (int i = 0; i < 8; ++i) {
            f32x4 acc = (f32x4){0.f, 0.f, 0.f, 0.f};
#pragma unroll
            for (int ks = 0; ks <= (i >> 1); ++ks) { acc = __builtin_amdgcn_mfma_f32_16x16x32_bf16(vf[ks], wf[n], acc, 0, 0, 0); ++n; }
            const int t = 16 * i + fr;
            const float y0 = bf_lo(uu[i].x) * (vg[0] * acc[0] + bs[i]), y1 = bf_hi(uu[i].x) * (vg[1] * acc[1] + bs[i]);
            const float y2 = bf_lo(uu[i].y) * (vg[2] * acc[2] + bs[i]), y3 = bf_hi(uu[i].y) * (vg[3] * acc[3] + bs[i]);
            u32x2 o; o.x = cvt_pk_bf16(y0, y1); o.y = cvt_pk_bf16(y2, y3);
            *(u32x2*)(ybuf + (size_t)(rowbase + t) * 2048 + cch) = o;
        }
    }
#undef A_LOAD
}

#define DPP_SHR(v, ident, d) __uint_as_float((unsigned)__builtin_amdgcn_update_dpp((int)__float_as_uint(ident), (int)__float_as_uint(v), 0x110 + (d), 0xf, 0xf, false))

constexpr int LSB = 256, NSB = SEQ / LSB, XB_OFF1 = LSB * 136 * 2, CW_OFF = 2 * XB_OFF1, AGG_OFF = CW_OFF + 2560, XBAR_LDS_OFF = AGG_OFF + 1024;
__device__ __forceinline__ void mixerB_phase(const Params& p, LAS unsigned char* lds, int l_in, int wid_s) {
    int tid_ = wid_s * 64 + lane_id_(); asm volatile("" : "+v"(tid_));
    int l = l_in; asm volatile("" : "+s"(l));
    const int tid = tid_, wid = __builtin_amdgcn_readfirstlane(tid >> 6), lane = tid & 63, fr = lane & 15, fq = lane >> 4;
    const int G = gridDim.x;
    unsigned char* ws = p.ws;
    const bf16_t* xb = (const bf16_t*)(ws + WS_PROJ) + (size_t)3 * MG * DM; const bf16_t* zb = (const bf16_t*)(ws + WS_PROJ) + (size_t)4 * MG * DM;
    bf16_t* ybuf = (bf16_t*)(ws + WS_Y);
    LAS float* sCW = (LAS float*)(lds + CW_OFF);
    LAS float* sAgg = (LAS float*)(lds + AGG_OFF);
    const int c8 = (tid & 15) * 8, t8 = (tid >> 4) * 8;
    const int chh = wid & 1, tq = wid >> 1;
    for (int task = blockIdx.x; task < BG * 8 * 4; task += G) {
        const int bh = task & (BG * 8 - 1), cq = task / (BG * 8), bl = bh >> 3, h = bh & 7;
        const int j0 = cq * 32 + chh * 16, chl = h * 128 + j0 + 4 * fq;
        __syncthreads();
        for (int e = tid; e < 640; e += 512) { const int k = e >> 7, c = e & 127; sCW[e] = (k < 4) ? p.conv_w[((size_t)l * 4 + k) * DM + h * 128 + c] : p.conv_b[(size_t)l * DM + h * 128 + c]; }
        bf16x8 wrf[4], wif[4]; f32x4 br, bi, nsp;
        {
            const bf16_t* wr_ = (const bf16_t*)(ws + WS_WRT) + ((size_t)l * 8 + h) * 16384 + (j0 + fr) * 128 + 8 * fq;
            const bf16_t* wi_ = (const bf16_t*)(ws + WS_WIT) + ((size_t)l * 8 + h) * 16384 + (j0 + fr) * 128 + 8 * fq;
#pragma unroll
            for (int ks = 0; ks < 4; ++ks) { wrf[ks] = *(const bf16x8*)(wr_ + ks * 32); wif[ks] = *(const bf16x8*)(wi_ + ks * 32); }
            br = *(const f32x4*)(p.b_rgate + (size_t)l * DM + chl); bi = *(const f32x4*)(p.b_igate + (size_t)l * DM + chl);
            const f32x4 lam = *(const f32x4*)(p.lru_lambda + (size_t)l * DM + chl);
#pragma unroll
            for (int r = 0; r < 4; ++r) { const float z = -lam[r]; nsp[r] = -8.0f * (fmaxf(z, 0.f) + log1pf(expf(-fabsf(z)))); }
        }
        u32x4 xr[11];
#define XB_LOAD(seg_) do { const int rb_ = bl * SEQ + (seg_) * LSB, ch_ = h * 128 + c8; \
        _Pragma("unroll") for (int r_ = 0; r_ < 11; ++r_) { const int t_ = t8 - 3 + r_; xr[r_] = (u32x4){0u, 0u, 0u, 0u}; \
            if (t_ >= 0 || (seg_) > 0) xr[r_] = *(const u32x4*)(xb + (size_t)(rb_ + t_) * DM + ch_); } } while (0)
        XB_LOAD(0);
        float S[4] = {0.f, 0.f, 0.f, 0.f};
        __syncthreads();
        for (int seg = 0; seg < NSB; ++seg) {
            const int rowbase = bl * SEQ + seg * LSB;
            LAS bf16_t* sXb = (LAS bf16_t*)(lds + (seg & 1) * XB_OFF1);
            {
                f32x2 cw2[5][4];
#pragma unroll
                for (int k = 0; k < 5; ++k) { const f32x4 a = *(const LAS f32x4*)(sCW + k * 128 + c8), b = *(const LAS f32x4*)(sCW + k * 128 + c8 + 4);
                    cw2[k][0] = (f32x2){a[0], a[1]}; cw2[k][1] = (f32x2){a[2], a[3]}; cw2[k][2] = (f32x2){b[0], b[1]}; cw2[k][3] = (f32x2){b[2], b[3]}; }
                f32x2 ur[11][4];
#pragma unroll
                for (int r = 0; r < 3; ++r)
#pragma unroll
                    for (int k = 0; k < 4; ++k) ur[r][k] = (f32x2){bf_lo(xr[r][k]), bf_hi(xr[r][k])};
#pragma unroll
                for (int tt = 0; tt < 8; ++tt) {
#pragma unroll
                    for (int k = 0; k < 4; ++k) ur[tt + 3][k] = (f32x2){bf_lo(xr[tt + 3][k]), bf_hi(xr[tt + 3][k])};
                    f32x2 o2[4];
#pragma unroll
                    for (int k = 0; k < 4; ++k) o2[k] = cw2[4][k] + cw2[0][k] * ur[tt][k] + cw2[1][k] * ur[tt + 1][k] + cw2[2][k] * ur[tt + 2][k] + cw2[3][k] * ur[tt + 3][k];
                    u32x4 w; w.x = cvt_pk_bf16(o2[0].x, o2[0].y); w.y = cvt_pk_bf16(o2[1].x, o2[1].y); w.z = cvt_pk_bf16(o2[2].x, o2[2].y); w.w = cvt_pk_bf16(o2[3].x, o2[3].y);
                    *(LAS u32x4*)(sXb + (t8 + tt) * 136 + c8) = w;
                }
            }
            __syncthreads();
            if (seg + 1 < NSB) XB_LOAD(seg + 1);
            u32x2 zz[4];
#pragma unroll
            for (int tt = 0; tt < 4; ++tt) zz[tt] = *(const u32x2*)(zb + (size_t)(rowbase + 64 * tq + 16 * tt + fr) * DM + chl);
            float Pt[4][4], Ht[4][4];
            float Pc[4] = {1.f, 1.f, 1.f, 1.f}, Hc[4] = {0.f, 0.f, 0.f, 0.f};
#pragma unroll
            for (int tt = 0; tt < 4; ++tt) {
                const int trow = 64 * tq + 16 * tt + fr;
                f32x4 aR = (f32x4){0.f, 0.f, 0.f, 0.f}, aI = (f32x4){0.f, 0.f, 0.f, 0.f};
#pragma unroll
                for (int ks = 0; ks < 4; ++ks) {
                    const bf16x8 xf = *(const LAS bf16x8*)(sXb + trow * 136 + ks * 32 + 8 * fq);
                    aR = __builtin_amdgcn_mfma_f32_16x16x32_bf16(wrf[ks], xf, aR, 0, 0, 0);
                    aI = __builtin_amdgcn_mfma_f32_16x16x32_bf16(wif[ks], xf, aI, 0, 0, 0);
                }
                const u32x2 xcw = *(const LAS u32x2*)(sXb + trow * 136 + j0 + 4 * fq);
                const f32x4 xc = (f32x4){bf_lo(xcw.x), bf_hi(xcw.x), bf_lo(xcw.y), bf_hi(xcw.y)};
                float Av[4], Bw[4];
#pragma unroll
                for (int pp = 0; pp < 2; ++pp) {
                    const f32x2 zr = ((f32x2){aR[2 * pp], aR[2 * pp + 1]} + (f32x2){br[2 * pp], br[2 * pp + 1]}) * -1.4426950409f;
                    const f32x2 zi = ((f32x2){aI[2 * pp], aI[2 * pp + 1]} + (f32x2){bi[2 * pp], bi[2 * pp + 1]}) * -1.4426950409f;
                    f32x2 er, ei; er.x = fast_exp2(zr.x); er.y = fast_exp2(zr.y); ei.x = fast_exp2(zi.x); ei.y = fast_exp2(zi.y);
                    const f32x2 dr = er + 1.0f, di = ei + 1.0f;
                    f32x2 rg, ig; rg.x = fast_rcp(dr.x); rg.y = fast_rcp(dr.y); ig.x = fast_rcp(di.x); ig.y = fast_rcp(di.y);
                    const f32x2 la = (f32x2){nsp[2 * pp], nsp[2 * pp + 1]} * rg;
                    const f32x2 la2 = la * 1.4426950409f;
                    f32x2 a; a.x = fast_exp2(la2.x); a.y = fast_exp2(la2.y);
                    const f32x2 x2 = la * 2.0f;
                    const f32x2 em = x2 * (x2 * (x2 * (x2 * (x2 * (x2 * 0.0013888889f + 0.0083333338f) + 0.041666668f) + 0.16666667f) + 0.5f) + 1.0f);
                    const f32x2 ga = a * a * -1.0f + 1.0f;
                    f32x2 g2; g2.x = (x2.x > -0.25f) ? -em.x : ga.x; g2.y = (x2.y > -0.25f) ? -em.y : ga.y;
                    f32x2 sq; sq.x = __builtin_amdgcn_sqrtf(fmaxf(g2.x, 0.f)); sq.y = __builtin_amdgcn_sqrtf(fmaxf(g2.y, 0.f));
                    const f32x2 bv = sq * (ig * (f32x2){xc[2 * pp], xc[2 * pp + 1]});
                    Av[2 * pp] = a.x; Av[2 * pp + 1] = a.y; Bw[2 * pp] = bv.x; Bw[2 * pp + 1] = bv.y;
                }
#define SCAN_STEP(d) asm volatile("s_nop 1\n" \
                    "v_fmac_f32_dpp %0, %0, %4 row_shr:" #d " row_mask:0xf bank_mask:0xf\n v_fmac_f32_dpp %1, %1, %5 row_shr:" #d " row_mask:0xf bank_mask:0xf\n" \
                    "v_fmac_f32_dpp %2, %2, %6 row_shr:" #d " row_mask:0xf bank_mask:0xf\n v_fmac_f32_dpp %3, %3, %7 row_shr:" #d " row_mask:0xf bank_mask:0xf\n" \
                    "v_mul_f32_dpp %4, %4, %4 row_shr:" #d " row_mask:0xf bank_mask:0xf\n v_mul_f32_dpp %5, %5, %5 row_shr:" #d " row_mask:0xf bank_mask:0xf\n" \
                    "v_mul_f32_dpp %6, %6, %6 row_shr:" #d " row_mask:0xf bank_mask:0xf\n v_mul_f32_dpp %7, %7, %7 row_shr:" #d " row_mask:0xf bank_mask:0xf" \
                    : "+v"(Bw[0]), "+v"(Bw[1]), "+v"(Bw[2]), "+v"(Bw[3]), "+v"(Av[0]), "+v"(Av[1]), "+v"(Av[2]), "+v"(Av[3]))
                SCAN_STEP(1); SCAN_STEP(2); SCAN_STEP(4); SCAN_STEP(8);
#undef SCAN_STEP
#pragma unroll
                for (int r = 0; r < 4; ++r) {
                    const float A = Av[r], Bv = Bw[r];
                    const float P = A * Pc[r], H = A * Hc[r] + Bv;
                    Pt[tt][r] = P; Ht[tt][r] = H;
                    Pc[r] = shfl_idx_(P, lane | 15); Hc[r] = shfl_idx_(H, lane | 15);
                }
            }
            if (fr == 0) {
                LAS float* q = sAgg + ((tq * 2 + chh) * 16 + 4 * fq) * 2;
                *(LAS f32x4*)q = (f32x4){Pc[0], Hc[0], Pc[1], Hc[1]}; *(LAS f32x4*)(q + 4) = (f32x4){Pc[2], Hc[2], Pc[3], Hc[3]};
            }
            __syncthreads();
            float carry[4] = {S[0], S[1], S[2], S[3]};
#pragma unroll
            for (int qd = 0; qd < 4; ++qd) {
                const LAS float* q = sAgg + ((qd * 2 + chh) * 16 + 4 * fq) * 2;
                const f32x4 a0 = *(const LAS f32x4*)q, a1 = *(const LAS f32x4*)(q + 4);
                if (qd == tq) { carry[0] = S[0]; carry[1] = S[1]; carry[2] = S[2]; carry[3] = S[3]; }
                S[0] = a0[0] * S[0] + a0[1]; S[1] = a0[2] * S[1] + a0[3]; S[2] = a1[0] * S[2] + a1[1]; S[3] = a1[2] * S[3] + a1[3];
            }
#pragma unroll
            for (int tt = 0; tt < 4; ++tt) {
                const int t = 64 * tq + 16 * tt + fr;
                const float y0 = (Ht[tt][0] + Pt[tt][0] * carry[0]) * bf_lo(zz[tt].x), y1 = (Ht[tt][1] + Pt[tt][1] * carry[1]) * bf_hi(zz[tt].x);
                const float y2 = (Ht[tt][2] + Pt[tt][2] * carry[2]) * bf_lo(zz[tt].y), y3 = (Ht[tt][3] + Pt[tt][3] * carry[3]) * bf_hi(zz[tt].y);
                u32x2 ov; ov.x = cvt_pk_bf16(y0, y1); ov.y = cvt_pk_bf16(y2, y3);
                *(u32x2*)(ybuf + (size_t)(rowbase + t) * 2048 + 1024 + chl) = ov;
            }
        }
#undef XB_LOAD
    }
}

__device__ void phase_final(const Params& p, int wid_s) {
    int tid_ = wid_s * 64 + lane_id_(); asm volatile("" : "+v"(tid_));
    const int tid = tid_, wave = tid >> 6, lane = tid & 63, G = gridDim.x;
    const float* ssqx = (const float*)(p.ws + WS_SSQX);
    f32x4 gv[4];
#pragma unroll
    for (int i = 0; i < 4; ++i) gv[i] = *(const f32x4*)(p.final_g + i * 256 + lane * 4);
    for (int row = blockIdx.x * 8 + wave; row < MTOT; row += G * 8) {
        float s = (lane < 16) ? ssqx[(size_t)row * 16 + lane] : 0.f;
#pragma unroll
        for (int d = 1; d < 16; d <<= 1) s += shfl_idx_(s, lane ^ d);
        s = shfl_idx_(s, lane & 0);
        const float rstd = __builtin_amdgcn_rsqf(s * (1.0f / DM) + EPS);
        float* xr = p.out + (size_t)row * DM; const bf16_t* xb = (const bf16_t*)(p.ws + WS_XBF) + (size_t)row * DM;
        u32x2 w[4];
#pragma unroll
        for (int i = 0; i < 4; ++i) w[i] = *(const u32x2*)(xb + i * 256 + lane * 4);
#pragma unroll
        for (int i = 0; i < 4; ++i) { f32x4 v = (f32x4){bf_lo(w[i].x), bf_hi(w[i].x), bf_lo(w[i].y), bf_hi(w[i].y)}; v = v * rstd * gv[i]; *(f32x4*)(xr + i * 256 + lane * 4) = v; }
    }
}

#define XB_TMO      128
#define XB_XCNT(j)  (256  + 64 * (j))
#define XB_XSUB(j)  (1280 + 64 * (j))
#define XB_XGEN(j)  (2304 + 64 * (j))
#define XB_TOP      3328
#define XB_TOPGEN   3392
#define XCD_BAR_WORDS 3456
#define XB_SPIN_CAP (1u << 18)
__device__ __forceinline__ unsigned xb_ld(unsigned* p)              { return __hip_atomic_load(p, __ATOMIC_RELAXED, __HIP_MEMORY_SCOPE_AGENT); }
__device__ __forceinline__ unsigned xb_add(unsigned* p, unsigned v) { return __hip_atomic_fetch_add(p, v, __ATOMIC_RELAXED, __HIP_MEMORY_SCOPE_AGENT); }
__device__ __forceinline__ unsigned xb_xcc_id() { return (unsigned)__builtin_amdgcn_s_getreg((3 << 11) | 20) & 0xFu; }
#define XB_SPIN(cond, bar) do { unsigned _sp = 0; while (cond) { __builtin_amdgcn_s_sleep(1); \
    if ((++_sp & 255u) == 0u) { if (xb_ld(&(bar)[XB_TMO])) break; if (_sp > XB_SPIN_CAP) { atomicAdd(&(bar)[XB_TMO], 1u); break; } } } } while (0)
struct XcdBarrier { unsigned* bar; unsigned x; volatile LAS unsigned* st; };
__device__ __forceinline__ XcdBarrier xcd_barrier_post(unsigned* bar, volatile LAS unsigned* st, int wid_s) {
    XcdBarrier b; b.bar = bar; b.x = xb_xcc_id(); b.st = st;
    if (wid_s == 0 && lane_id_() == 0) (void)xb_add(&bar[XB_XCNT(b.x)], 1u);
    return b;
}
__device__ __forceinline__ void xcd_barrier_complete(unsigned* bar, unsigned x, unsigned& nloc, unsigned& nx) {
    const unsigned G = gridDim.x * gridDim.y * gridDim.z;
    unsigned sum, cnt, mine, sp = 0u;
    for (;;) {
        sum = 0u; cnt = 0u; mine = 0u;
#pragma unroll
        for (unsigned j = 0; j < 16; ++j) { const unsigned c = xb_ld(&bar[XB_XCNT(j)]); sum += c; cnt += (c > 0u) ? 1u : 0u; mine = (j == x) ? c : mine; }
        if (sum == G) break;
        __builtin_amdgcn_s_sleep(1);
        if ((++sp & 255u) == 0u) { if (xb_ld(&bar[XB_TMO])) break; if (sp > XB_SPIN_CAP) { atomicAdd(&bar[XB_TMO], 1u); break; } }
    }
    nloc = mine > 0u ? mine : 1u; nx = cnt > 0u ? cnt : 1u;
}
__device__ __forceinline__ void xcd_barrier(const XcdBarrier& b, int wid_s) {
    asm volatile("s_waitcnt vmcnt(0)" ::: "memory");
    __syncthreads();
    if (wid_s == 0 && lane_id_() == 0) {
        unsigned* bar = b.bar;
        __builtin_amdgcn_s_waitcnt(0);
        unsigned nloc = b.st[0], nx = b.st[1];
        if (nloc == 0u) { xcd_barrier_complete(bar, b.x, nloc, nx); b.st[0] = nloc; b.st[1] = nx; }
        const unsigned old = xb_add(&bar[XB_XSUB(b.x)], 1u);
        const unsigned gen = old / nloc;
        if (old + 1u == (gen + 1u) * nloc) {
            __builtin_amdgcn_fence(__ATOMIC_RELEASE, "agent");
            asm volatile("s_waitcnt vmcnt(0)" ::: "memory");
            const unsigned og = xb_add(&bar[XB_TOP], 1u);
            const unsigned tg = og / nx;
            if (og + 1u == (tg + 1u) * nx) xb_add(&bar[XB_TOPGEN], 1u);
            else XB_SPIN(xb_ld(&bar[XB_TOPGEN]) == tg, bar);
            __builtin_amdgcn_fence(__ATOMIC_ACQUIRE, "agent");
            xb_add(&bar[XB_XGEN(b.x)], 1u);
            asm volatile("s_waitcnt vmcnt(0)" ::: "memory");
        } else {
            XB_SPIN(xb_ld(&bar[XB_XGEN(b.x)]) == gen, bar);
            __builtin_amdgcn_fence(__ATOMIC_ACQUIRE, "agent");
            asm volatile("s_waitcnt vmcnt(0)" ::: "memory");
        }
    }
    __syncthreads();
}

__global__ void __launch_bounds__(512, 2) mega_fwd(Params p) {
    extern __shared__ __attribute__((aligned(16))) unsigned char lds_raw[];
    LAS unsigned char* lds = (LAS unsigned char*)lds_raw;
    cg::grid_group grid = cg::this_grid();
    unsigned char* ws = p.ws;
    const int G = gridDim.x;
    const int wid_s = __builtin_amdgcn_readfirstlane((int)threadIdx.x >> 6);
    if (threadIdx.x < 4) ((LAS unsigned*)(lds + XBAR_LDS_OFF))[threadIdx.x] = 0u;
    __syncthreads();
    const XcdBarrier xbar = xcd_barrier_post((unsigned*)(ws + WS_BAR), (volatile LAS unsigned*)(lds + XBAR_LDS_OFF), wid_s);

#ifndef PM
#define PM 0xff
#endif
    if (PM & 1) phase_prep(p, lds, wid_s);
    grid.sync();

    for (int l = 0; l < DEPTH; ++l) {
        for (int grp = 0; grp < NGRP; ++grp) {
            const size_t r0 = (size_t)grp * MG;
            if (PM & 2) {
                pg8::Gemm g{(const bf16_t*)(ws + WS_XBF) + r0 * DM, (const bf16_t*)(ws + WS_WIN) + (size_t)l * NIN * DM, MG, NIN, DM};
                pg8::StaticOrder S; S.init(MG, NIN, G, (int)blockIdx.x);
                Epi1 E{(bf16_t*)(ws + WS_PROJ), (const float*)(ws + WS_SSQX) + r0 * 16, (float*)(ws + WS_SSQV), p.b_merge + (size_t)l * 2 * DM};
                pg8::gemm_phase<Epi1>(lds, g, S, E, wid_s);
#ifdef REPG1
                pg8::gemm_phase<Epi1>(lds, g, S, E, wid_s);
#endif
            }
            xcd_barrier(xbar, wid_s);
            if (PM & 4) {
                const unsigned epoch = (unsigned)(l * NGRP + grp + 1);
#ifndef REPB
#define REPB 1
#define REPA 1
#endif
                for (int rep = 0; rep < REPB; ++rep)
                mixerB_phase(p, lds, l, wid_s);
                for (int rep = 0; rep < REPA; ++rep)
                mixerA_phase(p, lds, l, wid_s);
                __syncthreads();
            }
            xcd_barrier(xbar, wid_s);
            if (PM & 8) {
                pg8::Gemm g{(const bf16_t*)(ws + WS_Y), (const bf16_t*)(ws + WS_WP) + (size_t)l * DM * 2048, MG, DM, 2048};
                pg8::StaticOrder S; S.init(MG, DM, G, (int)blockIdx.x);
                Epi2 E{(const bf16_t*)(ws + WS_PROJ) + (size_t)5 * MG * DM, (const bf16_t*)(ws + WS_PROJ) + (size_t)6 * MG * DM, (bf16_t*)(ws + WS_MB)};
                pg8::gemm_phase<Epi2>(lds, g, S, E, wid_s);
#ifdef REPG2
                pg8::gemm_phase<Epi2>(lds, g, S, E, wid_s);
#endif
            }
            xcd_barrier(xbar, wid_s);
            if (PM & 16) {
                pg8::Gemm g{(const bf16_t*)(ws + WS_MB), (const bf16_t*)(ws + WS_WO) + (size_t)l * DM * DM, MG, DM, DM};
                pg8::StaticOrder S; S.init(MG, DM, G, (int)blockIdx.x);
                Epi3 E{l == 0 ? p.x + r0 * DM : nullptr, nullptr, (bf16_t*)(ws + WS_XBF) + r0 * DM, (float*)(ws + WS_SSQX) + r0 * 16};
                pg8::gemm_phase<Epi3>(lds, g, S, E, wid_s);
            }
            if (NGRP == 1) xcd_barrier(xbar, wid_s);
        }
    }
    xcd_barrier(xbar, wid_s);
    if (PM & 32) phase_final(p, wid_s);
}

extern "C" void kernel_launch(void* const* d_in, const int* in_sizes, int n_in, void* d_out, int out_size, void* d_ws, size_t ws_size, hipStream_t stream) {
    static int grid_blocks = 0;
    if (grid_blocks == 0) {
        if (ws_size < WS_END) { fprintf(stderr, "kernel_launch: workspace too small (%zu < %zu)\n", ws_size, (size_t)WS_END); grid_blocks = -1; return; }
        int dev = 0, cus = 0, per_cu = 0;
        hipGetDevice(&dev);
        hipDeviceGetAttribute(&cus, hipDeviceAttributeMultiprocessorCount, dev);
        hipFuncSetAttribute((const void*)mega_fwd, hipFuncAttributeMaxDynamicSharedMemorySize, LDS_BYTES);
        hipOccupancyMaxActiveBlocksPerMultiprocessor(&per_cu, (const void*)mega_fwd, 512, LDS_BYTES);
        if (per_cu < 1) per_cu = 1;
        grid_blocks = cus * 1;
        fprintf(stderr, "kernel_launch: cus %d per_cu %d grid %d\n", cus, per_cu, grid_blocks);
    }
    if (grid_blocks < 0) return;
    Params p{};
    p.x = (const float*)d_in[0]; p.norm_g = (const float*)d_in[1]; p.w_in = (const float*)d_in[2]; p.b_merge = (const float*)d_in[3]; p.v_norm_g = (const float*)d_in[4];
    p.w_spatial = (const float*)d_in[5]; p.b_spatial = (const float*)d_in[6]; p.conv_w = (const float*)d_in[7]; p.conv_b = (const float*)d_in[8];
    p.w_rgate = (const float*)d_in[9]; p.b_rgate = (const float*)d_in[10]; p.w_igate = (const float*)d_in[11]; p.b_igate = (const float*)d_in[12]; p.lru_lambda = (const float*)d_in[13];
    p.w_proj_a = (const float*)d_in[14]; p.w_proj_b = (const float*)d_in[15]; p.w_out = (const float*)d_in[16]; p.final_g = (const float*)d_in[17];
    p.out = (float*)d_out; p.ws = (unsigned char*)d_ws;
    hipMemsetAsync((unsigned char*)d_ws + WS_BAR, 0, 16384, stream);
    void* args[] = {&p};
    hipError_t e = hipLaunchCooperativeKernel((const void*)mega_fwd, dim3(grid_blocks), dim3(512), args, LDS_BYTES, stream);
    if (e != hipSuccess) fprintf(stderr, "cooperative launch failed: %s (grid %d)\n", hipGetErrorString(e), grid_blocks);
}
```

```cpp
#include <hip/hip_runtime.h>
#include <hip/hip_cooperative_groups.h>
#include <cstdio>
namespace cg = cooperative_groups;

#define LAS __attribute__((address_space(3)))
typedef unsigned short bf16_t;
typedef short bf16x8 __attribute__((ext_vector_type(8)));
typedef float f32x4 __attribute__((ext_vector_type(4)));
typedef unsigned u32x4 __attribute__((ext_vector_type(4)));
typedef unsigned u32x2 __attribute__((ext_vector_type(2)));
typedef float f32x2 __attribute__((ext_vector_type(2)));

constexpr int DM = 1024, NBATCH = 16, SEQ = 4096, MTOT = NBATCH * SEQ, DEPTH = 4, NIN = 7168;
constexpr int NGRP = 2, MG = MTOT / NGRP, BG = NBATCH / NGRP;
constexpr int LSEG = 128, NSEG = SEQ / LSEG;
constexpr int NBITEM = BG * 8 * NSEG, NAITEM = (MG / 128) * 8;
constexpr float EPS = 1e-6f;
constexpr int LDS_BYTES = 142848 + 16;

constexpr size_t WS_WIN = 0;
constexpr size_t WS_WP = WS_WIN + (size_t)DEPTH * NIN * DM * 2;
constexpr size_t WS_WO = WS_WP + (size_t)DEPTH * DM * 2048 * 2;
constexpr size_t WS_WSB = WS_WO + (size_t)DEPTH * DM * DM * 2;
constexpr size_t WS_WRT = WS_WSB + (size_t)DEPTH * 8 * 128 * 128 * 2;
constexpr size_t WS_WIT = WS_WRT + (size_t)DEPTH * 8 * 128 * 128 * 2;
constexpr size_t WS_XBF = WS_WIT + (size_t)DEPTH * 8 * 128 * 128 * 2;
constexpr size_t WS_SSQX = WS_XBF + (size_t)MTOT * DM * 2;
constexpr size_t WS_SSQV = WS_SSQX + (size_t)MTOT * 16 * 4;
constexpr size_t WS_PROJ = WS_SSQV + (size_t)MG * 16 * 4;
constexpr size_t WS_Y = WS_PROJ + (size_t)7 * MG * DM * 2;
constexpr size_t WS_MB = WS_Y + (size_t)MG * 2048 * 2;
constexpr size_t WS_PAY = WS_MB + (size_t)MG * DM * 2;
constexpr size_t WS_PAYP = WS_PAY + (size_t)NBITEM * 8 * 16 * 8;
constexpr size_t WS_FLG = WS_PAYP + (size_t)NBITEM * 8 * 16 * 4;
constexpr size_t WS_BAR = WS_FLG + (size_t)NBITEM * 8 * 4;
constexpr size_t WS_END = WS_BAR + 16384;

struct Params {
    const float* x; const float* norm_g; const float* w_in; const float* b_merge; const float* v_norm_g; const float* w_spatial; const float* b_spatial;
    const float* conv_w; const float* conv_b; const float* w_rgate; const float* b_rgate; const float* w_igate; const float* b_igate; const float* lru_lambda;
    const float* w_proj_a; const float* w_proj_b; const float* w_out; const float* final_g;
    float* out; unsigned char* ws;
};

__device__ __forceinline__ float shfl_idx_(float v, int src_lane) { return __uint_as_float((unsigned)__builtin_amdgcn_ds_bpermute(src_lane << 2, (int)__float_as_uint(v))); }
__device__ __forceinline__ int lane_id_() { return (int)__builtin_amdgcn_mbcnt_hi(~0u, __builtin_amdgcn_mbcnt_lo(~0u, 0u)); }
__device__ __forceinline__ unsigned cvt_pk_bf16(float lo, float hi) { unsigned r; asm volatile("v_cvt_pk_bf16_f32 %0, %1, %2" : "=v"(r) : "v"(lo), "v"(hi)); return r; }
__device__ __forceinline__ float bf_lo(unsigned w) { return __uint_as_float(w << 16); }
__device__ __forceinline__ float bf_hi(unsigned w) { return __uint_as_float(w & 0xffff0000u); }
__device__ __forceinline__ float fast_rcp(float x) { return __builtin_amdgcn_rcpf(x); }
__device__ __forceinline__ float fast_exp2(float x) { return __builtin_amdgcn_exp2f(x); }
__device__ __forceinline__ float sigmoidf_(float x) { return fast_rcp(1.0f + fast_exp2(-1.4426950409f * x)); }

namespace pg8 {
constexpr int BM = 256, BK = 64, HALF = 128, HTB = HALF * BK * 2, STAGE_BYTES = 8 * HTB, NXCD = 8, WGM = 8;
__host__ __device__ __forceinline__ int lds_byte(int r, int c) { const int st = (r >> 4) * 2 + (c >> 5), rr = r & 15, cc = c & 31, ob = rr * 64 + cc * 2; return st * 1024 + (ob ^ (((ob >> 9) & 1) << 5)); }
__host__ __device__ __forceinline__ void stage_rc(int b, int& R, int& C) { const int st = b / 1024, sb = b % 1024, swz = sb ^ (((sb >> 9) & 1) << 5); R = (st >> 1) * 16 + swz / 64; C = (st & 1) * 32 + (swz % 64) / 2; }
__host__ __device__ __forceinline__ int perm32(int rho) { const int n = rho >> 4, i = rho & 15; return 8 * (i >> 2) + 4 * n + (i & 3); }
struct Unit { int pm, pn; };
struct Gemm { const bf16_t* A; const bf16_t* Bt; int M, N, K; };
struct StaticOrder {
    int nM, nN, nwg, G, c;
    __device__ void init(int M, int N, int G_, int c_) { nM = M / BM; nN = N / BM; nwg = nM * nN; G = G_; c = c_; }
    __device__ bool next(int i, Unit& u) const {
        const long L = (long)i * G + c; if (L >= nwg) return false;
        int wgid = (int)L; { const int q = nwg / NXCD, r = nwg % NXCD, xcd = wgid % NXCD, off = wgid / NXCD; wgid = (xcd < r ? xcd * (q + 1) : r * (q + 1) + (xcd - r) * q) + off; }
        const int nig = WGM * nN, gid = wgid / nig, fm = gid * WGM, gsz = (nM - fm) < WGM ? (nM - fm) : WGM;
        u.pm = fm + ((wgid % nig) % gsz); u.pn = (wgid % nig) / gsz; return true;
    }
};
template <class Epi>
__device__ __forceinline__ void gemm_phase(LAS unsigned char* lds, const Gemm g, const StaticOrder& S, const Epi& E, int wid_s) {
    int tid_ = wid_s * 64 + lane_id_(); asm volatile("" : "+v"(tid_));
    const int tid = tid_, wid = __builtin_amdgcn_readfirstlane(tid >> 6), lane = tid & 63, wr = wid >> 2, wc = wid & 3, fr = lane & 15, fq = lane >> 4;
    const int K = g.K, nt = K / BK;
    unsigned voffA[2], voffB[2];
#pragma unroll
    for (int i = 0; i < 2; ++i) { int R, C; stage_rc(tid * 16 + i * 8192, R, C); const int Rb = ((R & ~31) + perm32(R & 31));
        voffA[i] = (unsigned)(R * K + C) * 2u; voffB[i] = (unsigned)(Rb * K + C) * 2u; }
    const size_t kstep = (size_t)(BK * 2);
    const size_t hstep = (size_t)HALF * K * 2;
    const size_t tstep = 2 * hstep;
    const unsigned ldsw = (unsigned)wid * 1024u;
    const int aoff = lds_byte(wr * 64 + fr, fq * 8), boff = lds_byte(wc * 32 + fr, fq * 8);
#define PG8_SA(b, h) (((b) * 2 + (h)) * HTB)
#define PG8_SB(b, h) ((4 + (b) * 2 + (h)) * HTB)
#define PG8_STAGE(bufoff, gbase, voff) do { _Pragma("unroll") for (int _i = 0; _i < 2; ++_i) \
        __builtin_amdgcn_global_load_lds((const unsigned*)((const char*)(gbase) + (voff)[_i]), (LAS unsigned*)(lds + (bufoff) + ldsw + _i * 8192), 16, 0, 0); } while (0)
#define PG8_LDA(dst, b, h) do { _Pragma("unroll") for (int m = 0; m < 4; ++m) _Pragma("unroll") for (int k = 0; k < 2; ++k) dst[m][k] = *(const LAS bf16x8*)(lds + PG8_SA(b, h) + aoff + m * 2048 + k * 1024); } while (0)
#define PG8_LDB(dst, b, h) do { _Pragma("unroll") for (int n = 0; n < 2; ++n) _Pragma("unroll") for (int k = 0; k < 2; ++k) dst[n][k] = *(const LAS bf16x8*)(lds + PG8_SB(b, h) + boff + n * 2048 + k * 1024); } while (0)
#define PG8_MMA(ai, bj, At, Bt) do { __builtin_amdgcn_s_setprio(1); _Pragma("unroll") for (int m = 0; m < 4; ++m) _Pragma("unroll") for (int n = 0; n < 2; ++n) _Pragma("unroll") for (int k = 0; k < 2; ++k) \
        acc[ai][bj][m][n] = __builtin_amdgcn_mfma_f32_16x16x32_bf16(Bt[n][k], At[m][k], acc[ai][bj][m][n], 0, 0, 0); __builtin_amdgcn_s_setprio(0); } while (0)
#define PG8_WAIT_V(n) asm volatile("s_waitcnt vmcnt(" #n ")" ::: "memory")
#define PG8_WAIT_L(n) asm volatile("s_waitcnt lgkmcnt(" #n ")" ::: "memory")
#define PG8_BAR __builtin_amdgcn_s_barrier()
#define PG8_SCHED __builtin_amdgcn_sched_barrier(0)
    Unit cur, nxt; int ui = 0;
    if (!S.next(0, cur)) return;
    float est[8]; int est_pm = -1;
#pragma unroll
    for (int i = 0; i < 8; ++i) est[i] = 0.f;
    f32x4 acc[2][2][4][2];
#pragma unroll
    for (int a = 0; a < 2; ++a)
#pragma unroll
        for (int b = 0; b < 2; ++b)
#pragma unroll
            for (int m = 0; m < 4; ++m)
#pragma unroll
                for (int n = 0; n < 2; ++n) acc[a][b][m][n] = (f32x4){0.f, 0.f, 0.f, 0.f};
    bf16x8 At[4][2], B0[2][2], B1[2][2];
    const char* cA = (const char*)g.A + (size_t)cur.pm * tstep; const char* cB = (const char*)g.Bt + (size_t)cur.pn * tstep;
    PG8_STAGE(PG8_SB(0, 0), cB, voffB); PG8_STAGE(PG8_SB(0, 1), cB + hstep, voffB); PG8_STAGE(PG8_SA(0, 0), cA, voffA); PG8_STAGE(PG8_SA(0, 1), cA + hstep, voffA);
    if (wr == 1) PG8_BAR;
    PG8_WAIT_V(2); PG8_BAR;
    PG8_STAGE(PG8_SB(1, 0), cB + kstep, voffB); PG8_STAGE(PG8_SA(1, 0), cA + kstep, voffA); PG8_STAGE(PG8_SB(1, 1), cB + hstep + kstep, voffB);
    PG8_WAIT_V(6); PG8_BAR;
    for (;;) {
        const bool has_next = S.next(ui + 1, nxt);
        const char* nA = has_next ? (const char*)g.A + (size_t)nxt.pm * tstep : cA; const char* nB = has_next ? (const char*)g.Bt + (size_t)nxt.pn * tstep : cB;
        for (int t = 0; t < nt; t += 2) {
            const bool last = (t == nt - 2);
            const char* a1 = cA + (size_t)(t + 1) * kstep;
            const char* a2 = last ? nA : cA + (size_t)(t + 2) * kstep; const char* b2 = last ? nB : cB + (size_t)(t + 2) * kstep;
            const char* a3 = a2 + kstep; const char* b3 = b2 + kstep;
            if constexpr (Epi::HAS_MID) { if (t == nt / 2) E.mid(acc, cur, wr, wc, fr, fq); }
            PG8_LDB(B0, 0, 0); PG8_LDB(B1, 0, 1); PG8_SCHED; PG8_LDA(At, 0, 0); PG8_STAGE(PG8_SA(1, 1), a1 + hstep, voffA);
            PG8_WAIT_V(8); PG8_WAIT_L(0); PG8_BAR; PG8_MMA(0, 0, At, B0); PG8_MMA(0, 1, At, B1); PG8_BAR; PG8_SCHED;
            PG8_LDA(At, 0, 1); PG8_STAGE(PG8_SB(0, 0), b2, voffB); PG8_STAGE(PG8_SB(0, 1), b2 + hstep, voffB); PG8_STAGE(PG8_SA(0, 0), a2, voffA);
            PG8_WAIT_V(8); PG8_WAIT_L(0); PG8_BAR; PG8_MMA(1, 0, At, B0); PG8_MMA(1, 1, At, B1); PG8_BAR; PG8_SCHED;
            PG8_LDB(B0, 1, 0); PG8_LDB(B1, 1, 1); PG8_SCHED; PG8_LDA(At, 1, 0); PG8_STAGE(PG8_SA(0, 1), a2 + hstep, voffA);
            PG8_WAIT_V(8); PG8_WAIT_L(0); PG8_BAR; PG8_MMA(0, 0, At, B0); PG8_MMA(0, 1, At, B1); PG8_BAR; PG8_SCHED;
            PG8_LDA(At, 1, 1); PG8_STAGE(PG8_SB(1, 0), b3, voffB); PG8_STAGE(PG8_SB(1, 1), b3 + hstep, voffB); PG8_STAGE(PG8_SA(1, 0), a3, voffA);
            PG8_WAIT_V(8); PG8_WAIT_L(0); PG8_BAR; PG8_MMA(1, 0, At, B0); PG8_MMA(1, 1, At, B1); PG8_BAR; PG8_SCHED;
        }
        if (wr == 0) PG8_BAR;
        E(acc, cur, wr, wc, fr, fq, est, est_pm);
        if (!has_next) break;
#pragma unroll
        for (int a = 0; a < 2; ++a)
#pragma unroll
            for (int b = 0; b < 2; ++b)
#pragma unroll
                for (int m = 0; m < 4; ++m)
#pragma unroll
                    for (int n = 0; n < 2; ++n) acc[a][b][m][n] = (f32x4){0.f, 0.f, 0.f, 0.f};
        cur = nxt; cA = nA; cB = nB; ++ui;
        if (wr == 1) PG8_BAR;
    }
    PG8_WAIT_V(0);
    PG8_BAR;
#undef PG8_SA
#undef PG8_SB
#undef PG8_STAGE
#undef PG8_LDA
#undef PG8_LDB
#undef PG8_MMA
#undef PG8_WAIT_V
#undef PG8_WAIT_L
#undef PG8_BAR
#undef PG8_SCHED
}
}

struct Epi1 {
    static constexpr bool HAS_MID = false;
    bf16_t* proj; const float* ssqx; float* ssqv; const float* bm;
    __device__ __forceinline__ void mid(f32x4 (&)[2][2][4][2], const pg8::Unit&, int, int, int, int) const {}
    __device__ __forceinline__ void operator()(const f32x4 (&acc)[2][2][4][2], const pg8::Unit& u, int wr, int wc, int fr, int fq, float (&est)[8], int& est_pm) const {
        const int pn = u.pn; const bool uz = pn < 8, gg = pn >= 20;
        const int seg = uz ? 0 : (pn < 12 ? 1 : (gg ? 5 : (pn >> 2)));
        const int colt = uz ? pn * 128 : (gg ? (pn - 20) * 128 : (pn & 3) * 256);
        bf16_t* base = proj + (size_t)seg * MG * DM;
        const int row0 = u.pm * 256 + wr * 64 + fr, colw = wc * 32 + 8 * fq;
        const float G1c = -2.3022082f, G3c = -2.3022082f * 0.044715f, S1c = -1.4426950409f;
        const float c1_0 = (seg <= 1) ? G1c : S1c, c3_0 = (seg <= 1) ? G3c : 0.f;
        const float c1_1 = (seg == 1) ? G1c : S1c, c3_1 = (seg == 1) ? G3c : 0.f;
        const bool numx = (seg <= 4), raw = (seg == 3);
        float cb[2][8];
#pragma unroll
        for (int bj = 0; bj < 2; ++bj)
#pragma unroll
            for (int j = 0; j < 8; ++j) cb[bj][j] = gg ? -1.4426950409f * bm[bj * DM + colt + colw + j] : 0.f;
        if (u.pm != est_pm) {
            est_pm = u.pm;
            f32x4 pp[2][4];
#pragma unroll
            for (int ai = 0; ai < 2; ++ai)
#pragma unroll
                for (int m = 0; m < 4; ++m) pp[ai][m] = *(const f32x4*)(ssqx + (size_t)(row0 + ai * 128 + m * 16) * 16 + fq * 4);
#pragma unroll
            for (int ai = 0; ai < 2; ++ai)
#pragma unroll
                for (int m = 0; m < 4; ++m) { float s = (pp[ai][m][0] + pp[ai][m][1]) + (pp[ai][m][2] + pp[ai][m][3]); s += shfl_idx_(s, (fq * 16 + fr) ^ 16); s += shfl_idx_(s, (fq * 16 + fr) ^ 32);
                    est[ai * 4 + m] = __builtin_amdgcn_rsqf(s * (1.0f / DM) + EPS); }
        }
#pragma unroll
        for (int ai = 0; ai < 2; ++ai)
#pragma unroll
            for (int m = 0; m < 4; ++m) {
                const int row = row0 + ai * 128 + m * 16;
                const float rstd = est[ai * 4 + m];
                float sq = 0.f;
                float v[2][8];
#pragma unroll
                for (int bj = 0; bj < 2; ++bj) {
                    const float c1 = bj ? c1_1 : c1_0, c3 = bj ? c3_1 : c3_0;
#pragma unroll
                    for (int n = 0; n < 2; ++n)
#pragma unroll
                        for (int j = 0; j < 4; ++j) v[bj][n * 4 + j] = acc[ai][bj][m][n][j] * rstd;
                    if (!raw) {
#pragma unroll
                        for (int j = 0; j < 8; ++j) { const float x = v[bj][j]; const float arg = x * (c1 + c3 * x * x) + cb[bj][j]; const float r = fast_rcp(1.0f + fast_exp2(arg)); v[bj][j] = numx ? x * r : r; }
                    }
                    if (seg == 1) {
#pragma unroll
                        for (int j = 0; j < 8; ++j) sq += v[bj][j] * v[bj][j];
                    }
                }
                if (uz) {
                    u32x4 w; w.x = cvt_pk_bf16(v[0][0] * v[1][0], v[0][1] * v[1][1]); w.y = cvt_pk_bf16(v[0][2] * v[1][2], v[0][3] * v[1][3]);
                    w.z = cvt_pk_bf16(v[0][4] * v[1][4], v[0][5] * v[1][5]); w.w = cvt_pk_bf16(v[0][6] * v[1][6], v[0][7] * v[1][7]);
                    *(u32x4*)(base + (size_t)row * DM + colt + colw) = w;
                } else if (gg) {
                    float q[8];
#pragma unroll
                    for (int j = 0; j < 8; ++j) q[j] = v[0][j] * fast_rcp(fmaxf(v[1][j], 1e-30f));
                    u32x4 w; w.x = cvt_pk_bf16(q[0], q[1]); w.y = cvt_pk_bf16(q[2], q[3]); w.z = cvt_pk_bf16(q[4], q[5]); w.w = cvt_pk_bf16(q[6], q[7]);
                    *(u32x4*)(base + (size_t)row * DM + colt + colw) = w;
                    u32x4 w2; w2.x = cvt_pk_bf16(v[1][0], v[1][1]); w2.y = cvt_pk_bf16(v[1][2], v[1][3]); w2.z = cvt_pk_bf16(v[1][4], v[1][5]); w2.w = cvt_pk_bf16(v[1][6], v[1][7]);
                    *(u32x4*)(base + (size_t)MG * DM + (size_t)row * DM + colt + colw) = w2;
                } else {
#pragma unroll
                    for (int bj = 0; bj < 2; ++bj) {
                        u32x4 w; w.x = cvt_pk_bf16(v[bj][0], v[bj][1]); w.y = cvt_pk_bf16(v[bj][2], v[bj][3]); w.z = cvt_pk_bf16(v[bj][4], v[bj][5]); w.w = cvt_pk_bf16(v[bj][6], v[bj][7]);
                        *(u32x4*)(base + (size_t)row * DM + colt + bj * 128 + colw) = w;
                    }
                }
                if (seg == 1) { sq += shfl_idx_(sq, (fq * 16 + fr) ^ 16); sq += shfl_idx_(sq, (fq * 16 + fr) ^ 32); if (fq == 0) ssqv[(size_t)row * 16 + (pn & 3) * 4 + wc] = sq; }
            }
    }
};
struct Epi2 {
    static constexpr bool HAS_MID = true;
    const bf16_t* sa; const bf16_t* sb; bf16_t* mout;
    __device__ __forceinline__ void mid(f32x4 (&acc)[2][2][4][2], const pg8::Unit& u, int wr, int wc, int fr, int fq) const {
        int row0 = u.pm * 256 + wr * 64 + fr, col0 = u.pn * 256 + wc * 32 + 8 * fq;
        asm volatile("" : "+v"(row0), "+v"(col0));
#pragma unroll
        for (int ai = 0; ai < 2; ++ai) {
            u32x4 av[4][2];
#pragma unroll
            for (int m = 0; m < 4; ++m)
#pragma unroll
                for (int bj = 0; bj < 2; ++bj) av[m][bj] = *(const u32x4*)(sa + (size_t)(row0 + ai * 128 + m * 16) * DM + col0 + bj * 128);
#pragma unroll
            for (int m = 0; m < 4; ++m)
#pragma unroll
                for (int bj = 0; bj < 2; ++bj) {
#pragma unroll
                    for (int q = 0; q < 4; ++q) { acc[ai][bj][m][q >> 1][(q & 1) * 2] *= bf_lo(av[m][bj][q]); acc[ai][bj][m][q >> 1][(q & 1) * 2 + 1] *= bf_hi(av[m][bj][q]); }
                }
            asm volatile("" ::: "memory");
        }
    }
    __device__ __forceinline__ void operator()(const f32x4 (&acc)[2][2][4][2], const pg8::Unit& u, int wr, int wc, int fr, int fq, float (&)[8], int&) const {
        const int row0 = u.pm * 256 + wr * 64 + fr, col0 = u.pn * 256 + wc * 32 + 8 * fq;
        u32x4 bv[2][4][2];
#pragma unroll
        for (int ai = 0; ai < 2; ++ai)
#pragma unroll
            for (int m = 0; m < 4; ++m)
#pragma unroll
                for (int bj = 0; bj < 2; ++bj) bv[ai][m][bj] = *(const u32x4*)(sb + (size_t)(row0 + ai * 128 + m * 16) * DM + col0 + bj * 128);
#pragma unroll
        for (int ai = 0; ai < 2; ++ai)
#pragma unroll
            for (int m = 0; m < 4; ++m)
#pragma unroll
                for (int bj = 0; bj < 2; ++bj) {
                    const size_t off = (size_t)(row0 + ai * 128 + m * 16) * DM + col0 + bj * 128;
                    const u32x4 b = bv[ai][m][bj];
                    u32x4 w;
#pragma unroll
                    for (int q = 0; q < 4; ++q) w[q] = cvt_pk_bf16(acc[ai][bj][m][q >> 1][(q & 1) * 2] * bf_lo(b[q]), acc[ai][bj][m][q >> 1][(q & 1) * 2 + 1] * bf_hi(b[q]));
                    *(u32x4*)(mout + off) = w;
                }
    }
};
struct Epi3 {
    static constexpr bool HAS_MID = false;
    const float* xin_f; float* xout_f; bf16_t* xbf; float* ssqx;
    __device__ __forceinline__ void mid(f32x4 (&)[2][2][4][2], const pg8::Unit&, int, int, int, int) const {}
    __device__ __forceinline__ void operator()(const f32x4 (&acc)[2][2][4][2], const pg8::Unit& u, int wr, int wc, int fr, int fq, float (&)[8], int&) const {
        const int row0 = u.pm * 256 + wr * 64 + fr, col0 = u.pn * 256 + wc * 32 + 8 * fq;
#pragma unroll
        for (int ai = 0; ai < 2; ++ai) {
            f32x4 xv[4][2][2];
            if (xin_f) {
#pragma unroll
                for (int m = 0; m < 4; ++m)
#pragma unroll
                    for (int bj = 0; bj < 2; ++bj) { const size_t off = (size_t)(row0 + ai * 128 + m * 16) * DM + col0 + bj * 128; xv[m][bj][0] = *(const f32x4*)(xin_f + off); xv[m][bj][1] = *(const f32x4*)(xin_f + off + 4); }
            } else {
                u32x4 xb_[4][2];
#pragma unroll
                for (int m = 0; m < 4; ++m)
#pragma unroll
                    for (int bj = 0; bj < 2; ++bj) xb_[m][bj] = *(const u32x4*)(xbf + (size_t)(row0 + ai * 128 + m * 16) * DM + col0 + bj * 128);
#pragma unroll
                for (int m = 0; m < 4; ++m)
#pragma unroll
                    for (int bj = 0; bj < 2; ++bj) { const u32x4 w = xb_[m][bj];
                        xv[m][bj][0] = (f32x4){bf_lo(w.x), bf_hi(w.x), bf_lo(w.y), bf_hi(w.y)}; xv[m][bj][1] = (f32x4){bf_lo(w.z), bf_hi(w.z), bf_lo(w.w), bf_hi(w.w)}; }
            }
#pragma unroll
            for (int m = 0; m < 4; ++m) {
                const int row = row0 + ai * 128 + m * 16; float sq = 0.f;
#pragma unroll
                for (int bj = 0; bj < 2; ++bj) {
                    const size_t off = (size_t)row * DM + col0 + bj * 128;
                    const f32x4 x0 = xv[m][bj][0] + acc[ai][bj][m][0], x1 = xv[m][bj][1] + acc[ai][bj][m][1];
                    sq += (x0[0] * x0[0] + x0[1] * x0[1]) + (x0[2] * x0[2] + x0[3] * x0[3]) + (x1[0] * x1[0] + x1[1] * x1[1]) + (x1[2] * x1[2] + x1[3] * x1[3]);
                    if (xout_f) { *(f32x4*)(xout_f + off) = x0; *(f32x4*)(xout_f + off + 4) = x1; }
                    else { u32x4 w; w.x = cvt_pk_bf16(x0[0], x0[1]); w.y = cvt_pk_bf16(x0[2], x0[3]); w.z = cvt_pk_bf16(x1[0], x1[1]); w.w = cvt_pk_bf16(x1[2], x1[3]); *(u32x4*)(xbf + off) = w; }
                }
                sq += shfl_idx_(sq, (fq * 16 + fr) ^ 16); sq += shfl_idx_(sq, (fq * 16 + fr) ^ 32);
                if (fq == 0) ssqx[(size_t)row * 16 + u.pn * 4 + wc] = sq;
            }
            asm volatile("" ::: "memory");
        }
    }
};

struct TrJob { const float* src; const float* scale; bf16_t* dst; int C, ldd, coff, r0, c0; };
__device__ __forceinline__ TrJob tr_decode(const Params& p, int t) {
    unsigned char* ws = p.ws;
    const int l = t / 2624; int q = t % 2624; TrJob j;
    if (q < 1792) { j.src = p.w_in + (size_t)l * DM * NIN; j.C = NIN; j.scale = p.norm_g + l * DM; j.ldd = DM; j.coff = 0; j.r0 = (q / 112) * 64; j.c0 = (q % 112) * 64;
        const int n = j.c0; int d0 = n;
        if (n < 1024) d0 = (n >> 7) * 256 + (n & 127); else if (n < 2048) d0 = 2048 + (n - 1024); else if (n < 3072) d0 = ((n - 2048) >> 7) * 256 + 128 + ((n - 2048) & 127);
        else if (n >= 6144) d0 = 5120 + ((n - 6144) >> 7) * 256 + 128 + ((n - 6144) & 127); else if (n >= 5120) d0 = 5120 + ((n - 5120) >> 7) * 256 + ((n - 5120) & 127);
        j.dst = (bf16_t*)(ws + WS_WIN) + (size_t)l * NIN * DM + (ptrdiff_t)(d0 - j.c0) * DM; return j; }
    q -= 1792; j.scale = nullptr;
    if (q < 256) { j.src = p.w_proj_a + (size_t)l * DM * DM; j.C = DM; j.dst = (bf16_t*)(ws + WS_WP) + (size_t)l * DM * 2048; j.ldd = 2048; j.coff = 0; j.r0 = (q / 16) * 64; j.c0 = (q % 16) * 64; return j; }
    q -= 256;
    if (q < 256) { j.src = p.w_proj_b + (size_t)l * DM * DM; j.C = DM; j.dst = (bf16_t*)(ws + WS_WP) + (size_t)l * DM * 2048; j.ldd = 2048; j.coff = 1024; j.r0 = (q / 16) * 64; j.c0 = (q % 16) * 64; return j; }
    q -= 256;
    if (q < 256) { j.src = p.w_out + (size_t)l * DM * DM; j.C = DM; j.dst = (bf16_t*)(ws + WS_WO) + (size_t)l * DM * DM; j.ldd = DM; j.coff = 0; j.r0 = (q / 16) * 64; j.c0 = (q % 16) * 64; return j; }
    q -= 256;
    const bool ig = q >= 32; if (ig) q -= 32;
    const int h = q >> 2, tt = q & 3;
    j.src = (ig ? p.w_igate : p.w_rgate) + ((size_t)l * 8 + h) * 16384; j.C = 128; j.dst = (bf16_t*)(ws + (ig ? WS_WIT : WS_WRT)) + ((size_t)l * 8 + h) * 16384; j.ldd = 128; j.coff = 0; j.r0 = (tt >> 1) * 64; j.c0 = (tt & 1) * 64;
    return j;
}

__device__ void phase_prep(const Params& p, LAS unsigned char* lds, int wid_s) {
    int tid_ = wid_s * 64 + lane_id_(); asm volatile("" : "+v"(tid_));
    const int tid = tid_, G = gridDim.x;
    unsigned char* ws = p.ws;
    LAS float* tile = (LAS float*)lds;
    {
        const int NT = DEPTH * 2624;
        const int lr = tid >> 4, c4 = (tid & 15) * 4;
        int t = blockIdx.x;
        TrJob job; f32x4 v0, v1; float s0 = 1.f, s1 = 1.f;
        if (t < NT) { job = tr_decode(p, t);
            v0 = *(const f32x4*)(job.src + (size_t)(job.r0 + lr) * job.C + job.c0 + c4); v1 = *(const f32x4*)(job.src + (size_t)(job.r0 + 32 + lr) * job.C + job.c0 + c4);
            if (job.scale) { s0 = job.scale[job.r0 + lr]; s1 = job.scale[job.r0 + 32 + lr]; } }
        for (; t < NT; t += G) {
            TrJob nxt = job; f32x4 n0 = v0, n1 = v1; float ns0 = 1.f, ns1 = 1.f;
            if (t + G < NT) { nxt = tr_decode(p, t + G);
                n0 = *(const f32x4*)(nxt.src + (size_t)(nxt.r0 + lr) * nxt.C + nxt.c0 + c4); n1 = *(const f32x4*)(nxt.src + (size_t)(nxt.r0 + 32 + lr) * nxt.C + nxt.c0 + c4);
                if (nxt.scale) { ns0 = nxt.scale[nxt.r0 + lr]; ns1 = nxt.scale[nxt.r0 + 32 + lr]; } }
            tile[(c4 + 0) * 65 + lr] = v0[0] * s0; tile[(c4 + 1) * 65 + lr] = v0[1] * s0; tile[(c4 + 2) * 65 + lr] = v0[2] * s0; tile[(c4 + 3) * 65 + lr] = v0[3] * s0;
            tile[(c4 + 0) * 65 + 32 + lr] = v1[0] * s1; tile[(c4 + 1) * 65 + 32 + lr] = v1[1] * s1; tile[(c4 + 2) * 65 + 32 + lr] = v1[2] * s1; tile[(c4 + 3) * 65 + 32 + lr] = v1[3] * s1;
            __syncthreads();
            const int c = tid >> 3, r8 = (tid & 7) * 8;
            float f[8];
#pragma unroll
            for (int j = 0; j < 8; ++j) f[j] = tile[c * 65 + r8 + j];
            u32x4 w; w.x = cvt_pk_bf16(f[0], f[1]); w.y = cvt_pk_bf16(f[2], f[3]); w.z = cvt_pk_bf16(f[4], f[5]); w.w = cvt_pk_bf16(f[6], f[7]);
            *(u32x4*)(job.dst + (size_t)(job.c0 + c) * job.ldd + job.coff + job.r0 + r8) = w;
            __syncthreads();
            job = nxt; v0 = n0; v1 = n1; s0 = ns0; s1 = ns1;
        }
    }
    for (int e = blockIdx.x * 512 + tid; e < DEPTH * 8 * 128 * 128 / 8; e += G * 512) {
        const int s8 = (e & 15) * 8, t = (e >> 4) & 127;
        const f32x4 a = *(const f32x4*)(p.w_spatial + (size_t)e * 8), b = *(const f32x4*)(p.w_spatial + (size_t)e * 8 + 4);
        float f[8] = {a[0], a[1], a[2], a[3], b[0], b[1], b[2], b[3]};
#pragma unroll
        for (int j = 0; j < 8; ++j) f[j] = (s8 + j <= t) ? f[j] : 0.f;
        u32x4 w; w.x = cvt_pk_bf16(f[0], f[1]); w.y = cvt_pk_bf16(f[2], f[3]); w.z = cvt_pk_bf16(f[4], f[5]); w.w = cvt_pk_bf16(f[6], f[7]);
        *(u32x4*)((bf16_t*)(ws + WS_WSB) + (size_t)e * 8) = w;
    }
    {
        const int wave = tid >> 6, lane = tid & 63;
        bf16_t* xbf = (bf16_t*)(ws + WS_XBF); float* ssqx = (float*)(ws + WS_SSQX);
        for (int row = (blockIdx.x * 8 + wave) * 2; row < MTOT; row += G * 16) {
            f32x4 v[2][4];
#pragma unroll
            for (int r = 0; r < 2; ++r)
#pragma unroll
                for (int i = 0; i < 4; ++i) v[r][i] = *(const f32x4*)(p.x + (size_t)(row + r) * DM + i * 256 + lane * 4);
#pragma unroll
            for (int r = 0; r < 2; ++r) {
                float sq = 0.f;
#pragma unroll
                for (int i = 0; i < 4; ++i) {
                    sq += (v[r][i][0] * v[r][i][0] + v[r][i][1] * v[r][i][1]) + (v[r][i][2] * v[r][i][2] + v[r][i][3] * v[r][i][3]);
                    u32x2 w; w.x = cvt_pk_bf16(v[r][i][0], v[r][i][1]); w.y = cvt_pk_bf16(v[r][i][2], v[r][i][3]);
                    *(u32x2*)(xbf + (size_t)(row + r) * DM + i * 256 + lane * 4) = w;
                }
#pragma unroll
                for (int d = 1; d < 64; d <<= 1) sq += shfl_idx_(sq, lane ^ d);
                if (lane < 16) ssqx[(size_t)(row + r) * 16 + lane] = (lane == 0) ? sq : 0.f;
            }
        }
    }
    for (int e = blockIdx.x * 512 + tid; e < NBITEM * 8; e += G * 512) ((unsigned*)(ws + WS_FLG))[e] = 0u;
}

__device__ __forceinline__ void mixerA_phase(const Params& p, LAS unsigned char* lds, int l_in, int wid_s) {
    int tid_ = wid_s * 64 + lane_id_(); asm volatile("" : "+v"(tid_));
    int l = l_in; asm volatile("" : "+s"(l));
    const int tid = tid_, wid = tid >> 6, lane = tid & 63, fr = lane & 15, fq = lane >> 4;
    const int G = gridDim.x;
    unsigned char* ws = p.ws;
    const bf16_t* gu = (const bf16_t*)(ws + WS_PROJ); const bf16_t* gv = gu + (size_t)MG * DM;
    const float* ssqv = (const float*)(ws + WS_SSQV);
    bf16_t* ybuf = (bf16_t*)(ws + WS_Y);
    LAS bf16_t* sVT = (LAS bf16_t*)lds;
    const int tok = tid >> 2, cl = tid & 3;
    const int c0 = wid * 16;
    const int Ge = G & ~7;
    if ((int)blockIdx.x >= Ge) return;
    const int gi = blockIdx.x & 7;
    const int cch = gi * 128 + c0 + 4 * fq;
    bf16x8 wf[20]; f32x4 vg; float bs[8];
    {
        const bf16_t* wsb = (const bf16_t*)(ws + WS_WSB) + ((size_t)l * 8 + gi) * 16384;
        int n = 0;
#pragma unroll
        for (int i = 0; i < 8; ++i)
#pragma unroll
            for (int ks = 0; ks <= (i >> 1); ++ks) { wf[n] = *(const bf16x8*)(wsb + (16 * i + fr) * 128 + ks * 32 + 8 * fq); ++n; }
        vg = *(const f32x4*)(p.v_norm_g + l * DM + cch);
#pragma unroll
        for (int i = 0; i < 8; ++i) bs[i] = p.b_spatial[((size_t)l * 8 + gi) * 128 + 16 * i + fr];
    }
    u32x4 pv[4]; f32x4 pq[4];
#define A_LOAD(it_) do { const int rb_ = ((it_) >> 3) * 128, gi_ = (it_) & 7; \
        _Pragma("unroll") for (int i_ = 0; i_ < 4; ++i_) { pv[i_] = *(const u32x4*)(gv + (size_t)(rb_ + tok) * DM + gi_ * 128 + (4 * i_ + cl) * 8); pq[i_] = *(const f32x4*)(ssqv + (size_t)(rb_ + tok) * 16 + 4 * i_); } } while (0)
    int it = blockIdx.x;
    if (it < NAITEM) A_LOAD(it);
    for (; it < NAITEM; it += Ge) {
        const int chunk = it >> 3, rowbase = chunk * 128;
        u32x2 uu[8];
#pragma unroll
        for (int i = 0; i < 8; ++i) uu[i] = *(const u32x2*)(gu + (size_t)(rowbase + 16 * i + fr) * DM + cch);
        __syncthreads();
        {
            const f32x4 a = pq[0], b = pq[1], c = pq[2], d = pq[3];
            const float ssum = ((a[0] + a[1]) + (a[2] + a[3])) + ((b[0] + b[1]) + (b[2] + b[3])) + ((c[0] + c[1]) + (c[2] + c[3])) + ((d[0] + d[1]) + (d[2] + d[3]));
            const float rs = __builtin_amdgcn_rsqf(ssum * (1.0f / DM) + EPS);
#pragma unroll
            for (int i = 0; i < 4; ++i) {
                const int c8 = 4 * i + cl;
#pragma unroll
                for (int k = 0; k < 4; ++k) {
                    const unsigned pk = cvt_pk_bf16(bf_lo(pv[i][k]) * rs, bf_hi(pv[i][k]) * rs);
                    sVT[(c8 * 8 + 2 * k) * 136 + tok] = (bf16_t)(pk & 0xffffu);
                    sVT[(c8 * 8 + 2 * k + 1) * 136 + tok] = (bf16_t)(pk >> 16);
                }
            }
        }
        __syncthreads();
        if (it + Ge < NAITEM) A_LOAD(it + Ge);
        bf16x8 vf[4];
#pragma unroll
        for (int ks = 0; ks < 4; ++ks) vf[ks] = *(const LAS bf16x8*)(sVT + (c0 + fr) * 136 + ks * 32 + 8 * fq);
        int n = 0;
#pragma unroll
        for (int i = 0; i < 8; ++i) {
            f32x4 acc = (f32x4){0.f, 0.f, 0.f, 0.f};
#pragma unroll
            for (int ks = 0; ks <= (i >> 1); ++ks) { acc = __builtin_amdgcn_mfma_f32_16x16x32_bf16(vf[ks], wf[n], acc, 0, 0, 0); ++n; }
            const int t = 16 * i + fr;
            const float y0 = bf_lo(uu[i].x) * (vg[0] * acc[0] + bs[i]), y1 = bf_hi(uu[i].x) * (vg[1] * acc[1] + bs[i]);
            const float y2 = bf_lo(uu[i].y) * (vg[2] * acc[2] + bs[i]), y3 = bf_hi(uu[i].y) * (vg[3] * acc[3] + bs[i]);
            u32x2 o; o.x = cvt_pk_bf16(y0, y1); o.y = cvt_pk_bf16(y2, y3);
            *(u32x2*)(ybuf + (size_t)(rowbase + t) * 2048 + cch) = o;
        }
    }
#undef A_LOAD
}

#define DPP_SHR(v, ident, d) __uint_as_float((unsigned)__builtin_amdgcn_update_dpp((int)__float_as_uint(ident), (int)__float_as_uint(v), 0x110 + (d), 0xf, 0xf, false))

constexpr int LSB = 256, NSB = SEQ / LSB, XB_OFF1 = LSB * 136 * 2, CW_OFF = 2 * XB_OFF1, AGG_OFF = CW_OFF + 2560, XBAR_LDS_OFF = AGG_OFF + 1024;
__device__ __forceinline__ void mixerB_phase(const Params& p, LAS unsigned char* lds, int l_in, int wid_s) {
    int tid_ = wid_s * 64 + lane_id_(); asm volatile("" : "+v"(tid_));
    int l = l_in; asm volatile("" : "+s"(l));
    const int tid = tid_, wid = __builtin_amdgcn_readfirstlane(tid >> 6), lane = tid & 63, fr = lane & 15, fq = lane >> 4;
    const int G = gridDim.x;
    unsigned char* ws = p.ws;
    const bf16_t* xb = (const bf16_t*)(ws + WS_PROJ) + (size_t)3 * MG * DM; const bf16_t* zb = (const bf16_t*)(ws + WS_PROJ) + (size_t)4 * MG * DM;
    bf16_t* ybuf = (bf16_t*)(ws + WS_Y);
    LAS float* sCW = (LAS float*)(lds + CW_OFF);
    LAS float* sAgg = (LAS float*)(lds + AGG_OFF);
    const int c8 = (tid & 15) * 8, t8 = (tid >> 4) * 8;
    const int chh = wid & 1, tq = wid >> 1;
    for (int task = blockIdx.x; task < BG * 8 * 4; task += G) {
        const int bh = task & (BG * 8 - 1), cq = task / (BG * 8), bl = bh >> 3, h = bh & 7;
        const int j0 = cq * 32 + chh * 16, chl = h * 128 + j0 + 4 * fq;
        __syncthreads();
        for (int e = tid; e < 640; e += 512) { const int k = e >> 7, c = e & 127; sCW[e] = (k < 4) ? p.conv_w[((size_t)l * 4 + k) * DM + h * 128 + c] : p.conv_b[(size_t)l * DM + h * 128 + c]; }
        bf16x8 wrf[4], wif[4]; f32x4 br, bi, nsp;
        {
            const bf16_t* wr_ = (const bf16_t*)(ws + WS_WRT) + ((size_t)l * 8 + h) * 16384 + (j0 + fr) * 128 + 8 * fq;
            const bf16_t* wi_ = (const bf16_t*)(ws + WS_WIT) + ((size_t)l * 8 + h) * 16384 + (j0 + fr) * 128 + 8 * fq;
#pragma unroll
            for (int ks = 0; ks < 4; ++ks) { wrf[ks] = *(const bf16x8*)(wr_ + ks * 32); wif[ks] = *(const bf16x8*)(wi_ + ks * 32); }
            br = *(const f32x4*)(p.b_rgate + (size_t)l * DM + chl); bi = *(const f32x4*)(p.b_igate + (size_t)l * DM + chl);
            const f32x4 lam = *(const f32x4*)(p.lru_lambda + (size_t)l * DM + chl);
#pragma unroll
            for (int r = 0; r < 4; ++r) { const float z = -lam[r]; nsp[r] = -8.0f * (fmaxf(z, 0.f) + log1pf(expf(-fabsf(z)))); }
        }
        u32x4 xr[11];
#define XB_LOAD(seg_) do { const int rb_ = bl * SEQ + (seg_) * LSB, ch_ = h * 128 + c8; \
        _Pragma("unroll") for (int r_ = 0; r_ < 11; ++r_) { const int t_ = t8 - 3 + r_; xr[r_] = (u32x4){0u, 0u, 0u, 0u}; \
            if (t_ >= 0 || (seg_) > 0) xr[r_] = *(const u32x4*)(xb + (size_t)(rb_ + t_) * DM + ch_); } } while (0)
        XB_LOAD(0);
        float S[4] = {0.f, 0.f, 0.f, 0.f};
        __syncthreads();
        for (int seg = 0; seg < NSB; ++seg) {
            const int rowbase = bl * SEQ + seg * LSB;
            LAS bf16_t* sXb = (LAS bf16_t*)(lds + (seg & 1) * XB_OFF1);
            {
                f32x2 cw2[5][4];
#pragma unroll
                for (int k = 0; k < 5; ++k) { const f32x4 a = *(const LAS f32x4*)(sCW + k * 128 + c8), b = *(const LAS f32x4*)(sCW + k * 128 + c8 + 4);
                    cw2[k][0] = (f32x2){a[0], a[1]}; cw2[k][1] = (f32x2){a[2], a[3]}; cw2[k][2] = (f32x2){b[0], b[1]}; cw2[k][3] = (f32x2){b[2], b[3]}; }
                f32x2 ur[11][4];
#pragma unroll
                for (int r = 0; r < 3; ++r)
#pragma unroll
                    for (int k = 0; k < 4; ++k) ur[r][k] = (f32x2){bf_lo(xr[r][k]), bf_hi(xr[r][k])};
#pragma unroll
                for (int tt = 0; tt < 8; ++tt) {
#pragma unroll
                    for (int k = 0; k < 4; ++k) ur[tt + 3][k] = (f32x2){bf_lo(xr[tt + 3][k]), bf_hi(xr[tt + 3][k])};
                    f32x2 o2[4];
#pragma unroll
                    for (int k = 0; k < 4; ++k) o2[k] = cw2[4][k] + cw2[0][k] * ur[tt][k] + cw2[1][k] * ur[tt + 1][k] + cw2[2][k] * ur[tt + 2][k] + cw2[3][k] * ur[tt + 3][k];
                    u32x4 w; w.x = cvt_pk_bf16(o2[0].x, o2[0].y); w.y = cvt_pk_bf16(o2[1].x, o2[1].y); w.z = cvt_pk_bf16(o2[2].x, o2[2].y); w.w = cvt_pk_bf16(o2[3].x, o2[3].y);
                    *(LAS u32x4*)(sXb + (t8 + tt) * 136 + c8) = w;
                }
            }
            __syncthreads();
            if (seg + 1 < NSB) XB_LOAD(seg + 1);
            u32x2 zz[4];
#pragma unroll
            for (int tt = 0; tt < 4; ++tt) zz[tt] = *(const u32x2*)(zb + (size_t)(rowbase + 64 * tq + 16 * tt + fr) * DM + chl);
            float Pt[4][4], Ht[4][4];
            float Pc[4] = {1.f, 1.f, 1.f, 1.f}, Hc[4] = {0.f, 0.f, 0.f, 0.f};
            f32x4 aRa[4], aIa[4]; u32x2 xcwa[4];
#pragma unroll
            for (int tt = 0; tt < 4; ++tt) {
                const int trow = 64 * tq + 16 * tt + fr;
                aRa[tt] = (f32x4){0.f, 0.f, 0.f, 0.f}; aIa[tt] = (f32x4){0.f, 0.f, 0.f, 0.f};
#pragma unroll
                for (int ks = 0; ks < 4; ++ks) {
                    const bf16x8 xf = *(const LAS bf16x8*)(sXb + trow * 136 + ks * 32 + 8 * fq);
                    aRa[tt] = __builtin_amdgcn_mfma_f32_16x16x32_bf16(wrf[ks], xf, aRa[tt], 0, 0, 0);
                    aIa[tt] = __builtin_amdgcn_mfma_f32_16x16x32_bf16(wif[ks], xf, aIa[tt], 0, 0, 0);
                }
                xcwa[tt] = *(const LAS u32x2*)(sXb + trow * 136 + j0 + 4 * fq);
            }
            __builtin_amdgcn_sched_barrier(0);
#pragma unroll
            for (int tt = 0; tt < 4; ++tt) {
                const f32x4 aR = aRa[tt], aI = aIa[tt];
                const u32x2 xcw = xcwa[tt];
                const f32x4 xc = (f32x4){bf_lo(xcw.x), bf_hi(xcw.x), bf_lo(xcw.y), bf_hi(xcw.y)};
                float Av[4], Bw[4];
#pragma unroll
                for (int pp = 0; pp < 2; ++pp) {
                    const f32x2 zr = ((f32x2){aR[2 * pp], aR[2 * pp + 1]} + (f32x2){br[2 * pp], br[2 * pp + 1]}) * -1.4426950409f;
                    const f32x2 zi = ((f32x2){aI[2 * pp], aI[2 * pp + 1]} + (f32x2){bi[2 * pp], bi[2 * pp + 1]}) * -1.4426950409f;
                    f32x2 er, ei; er.x = fast_exp2(zr.x); er.y = fast_exp2(zr.y); ei.x = fast_exp2(zi.x); ei.y = fast_exp2(zi.y);
                    const f32x2 dr = er + 1.0f, di = ei + 1.0f;
                    f32x2 rg, ig; rg.x = fast_rcp(dr.x); rg.y = fast_rcp(dr.y); ig.x = fast_rcp(di.x); ig.y = fast_rcp(di.y);
                    const f32x2 la = (f32x2){nsp[2 * pp], nsp[2 * pp + 1]} * rg;
                    const f32x2 la2 = la * 1.4426950409f;
                    f32x2 a; a.x = fast_exp2(la2.x); a.y = fast_exp2(la2.y);
                    const f32x2 x2 = la * 2.0f;
                    const f32x2 em = x2 * (x2 * (x2 * (x2 * (x2 * (x2 * 0.0013888889f + 0.0083333338f) + 0.041666668f) + 0.16666667f) + 0.5f) + 1.0f);
                    const f32x2 ga = a * a * -1.0f + 1.0f;
                    f32x2 g2; g2.x = (x2.x > -0.25f) ? -em.x : ga.x; g2.y = (x2.y > -0.25f) ? -em.y : ga.y;
                    f32x2 sq; sq.x = __builtin_amdgcn_sqrtf(fmaxf(g2.x, 0.f)); sq.y = __builtin_amdgcn_sqrtf(fmaxf(g2.y, 0.f));
                    const f32x2 bv = sq * (ig * (f32x2){xc[2 * pp], xc[2 * pp + 1]});
                    Av[2 * pp] = a.x; Av[2 * pp + 1] = a.y; Bw[2 * pp] = bv.x; Bw[2 * pp + 1] = bv.y;
                }
#define SCAN_STEP(d) asm volatile("s_nop 1\n" \
                    "v_fmac_f32_dpp %0, %0, %4 row_shr:" #d " row_mask:0xf bank_mask:0xf\n v_fmac_f32_dpp %1, %1, %5 row_shr:" #d " row_mask:0xf bank_mask:0xf\n" \
                    "v_fmac_f32_dpp %2, %2, %6 row_shr:" #d " row_mask:0xf bank_mask:0xf\n v_fmac_f32_dpp %3, %3, %7 row_shr:" #d " row_mask:0xf bank_mask:0xf\n" \
                    "v_mul_f32_dpp %4, %4, %4 row_shr:" #d " row_mask:0xf bank_mask:0xf\n v_mul_f32_dpp %5, %5, %5 row_shr:" #d " row_mask:0xf bank_mask:0xf\n" \
                    "v_mul_f32_dpp %6, %6, %6 row_shr:" #d " row_mask:0xf bank_mask:0xf\n v_mul_f32_dpp %7, %7, %7 row_shr:" #d " row_mask:0xf bank_mask:0xf" \
                    : "+v"(Bw[0]), "+v"(Bw[1]), "+v"(Bw[2]), "+v"(Bw[3]), "+v"(Av[0]), "+v"(Av[1]), "+v"(Av[2]), "+v"(Av[3]))
                SCAN_STEP(1); SCAN_STEP(2); SCAN_STEP(4); SCAN_STEP(8);
#undef SCAN_STEP
#pragma unroll
                for (int r = 0; r < 4; ++r) {
                    const float A = Av[r], Bv = Bw[r];
                    const float P = A * Pc[r], H = A * Hc[r] + Bv;
                    Pt[tt][r] = P; Ht[tt][r] = H;
                    Pc[r] = shfl_idx_(P, lane | 15); Hc[r] = shfl_idx_(H, lane | 15);
                }
            }
            if (fr == 0) {
                LAS float* q = sAgg + ((tq * 2 + chh) * 16 + 4 * fq) * 2;
                *(LAS f32x4*)q = (f32x4){Pc[0], Hc[0], Pc[1], Hc[1]}; *(LAS f32x4*)(q + 4) = (f32x4){Pc[2], Hc[2], Pc[3], Hc[3]};
            }
            __syncthreads();
            float carry[4] = {S[0], S[1], S[2], S[3]};
#pragma unroll
            for (int qd = 0; qd < 4; ++qd) {
                const LAS float* q = sAgg + ((qd * 2 + chh) * 16 + 4 * fq) * 2;
                const f32x4 a0 = *(const LAS f32x4*)q, a1 = *(const LAS f32x4*)(q + 4);
                if (qd == tq) { carry[0] = S[0]; carry[1] = S[1]; carry[2] = S[2]; carry[3] = S[3]; }
                S[0] = a0[0] * S[0] + a0[1]; S[1] = a0[2] * S[1] + a0[3]; S[2] = a1[0] * S[2] + a1[1]; S[3] = a1[2] * S[3] + a1[3];
            }
#pragma unroll
            for (int tt = 0; tt < 4; ++tt) {
                const int t = 64 * tq + 16 * tt + fr;
                const float y0 = (Ht[tt][0] + Pt[tt][0] * carry[0]) * bf_lo(zz[tt].x), y1 = (Ht[tt][1] + Pt[tt][1] * carry[1]) * bf_hi(zz[tt].x);
                const float y2 = (Ht[tt][2] + Pt[tt][2] * carry[2]) * bf_lo(zz[tt].y), y3 = (Ht[tt][3] + Pt[tt][3] * carry[3]) * bf_hi(zz[tt].y);
                u32x2 ov; ov.x = cvt_pk_bf16(y0, y1); ov.y = cvt_pk_bf16(y2, y3);
                *(u32x2*)(ybuf + (size_t)(rowbase + t) * 2048 + 1024 + chl) = ov;
            }
        }
#undef XB_LOAD
    }
}

__device__ void phase_final(const Params& p, int wid_s) {
    int tid_ = wid_s * 64 + lane_id_(); asm volatile("" : "+v"(tid_));
    const int tid = tid_, wave = tid >> 6, lane = tid & 63, G = gridDim.x;
    const float* ssqx = (const float*)(p.ws + WS_SSQX);
    f32x4 gv[4];
#pragma unroll
    for (int i = 0; i < 4; ++i) gv[i] = *(const f32x4*)(p.final_g + i * 256 + lane * 4);
    for (int row = blockIdx.x * 8 + wave; row < MTOT; row += G * 8) {
        float s = (lane < 16) ? ssqx[(size_t)row * 16 + lane] : 0.f;
#pragma unroll
        for (int d = 1; d < 16; d <<= 1) s += shfl_idx_(s, lane ^ d);
        s = shfl_idx_(s, lane & 0);
        const float rstd = __builtin_amdgcn_rsqf(s * (1.0f / DM) + EPS);
        float* xr = p.out + (size_t)row * DM; const bf16_t* xb = (const bf16_t*)(p.ws + WS_XBF) + (size_t)row * DM;
        u32x2 w[4];
#pragma unroll
        for (int i = 0; i < 4; ++i) w[i] = *(const u32x2*)(xb + i * 256 + lane * 4);
#pragma unroll
        for (int i = 0; i < 4; ++i) { f32x4 v = (f32x4){bf_lo(w[i].x), bf_hi(w[i].x), bf_lo(w[i].y), bf_hi(w[i].y)}; v = v * rstd * gv[i]; *(f32x4*)(xr + i * 256 + lane * 4) = v; }
    }
}

#define XB_TMO      128
#define XB_XCNT(j)  (256  + 64 * (j))
#define XB_XSUB(j)  (1280 + 64 * (j))
#define XB_XGEN(j)  (2304 + 64 * (j))
#define XB_TOP      3328
#define XB_TOPGEN   3392
#define XCD_BAR_WORDS 3456
#define XB_SPIN_CAP (1u << 18)
__device__ __forceinline__ unsigned xb_ld(unsigned* p)              { return __hip_atomic_load(p, __ATOMIC_RELAXED, __HIP_MEMORY_SCOPE_AGENT); }
__device__ __forceinline__ unsigned xb_add(unsigned* p, unsigned v) { return __hip_atomic_fetch_add(p, v, __ATOMIC_RELAXED, __HIP_MEMORY_SCOPE_AGENT); }
__device__ __forceinline__ unsigned xb_xcc_id() { return (unsigned)__builtin_amdgcn_s_getreg((3 << 11) | 20) & 0xFu; }
#define XB_SPIN(cond, bar) do { unsigned _sp = 0; while (cond) { __builtin_amdgcn_s_sleep(1); \
    if ((++_sp & 255u) == 0u) { if (xb_ld(&(bar)[XB_TMO])) break; if (_sp > XB_SPIN_CAP) { atomicAdd(&(bar)[XB_TMO], 1u); break; } } } } while (0)
struct XcdBarrier { unsigned* bar; unsigned x; volatile LAS unsigned* st; };
__device__ __forceinline__ XcdBarrier xcd_barrier_post(unsigned* bar, volatile LAS unsigned* st, int wid_s) {
    XcdBarrier b; b.bar = bar; b.x = xb_xcc_id(); b.st = st;
    if (wid_s == 0 && lane_id_() == 0) (void)xb_add(&bar[XB_XCNT(b.x)], 1u);
    return b;
}
__device__ __forceinline__ void xcd_barrier_complete(unsigned* bar, unsigned x, unsigned& nloc, unsigned& nx) {
    const unsigned G = gridDim.x * gridDim.y * gridDim.z;
    unsigned sum, cnt, mine, sp = 0u;
    for (;;) {
        sum = 0u; cnt = 0u; mine = 0u;
#pragma unroll
        for (unsigned j = 0; j < 16; ++j) { const unsigned c = xb_ld(&bar[XB_XCNT(j)]); sum += c; cnt += (c > 0u) ? 1u : 0u; mine = (j == x) ? c : mine; }
        if (sum == G) break;
        __builtin_amdgcn_s_sleep(1);
        if ((++sp & 255u) == 0u) { if (xb_ld(&bar[XB_TMO])) break; if (sp > XB_SPIN_CAP) { atomicAdd(&bar[XB_TMO], 1u); break; } }
    }
    nloc = mine > 0u ? mine : 1u; nx = cnt > 0u ? cnt : 1u;
}
__device__ __forceinline__ void xcd_barrier(const XcdBarrier& b, int wid_s) {
    asm volatile("s_waitcnt vmcnt(0)" ::: "memory");
    __syncthreads();
    if (wid_s == 0 && lane_id_() == 0) {
        unsigned* bar = b.bar;
        __builtin_amdgcn_s_waitcnt(0);
        unsigned nloc = b.st[0], nx = b.st[1];
        if (nloc == 0u) { xcd_barrier_complete(bar, b.x, nloc, nx); b.st[0] = nloc; b.st[1] = nx; }
        const unsigned old = xb_add(&bar[XB_XSUB(b.x)], 1u);
        const unsigned gen = old / nloc;
        if (old + 1u == (gen + 1u) * nloc) {
            __builtin_amdgcn_fence(__ATOMIC_RELEASE, "agent");
            asm volatile("s_waitcnt vmcnt(0)" ::: "memory");
            const unsigned og = xb_add(&bar[XB_TOP], 1u);
            const unsigned tg = og / nx;
            if (og + 1u == (tg + 1u) * nx) xb_add(&bar[XB_TOPGEN], 1u);
            else XB_SPIN(xb_ld(&bar[XB_TOPGEN]) == tg, bar);
            __builtin_amdgcn_fence(__ATOMIC_ACQUIRE, "agent");
            xb_add(&bar[XB_XGEN(b.x)], 1u);
            asm volatile("s_waitcnt vmcnt(0)" ::: "memory");
        } else {
            XB_SPIN(xb_ld(&bar[XB_XGEN(b.x)]) == gen, bar);
            __builtin_amdgcn_fence(__ATOMIC_ACQUIRE, "agent");
            asm volatile("s_waitcnt vmcnt(0)" ::: "memory");
        }
    }
    __syncthreads();
}

__global__ void __launch_bounds__(512, 2) mega_fwd(Params p) {
    extern __shared__ __attribute__((aligned(16))) unsigned char lds_raw[];
    LAS unsigned char* lds = (LAS unsigned char*)lds_raw;
    cg::grid_group grid = cg::this_grid();
    unsigned char* ws = p.ws;
    const int G = gridDim.x;
    const int wid_s = __builtin_amdgcn_readfirstlane((int)threadIdx.x >> 6);
    if (threadIdx.x < 4) ((LAS unsigned*)(lds + XBAR_LDS_OFF))[threadIdx.x] = 0u;
    __syncthreads();
    const XcdBarrier xbar = xcd_barrier_post((unsigned*)(ws + WS_BAR), (volatile LAS unsigned*)(lds + XBAR_LDS_OFF), wid_s);

#ifndef PM
#define PM 0xff
#endif
    if (PM & 1) phase_prep(p, lds, wid_s);
    grid.sync();

    for (int l = 0; l < DEPTH; ++l) {
        for (int grp = 0; grp < NGRP; ++grp) {
            const size_t r0 = (size_t)grp * MG;
            if (PM & 2) {
                pg8::Gemm g{(const bf16_t*)(ws + WS_XBF) + r0 * DM, (const bf16_t*)(ws + WS_WIN) + (size_t)l * NIN * DM, MG, NIN, DM};
                pg8::StaticOrder S; S.init(MG, NIN, G, (int)blockIdx.x);
                Epi1 E{(bf16_t*)(ws + WS_PROJ), (const float*)(ws + WS_SSQX) + r0 * 16, (float*)(ws + WS_SSQV), p.b_merge + (size_t)l * 2 * DM};
                pg8::gemm_phase<Epi1>(lds, g, S, E, wid_s);
#ifdef REPG1
                pg8::gemm_phase<Epi1>(lds, g, S, E, wid_s);
#endif
            }
            xcd_barrier(xbar, wid_s);
            if (PM & 4) {
                const unsigned epoch = (unsigned)(l * NGRP + grp + 1);
#ifndef REPB
#define REPB 1
#define REPA 1
#endif
                for (int rep = 0; rep < REPB; ++rep)
                mixerB_phase(p, lds, l, wid_s);
                for (int rep = 0; rep < REPA; ++rep)
                mixerA_phase(p, lds, l, wid_s);
                __syncthreads();
            }
            xcd_barrier(xbar, wid_s);
            if (PM & 8) {
                pg8::Gemm g{(const bf16_t*)(ws + WS_Y), (const bf16_t*)(ws + WS_WP) + (size_t)l * DM * 2048, MG, DM, 2048};
                pg8::StaticOrder S; S.init(MG, DM, G, (int)blockIdx.x);
                Epi2 E{(const bf16_t*)(ws + WS_PROJ) + (size_t)5 * MG * DM, (const bf16_t*)(ws + WS_PROJ) + (size_t)6 * MG * DM, (bf16_t*)(ws + WS_MB)};
                pg8::gemm_phase<Epi2>(lds, g, S, E, wid_s);
#ifdef REPG2
                pg8::gemm_phase<Epi2>(lds, g, S, E, wid_s);
#endif
            }
            xcd_barrier(xbar, wid_s);
            if (PM & 16) {
                pg8::Gemm g{(const bf16_t*)(ws + WS_MB), (const bf16_t*)(ws + WS_WO) + (size_t)l * DM * DM, MG, DM, DM};
                pg8::StaticOrder S; S.init(MG, DM, G, (int)blockIdx.x);
                Epi3 E{l == 0 ? p.x + r0 * DM : nullptr, nullptr, (bf16_t*)(ws + WS_XBF) + r0 * DM, (float*)(ws + WS_SSQX) + r0 * 16};
                pg8::gemm_phase<Epi3>(lds, g, S, E, wid_s);
            }
            if (NGRP == 1) xcd_barrier(xbar, wid_s);
        }
    }
    xcd_barrier(xbar, wid_s);
    if (PM & 32) phase_final(p, wid_s);
}

extern "C" void kernel_launch(void* const* d_in, const int* in_sizes, int n_in, void* d_out, int out_size, void* d_ws, size_t ws_size, hipStream_t stream) {
    static int grid_blocks = 0;
    if (grid_blocks == 0) {
        if (ws_size < WS_END) { fprintf(stderr, "kernel_launch: workspace too small (%zu < %zu)\n", ws_size, (size_t)WS_END); grid_blocks = -1; return; }
        int dev = 0, cus = 0, per_cu = 0;
        hipGetDevice(&dev);
        hipDeviceGetAttribute(&cus, hipDeviceAttributeMultiprocessorCount, dev);
        hipFuncSetAttribute((const void*)mega_fwd, hipFuncAttributeMaxDynamicSharedMemorySize, LDS_BYTES);
        hipOccupancyMaxActiveBlocksPerMultiprocessor(&per_cu, (const void*)mega_fwd, 512, LDS_BYTES);
        if (per_cu < 1) per_cu = 1;
        grid_blocks = cus * 1;
        fprintf(stderr, "kernel_launch: cus %d per_cu %d grid %d\n", cus, per_cu, grid_blocks);
    }
    if (grid_blocks < 0) return;
    Params p{};
    p.x = (const float*)d_in[0]; p.norm_g = (const float*)d_in[1]; p.w_in = (const float*)d_in[2]; p.b_merge = (const float*)d_in[3]; p.v_norm_g = (const float*)d_in[4];
    p.w_spatial = (const float*)d_in[5]; p.b_spatial = (const float*)d_in[6]; p.conv_w = (const float*)d_in[7]; p.conv_b = (const float*)d_in[8];
    p.w_rgate = (const float*)d_in[9]; p.b_rgate = (const float*)d_in[10]; p.w_igate = (const float*)d_in[11]; p.b_igate = (const float*)d_in[12]; p.lru_lambda = (const float*)d_in[13];
    p.w_proj_a = (const float*)d_in[14]; p.w_proj_b = (const float*)d_in[15]; p.w_out = (const float*)d_in[16]; p.final_g = (const float*)d_in[17];
    p.out = (float*)d_out; p.ws = (unsigned char*)d_ws;
    hipMemsetAsync((unsigned char*)d_ws + WS_BAR, 0, 16384, stream);
    void* args[] = {&p};
    hipError_t e = hipLaunchCooperativeKernel((const void*)mega_fwd, dim3(grid_blocks), dim3(512), args, LDS_BYTES, stream);
    if (e != hipSuccess) fprintf(stderr, "cooperative launch failed: %s (grid %d)\n", hipGetErrorString(e), grid_blocks);
}
```

```cpp
#include <hip/hip_runtime.h>
#include <hip/hip_cooperative_groups.h>
#include <cstdio>
namespace cg = cooperative_groups;

#define LAS __attribute__((address_space(3)))
typedef unsigned short bf16_t;
typedef short bf16x8 __attribute__((ext_vector_type(8)));
typedef float f32x4 __attribute__((ext_vector_type(4)));
typedef unsigned u32x4 __attribute__((ext_vector_type(4)));
typedef unsigned u32x2 __attribute__((ext_vector_type(2)));
typedef float f32x2 __attribute__((ext_vector_type(2)));

constexpr int DM = 1024, NBATCH = 16, SEQ = 4096, MTOT = NBATCH * SEQ, DEPTH = 4, NIN = 7168;
constexpr int NGRP = 2, MG = MTOT / NGRP, BG = NBATCH / NGRP;
constexpr int LSEG = 128, NSEG = SEQ / LSEG;
constexpr int NBITEM = BG * 8 * NSEG, NAITEM = (MG / 128) * 8;
constexpr float EPS = 1e-6f;
constexpr int LDS_BYTES = 142848 + 16;

constexpr size_t WS_WIN = 0;
constexpr size_t WS_WP = WS_WIN + (size_t)DEPTH * NIN * DM * 2;
constexpr size_t WS_WO = WS_WP + (size_t)DEPTH * DM * 2048 * 2;
constexpr size_t WS_WSB = WS_WO + (size_t)DEPTH * DM * DM * 2;
constexpr size_t WS_WRT = WS_WSB + (size_t)DEPTH * 8 * 128 * 128 * 2;
constexpr size_t WS_WIT = WS_WRT + (size_t)DEPTH * 8 * 128 * 128 * 2;
constexpr size_t WS_XBF = WS_WIT + (size_t)DEPTH * 8 * 128 * 128 * 2;
constexpr size_t WS_SSQX = WS_XBF + (size_t)MTOT * DM * 2;
constexpr size_t WS_SSQV = WS_SSQX + (size_t)MTOT * 16 * 4;
constexpr size_t WS_PROJ = WS_SSQV + (size_t)MG * 16 * 4;
constexpr size_t WS_Y = WS_PROJ + (size_t)7 * MG * DM * 2;
constexpr size_t WS_MB = WS_Y + (size_t)MG * 2048 * 2;
constexpr size_t WS_PAY = WS_MB + (size_t)MG * DM * 2;
constexpr size_t WS_PAYP = WS_PAY + (size_t)NBITEM * 8 * 16 * 8;
constexpr size_t WS_FLG = WS_PAYP + (size_t)NBITEM * 8 * 16 * 4;
constexpr size_t WS_BAR = WS_FLG + (size_t)NBITEM * 8 * 4;
constexpr size_t WS_END = WS_BAR + 16384;

struct Params {
    const float* x; const float* norm_g; const float* w_in; const float* b_merge; const float* v_norm_g; const float* w_spatial; const float* b_spatial;
    const float* conv_w; const float* conv_b; const float* w_rgate; const float* b_rgate; const float* w_igate; const float* b_igate; const float* lru_lambda;
    const float* w_proj_a; const float* w_proj_b; const float* w_out; const float* final_g;
    float* out; unsigned char* ws;
};

__device__ __forceinline__ float shfl_idx_(float v, int src_lane) { return __uint_as_float((unsigned)__builtin_amdgcn_ds_bpermute(src_lane << 2, (int)__float_as_uint(v))); }
__device__ __forceinline__ int lane_id_() { return (int)__builtin_amdgcn_mbcnt_hi(~0u, __builtin_amdgcn_mbcnt_lo(~0u, 0u)); }
__device__ __forceinline__ unsigned cvt_pk_bf16(float lo, float hi) { unsigned r; asm volatile("v_cvt_pk_bf16_f32 %0, %1, %2" : "=v"(r) : "v"(lo), "v"(hi)); return r; }
__device__ __forceinline__ float bf_lo(unsigned w) { return __uint_as_float(w << 16); }
__device__ __forceinline__ float bf_hi(unsigned w) { return __uint_as_float(w & 0xffff0000u); }
__device__ __forceinline__ float fast_rcp(float x) { return __builtin_amdgcn_rcpf(x); }
__device__ __forceinline__ float fast_exp2(float x) { return __builtin_amdgcn_exp2f(x); }
__device__ __forceinline__ float sigmoidf_(float x) { return fast_rcp(1.0f + fast_exp2(-1.4426950409f * x)); }

namespace pg8 {
constexpr int BM = 256, BK = 64, HALF = 128, HTB = HALF * BK * 2, STAGE_BYTES = 8 * HTB, NXCD = 8, WGM = 8;
__host__ __device__ __forceinline__ int lds_byte(int r, int c) { const int st = (r >> 4) * 2 + (c >> 5), rr = r & 15, cc = c & 31, ob = rr * 64 + cc * 2; return st * 1024 + (ob ^ (((ob >> 9) & 1) << 5)); }
__host__ __device__ __forceinline__ void stage_rc(int b, int& R, int& C) { const int st = b / 1024, sb = b % 1024, swz = sb ^ (((sb >> 9) & 1) << 5); R = (st >> 1) * 16 + swz / 64; C = (st & 1) * 32 + (swz % 64) / 2; }
__host__ __device__ __forceinline__ int perm32(int rho) { const int n = rho >> 4, i = rho & 15; return 8 * (i >> 2) + 4 * n + (i & 3); }
struct Unit { int pm, pn; };
struct Gemm { const bf16_t* A; const bf16_t* Bt; int M, N, K; };
struct StaticOrder {
    int nM, nN, nwg, G, c;
    __device__ void init(int M, int N, int G_, int c_) { nM = M / BM; nN = N / BM; nwg = nM * nN; G = G_; c = c_; }
    __device__ bool next(int i, Unit& u) const {
        const long L = (long)i * G + c; if (L >= nwg) return false;
        int wgid = (int)L; { const int q = nwg / NXCD, r = nwg % NXCD, xcd = wgid % NXCD, off = wgid / NXCD; wgid = (xcd < r ? xcd * (q + 1) : r * (q + 1) + (xcd - r) * q) + off; }
        const int nig = WGM * nN, gid = wgid / nig, fm = gid * WGM, gsz = (nM - fm) < WGM ? (nM - fm) : WGM;
        u.pm = fm + ((wgid % nig) % gsz); u.pn = (wgid % nig) / gsz; return true;
    }
};
template <class Epi>
__device__ __forceinline__ void gemm_phase(LAS unsigned char* lds, const Gemm g, const StaticOrder& S, const Epi& E, int wid_s) {
    int tid_ = wid_s * 64 + lane_id_(); asm volatile("" : "+v"(tid_));
    const int tid = tid_, wid = __builtin_amdgcn_readfirstlane(tid >> 6), lane = tid & 63, wr = wid >> 2, wc = wid & 3, fr = lane & 15, fq = lane >> 4;
    const int K = g.K, nt = K / BK;
    unsigned voffA[2], voffB[2];
#pragma unroll
    for (int i = 0; i < 2; ++i) { int R, C; stage_rc(tid * 16 + i * 8192, R, C); const int Rb = ((R & ~31) + perm32(R & 31));
        voffA[i] = (unsigned)(R * K + C) * 2u; voffB[i] = (unsigned)(Rb * K + C) * 2u; }
    const size_t kstep = (size_t)(BK * 2);
    const size_t hstep = (size_t)HALF * K * 2;
    const size_t tstep = 2 * hstep;
    const unsigned ldsw = (unsigned)wid * 1024u;
    const int aoff = lds_byte(wr * 64 + fr, fq * 8), boff = lds_byte(wc * 32 + fr, fq * 8);
#define PG8_SA(b, h) (((b) * 2 + (h)) * HTB)
#define PG8_SB(b, h) ((4 + (b) * 2 + (h)) * HTB)
#define PG8_STAGE(bufoff, gbase, voff) do { _Pragma("unroll") for (int _i = 0; _i < 2; ++_i) \
        __builtin_amdgcn_global_load_lds((const unsigned*)((const char*)(gbase) + (voff)[_i]), (LAS unsigned*)(lds + (bufoff) + ldsw + _i * 8192), 16, 0, 0); } while (0)
#define PG8_LDA(dst, b, h) do { _Pragma("unroll") for (int m = 0; m < 4; ++m) _Pragma("unroll") for (int k = 0; k < 2; ++k) dst[m][k] = *(const LAS bf16x8*)(lds + PG8_SA(b, h) + aoff + m * 2048 + k * 1024); } while (0)
#define PG8_LDB(dst, b, h) do { _Pragma("unroll") for (int n = 0; n < 2; ++n) _Pragma("unroll") for (int k = 0; k < 2; ++k) dst[n][k] = *(const LAS bf16x8*)(lds + PG8_SB(b, h) + boff + n * 2048 + k * 1024); } while (0)
#define PG8_MMA(ai, bj, At, Bt) do { __builtin_amdgcn_s_setprio(1); _Pragma("unroll") for (int m = 0; m < 4; ++m) _Pragma("unroll") for (int n = 0; n < 2; ++n) _Pragma("unroll") for (int k = 0; k < 2; ++k) \
        acc[ai][bj][m][n] = __builtin_amdgcn_mfma_f32_16x16x32_bf16(Bt[n][k], At[m][k], acc[ai][bj][m][n], 0, 0, 0); __builtin_amdgcn_s_setprio(0); } while (0)
#define PG8_WAIT_V(n) asm volatile("s_waitcnt vmcnt(" #n ")" ::: "memory")
#define PG8_WAIT_L(n) asm volatile("s_waitcnt lgkmcnt(" #n ")" ::: "memory")
#define PG8_BAR __builtin_amdgcn_s_barrier()
#define PG8_SCHED __builtin_amdgcn_sched_barrier(0)
    Unit cur, nxt; int ui = 0;
    if (!S.next(0, cur)) return;
    float est[8]; int est_pm = -1;
#pragma unroll
    for (int i = 0; i < 8; ++i) est[i] = 0.f;
    f32x4 acc[2][2][4][2];
#pragma unroll
    for (int a = 0; a < 2; ++a)
#pragma unroll
        for (int b = 0; b < 2; ++b)
#pragma unroll
            for (int m = 0; m < 4; ++m)
#pragma unroll
                for (int n = 0; n < 2; ++n) acc[a][b][m][n] = (f32x4){0.f, 0.f, 0.f, 0.f};
    bf16x8 At[4][2], B0[2][2], B1[2][2];
    const char* cA = (const char*)g.A + (size_t)cur.pm * tstep; const char* cB = (const char*)g.Bt + (size_t)cur.pn * tstep;
    PG8_STAGE(PG8_SB(0, 0), cB, voffB); PG8_STAGE(PG8_SB(0, 1), cB + hstep, voffB); PG8_STAGE(PG8_SA(0, 0), cA, voffA); PG8_STAGE(PG8_SA(0, 1), cA + hstep, voffA);
    if (wr == 1) PG8_BAR;
    PG8_WAIT_V(2); PG8_BAR;
    PG8_STAGE(PG8_SB(1, 0), cB + kstep, voffB); PG8_STAGE(PG8_SA(1, 0), cA + kstep, voffA); PG8_STAGE(PG8_SB(1, 1), cB + hstep + kstep, voffB);
    PG8_WAIT_V(6); PG8_BAR;
    for (;;) {
        const bool has_next = S.next(ui + 1, nxt);
        const char* nA = has_next ? (const char*)g.A + (size_t)nxt.pm * tstep : cA; const char* nB = has_next ? (const char*)g.Bt + (size_t)nxt.pn * tstep : cB;
        for (int t = 0; t < nt; t += 2) {
            const bool last = (t == nt - 2);
            const char* a1 = cA + (size_t)(t + 1) * kstep;
            const char* a2 = last ? nA : cA + (size_t)(t + 2) * kstep; const char* b2 = last ? nB : cB + (size_t)(t + 2) * kstep;
            const char* a3 = a2 + kstep; const char* b3 = b2 + kstep;
            if constexpr (Epi::HAS_MID) { if (t == nt / 2) E.mid(acc, cur, wr, wc, fr, fq); }
            PG8_LDB(B0, 0, 0); PG8_LDB(B1, 0, 1); PG8_SCHED; PG8_LDA(At, 0, 0); PG8_STAGE(PG8_SA(1, 1), a1 + hstep, voffA);
            PG8_WAIT_V(8); PG8_WAIT_L(0); PG8_BAR; PG8_MMA(0, 0, At, B0); PG8_MMA(0, 1, At, B1); PG8_BAR; PG8_SCHED;
            PG8_LDA(At, 0, 1); PG8_STAGE(PG8_SB(0, 0), b2, voffB); PG8_STAGE(PG8_SB(0, 1), b2 + hstep, voffB); PG8_STAGE(PG8_SA(0, 0), a2, voffA);
            PG8_WAIT_V(8); PG8_WAIT_L(0); PG8_BAR; PG8_MMA(1, 0, At, B0); PG8_MMA(1, 1, At, B1); PG8_BAR; PG8_SCHED;
            PG8_LDB(B0, 1, 0); PG8_LDB(B1, 1, 1); PG8_SCHED; PG8_LDA(At, 1, 0); PG8_STAGE(PG8_SA(0, 1), a2 + hstep, voffA);
            PG8_WAIT_V(8); PG8_WAIT_L(0); PG8_BAR; PG8_MMA(0, 0, At, B0); PG8_MMA(0, 1, At, B1); PG8_BAR; PG8_SCHED;
            PG8_LDA(At, 1, 1); PG8_STAGE(PG8_SB(1, 0), b3, voffB); PG8_STAGE(PG8_SB(1, 1), b3 + hstep, voffB); PG8_STAGE(PG8_SA(1, 0), a3, voffA);
            PG8_WAIT_V(8); PG8_WAIT_L(0); PG8_BAR; PG8_MMA(1, 0, At, B0); PG8_MMA(1, 1, At, B1); PG8_BAR; PG8_SCHED;
        }
        if (wr == 0) PG8_BAR;
        E(acc, cur, wr, wc, fr, fq, est, est_pm);
        if (!has_next) break;
#pragma unroll
        for (int a = 0; a < 2; ++a)
#pragma unroll
            for (int b = 0; b < 2; ++b)
#pragma unroll
                for (int m = 0; m < 4; ++m)
#pragma unroll
                    for (int n = 0; n < 2; ++n) acc[a][b][m][n] = (f32x4){0.f, 0.f, 0.f, 0.f};
        cur = nxt; cA = nA; cB = nB; ++ui;
        if (wr == 1) PG8_BAR;
    }
    PG8_WAIT_V(0);
    PG8_BAR;
#undef PG8_SA
#undef PG8_SB
#undef PG8_STAGE
#undef PG8_LDA
#undef PG8_LDB
#undef PG8_MMA
#undef PG8_WAIT_V
#undef PG8_WAIT_L
#undef PG8_BAR
#undef PG8_SCHED
}
}

struct Epi1 {
    static constexpr bool HAS_MID = false;
    bf16_t* proj; const float* ssqx; float* ssqv; const float* bm;
    __device__ __forceinline__ void mid(f32x4 (&)[2][2][4][2], const pg8::Unit&, int, int, int, int) const {}
    __device__ __forceinline__ void operator()(const f32x4 (&acc)[2][2][4][2], const pg8::Unit& u, int wr, int wc, int fr, int fq, float (&est)[8], int& est_pm) const {
        const int pn = u.pn; const bool uz = pn < 8, gg = pn >= 20;
        const int seg = uz ? 0 : (pn < 12 ? 1 : (gg ? 5 : (pn >> 2)));
        const int colt = uz ? pn * 128 : (gg ? (pn - 20) * 128 : (pn & 3) * 256);
        bf16_t* base = proj + (size_t)seg * MG * DM;
        const int row0 = u.pm * 256 + wr * 64 + fr, colw = wc * 32 + 8 * fq;
        const float G1c = -2.3022082f, G3c = -2.3022082f * 0.044715f, S1c = -1.4426950409f;
        const float c1_0 = (seg <= 1) ? G1c : S1c, c3_0 = (seg <= 1) ? G3c : 0.f;
        const float c1_1 = (seg == 1) ? G1c : S1c, c3_1 = (seg == 1) ? G3c : 0.f;
        const bool numx = (seg <= 4), raw = (seg == 3);
        float cb[2][8];
#pragma unroll
        for (int bj = 0; bj < 2; ++bj)
#pragma unroll
            for (int j = 0; j < 8; ++j) cb[bj][j] = gg ? -1.4426950409f * bm[bj * DM + colt + colw + j] : 0.f;
        if (u.pm != est_pm) {
            est_pm = u.pm;
            f32x4 pp[2][4];
#pragma unroll
            for (int ai = 0; ai < 2; ++ai)
#pragma unroll
                for (int m = 0; m < 4; ++m) pp[ai][m] = *(const f32x4*)(ssqx + (size_t)(row0 + ai * 128 + m * 16) * 16 + fq * 4);
#pragma unroll
            for (int ai = 0; ai < 2; ++ai)
#pragma unroll
                for (int m = 0; m < 4; ++m) { float s = (pp[ai][m][0] + pp[ai][m][1]) + (pp[ai][m][2] + pp[ai][m][3]); s += shfl_idx_(s, (fq * 16 + fr) ^ 16); s += shfl_idx_(s, (fq * 16 + fr) ^ 32);
                    est[ai * 4 + m] = __builtin_amdgcn_rsqf(s * (1.0f / DM) + EPS); }
        }
#pragma unroll
        for (int ai = 0; ai < 2; ++ai)
#pragma unroll
            for (int m = 0; m < 4; ++m) {
                const int row = row0 + ai * 128 + m * 16;
                const float rstd = est[ai * 4 + m];
                float sq = 0.f;
                float v[2][8];
#pragma unroll
                for (int bj = 0; bj < 2; ++bj) {
                    const float c1 = bj ? c1_1 : c1_0, c3 = bj ? c3_1 : c3_0;
#pragma unroll
                    for (int n = 0; n < 2; ++n)
#pragma unroll
                        for (int j = 0; j < 4; ++j) v[bj][n * 4 + j] = acc[ai][bj][m][n][j] * rstd;
                    if (!raw) {
#pragma unroll
                        for (int j = 0; j < 8; ++j) { const float x = v[bj][j]; const float arg = x * (c1 + c3 * x * x) + cb[bj][j]; const float r = fast_rcp(1.0f + fast_exp2(arg)); v[bj][j] = numx ? x * r : r; }
                    }
                    if (seg == 1) {
#pragma unroll
                        for (int j = 0; j < 8; ++j) sq += v[bj][j] * v[bj][j];
                    }
                }
                if (uz) {
                    u32x4 w; w.x = cvt_pk_bf16(v[0][0] * v[1][0], v[0][1] * v[1][1]); w.y = cvt_pk_bf16(v[0][2] * v[1][2], v[0][3] * v[1][3]);
                    w.z = cvt_pk_bf16(v[0][4] * v[1][4], v[0][5] * v[1][5]); w.w = cvt_pk_bf16(v[0][6] * v[1][6], v[0][7] * v[1][7]);
                    *(u32x4*)(base + (size_t)row * DM + colt + colw) = w;
                } else if (gg) {
                    float q[8];
#pragma unroll
                    for (int j = 0; j < 8; ++j) q[j] = v[0][j] * fast_rcp(fmaxf(v[1][j], 1e-30f));
                    u32x4 w; w.x = cvt_pk_bf16(q[0], q[1]); w.y = cvt_pk_bf16(q[2], q[3]); w.z = cvt_pk_bf16(q[4], q[5]); w.w = cvt_pk_bf16(q[6], q[7]);
                    *(u32x4*)(base + (size_t)row * DM + colt + colw) = w;
                    u32x4 w2; w2.x = cvt_pk_bf16(v[1][0], v[1][1]); w2.y = cvt_pk_bf16(v[1][2], v[1][3]); w2.z = cvt_pk_bf16(v[1][4], v[1][5]); w2.w = cvt_pk_bf16(v[1][6], v[1][7]);
                    *(u32x4*)(base + (size_t)MG * DM + (size_t)row * DM + colt + colw) = w2;
                } else {
#pragma unroll
                    for (int bj = 0; bj < 2; ++bj) {
                        u32x4 w; w.x = cvt_pk_bf16(v[bj][0], v[bj][1]); w.y = cvt_pk_bf16(v[bj][2], v[bj][3]); w.z = cvt_pk_bf16(v[bj][4], v[bj][5]); w.w = cvt_pk_bf16(v[bj][6], v[bj][7]);
                        *(u32x4*)(base + (size_t)row * DM + colt + bj * 128 + colw) = w;
                    }
                }
                if (seg == 1) { sq += shfl_idx_(sq, (fq * 16 + fr) ^ 16); sq += shfl_idx_(sq, (fq * 16 + fr) ^ 32); if (fq == 0) ssqv[(size_t)row * 16 + (pn & 3) * 4 + wc] = sq; }
            }
    }
};
struct Epi2 {
    static constexpr bool HAS_MID = true;
    const bf16_t* sa; const bf16_t* sb; bf16_t* mout;
    __device__ __forceinline__ void mid(f32x4 (&acc)[2][2][4][2], const pg8::Unit& u, int wr, int wc, int fr, int fq) const {
        int row0 = u.pm * 256 + wr * 64 + fr, col0 = u.pn * 256 + wc * 32 + 8 * fq;
        asm volatile("" : "+v"(row0), "+v"(col0));
#pragma unroll
        for (int ai = 0; ai < 2; ++ai) {
            u32x4 av[4][2];
#pragma unroll
            for (int m = 0; m < 4; ++m)
#pragma unroll
                for (int bj = 0; bj < 2; ++bj) av[m][bj] = *(const u32x4*)(sa + (size_t)(row0 + ai * 128 + m * 16) * DM + col0 + bj * 128);
#pragma unroll
            for (int m = 0; m < 4; ++m)
#pragma unroll
                for (int bj = 0; bj < 2; ++bj) {
#pragma unroll
                    for (int q = 0; q < 4; ++q) { acc[ai][bj][m][q >> 1][(q & 1) * 2] *= bf_lo(av[m][bj][q]); acc[ai][bj][m][q >> 1][(q & 1) * 2 + 1] *= bf_hi(av[m][bj][q]); }
                }
            asm volatile("" ::: "memory");
        }
    }
    __device__ __forceinline__ void operator()(const f32x4 (&acc)[2][2][4][2], const pg8::Unit& u, int wr, int wc, int fr, int fq, float (&)[8], int&) const {
        const int row0 = u.pm * 256 + wr * 64 + fr, col0 = u.pn * 256 + wc * 32 + 8 * fq;
        u32x4 bv[2][4][2];
#pragma unroll
        for (int ai = 0; ai < 2; ++ai)
#pragma unroll
            for (int m = 0; m < 4; ++m)
#pragma unroll
                for (int bj = 0; bj < 2; ++bj) bv[ai][m][bj] = *(const u32x4*)(sb + (size_t)(row0 + ai * 128 + m * 16) * DM + col0 + bj * 128);
#pragma unroll
        for (int ai = 0; ai < 2; ++ai)
#pragma unroll
            for (int m = 0; m < 4; ++m)
#pragma unroll
                for (int bj = 0; bj < 2; ++bj) {
                    const size_t off = (size_t)(row0 + ai * 128 + m * 16) * DM + col0 + bj * 128;
                    const u32x4 b = bv[ai][m][bj];
                    u32x4 w;
#pragma unroll
                    for (int q = 0; q < 4; ++q) w[q] = cvt_pk_bf16(acc[ai][bj][m][q >> 1][(q & 1) * 2] * bf_lo(b[q]), acc[ai][bj][m][q >> 1][(q & 1) * 2 + 1] * bf_hi(b[q]));
                    *(u32x4*)(mout + off) = w;
                }
    }
};
struct Epi3 {
    static constexpr bool HAS_MID = false;
    const float* xin_f; float* xout_f; bf16_t* xbf; float* ssqx;
    __device__ __forceinline__ void mid(f32x4 (&)[2][2][4][2], const pg8::Unit&, int, int, int, int) const {}
    __device__ __forceinline__ void operator()(const f32x4 (&acc)[2][2][4][2], const pg8::Unit& u, int wr, int wc, int fr, int fq, float (&)[8], int&) const {
        const int row0 = u.pm * 256 + wr * 64 + fr, col0 = u.pn * 256 + wc * 32 + 8 * fq;
#pragma unroll
        for (int ai = 0; ai < 2; ++ai) {
            f32x4 xv[4][2][2];
            if (xin_f) {
#pragma unroll
                for (int m = 0; m < 4; ++m)
#pragma unroll
                    for (int bj = 0; bj < 2; ++bj) { const size_t off = (size_t)(row0 + ai * 128 + m * 16) * DM + col0 + bj * 128; xv[m][bj][0] = *(const f32x4*)(xin_f + off); xv[m][bj][1] = *(const f32x4*)(xin_f + off + 4); }
            } else {
                u32x4 xb_[4][2];
#pragma unroll
                for (int m = 0; m < 4; ++m)
#pragma unroll
                    for (int bj = 0; bj < 2; ++bj) xb_[m][bj] = *(const u32x4*)(xbf + (size_t)(row0 + ai * 128 + m * 16) * DM + col0 + bj * 128);
#pragma unroll
                for (int m = 0; m < 4; ++m)
#pragma unroll
                    for (int bj = 0; bj < 2; ++bj) { const u32x4 w = xb_[m][bj];
                        xv[m][bj][0] = (f32x4){bf_lo(w.x), bf_hi(w.x), bf_lo(w.y), bf_hi(w.y)}; xv[m][bj][1] = (f32x4){bf_lo(w.z), bf_hi(w.z), bf_lo(w.w), bf_hi(w.w)}; }
            }
#pragma unroll
            for (int m = 0; m < 4; ++m) {
                const int row = row0 + ai * 128 + m * 16; float sq = 0.f;
#pragma unroll
                for (int bj = 0; bj < 2; ++bj) {
                    const size_t off = (size_t)row * DM + col0 + bj * 128;
                    const f32x4 x0 = xv[m][bj][0] + acc[ai][bj][m][0], x1 = xv[m][bj][1] + acc[ai][bj][m][1];
                    sq += (x0[0] * x0[0] + x0[1] * x0[1]) + (x0[2] * x0[2] + x0[3] * x0[3]) + (x1[0] * x1[0] + x1[1] * x1[1]) + (x1[2] * x1[2] + x1[3] * x1[3]);
                    if (xout_f) { *(f32x4*)(xout_f + off) = x0; *(f32x4*)(xout_f + off + 4) = x1; }
                    else { u32x4 w; w.x = cvt_pk_bf16(x0[0], x0[1]); w.y = cvt_pk_bf16(x0[2], x0[3]); w.z = cvt_pk_bf16(x1[0], x1[1]); w.w = cvt_pk_bf16(x1[2], x1[3]); *(u32x4*)(xbf + off) = w; }
                }
                sq += shfl_idx_(sq, (fq * 16 + fr) ^ 16); sq += shfl_idx_(sq, (fq * 16 + fr) ^ 32);
                if (fq == 0) ssqx[(size_t)row * 16 + u.pn * 4 + wc] = sq;
            }
            asm volatile("" ::: "memory");
        }
    }
};

struct TrJob { const float* src; const float* scale; bf16_t* dst; int C, ldd, coff, r0, c0; };
__device__ __forceinline__ TrJob tr_decode(const Params& p, int t) {
    unsigned char* ws = p.ws;
    const int l = t / 2624; int q = t % 2624; TrJob j;
    if (q < 1792) { j.src = p.w_in + (size_t)l * DM * NIN; j.C = NIN; j.scale = p.norm_g + l * DM; j.ldd = DM; j.coff = 0; j.r0 = (q / 112) * 64; j.c0 = (q % 112) * 64;
        const int n = j.c0; int d0 = n;
        if (n < 1024) d0 = (n >> 7) * 256 + (n & 127); else if (n < 2048) d0 = 2048 + (n - 1024); else if (n < 3072) d0 = ((n - 2048) >> 7) * 256 + 128 + ((n - 2048) & 127);
        else if (n >= 6144) d0 = 5120 + ((n - 6144) >> 7) * 256 + 128 + ((n - 6144) & 127); else if (n >= 5120) d0 = 5120 + ((n - 5120) >> 7) * 256 + ((n - 5120) & 127);
        j.dst = (bf16_t*)(ws + WS_WIN) + (size_t)l * NIN * DM + (ptrdiff_t)(d0 - j.c0) * DM; return j; }
    q -= 1792; j.scale = nullptr;
    if (q < 256) { j.src = p.w_proj_a + (size_t)l * DM * DM; j.C = DM; j.dst = (bf16_t*)(ws + WS_WP) + (size_t)l * DM * 2048; j.ldd = 2048; j.coff = 0; j.r0 = (q / 16) * 64; j.c0 = (q % 16) * 64; return j; }
    q -= 256;
    if (q < 256) { j.src = p.w_proj_b + (size_t)l * DM * DM; j.C = DM; j.dst = (bf16_t*)(ws + WS_WP) + (size_t)l * DM * 2048; j.ldd = 2048; j.coff = 1024; j.r0 = (q / 16) * 64; j.c0 = (q % 16) * 64; return j; }
    q -= 256;
    if (q < 256) { j.src = p.w_out + (size_t)l * DM * DM; j.C = DM; j.dst = (bf16_t*)(ws + WS_WO) + (size_t)l * DM * DM; j.ldd = DM; j.coff = 0; j.r0 = (q / 16) * 64; j.c0 = (q % 16) * 64; return j; }
    q -= 256;
    const bool ig = q >= 32; if (ig) q -= 32;
    const int h = q >> 2, tt = q & 3;
    j.src = (ig ? p.w_igate : p.w_rgate) + ((size_t)l * 8 + h) * 16384; j.C = 128; j.dst = (bf16_t*)(ws + (ig ? WS_WIT : WS_WRT)) + ((size_t)l * 8 + h) * 16384; j.ldd = 128; j.coff = 0; j.r0 = (tt >> 1) * 64; j.c0 = (tt & 1) * 64;
    return j;
}

__device__ void phase_prep(const Params& p, LAS unsigned char* lds, int wid_s) {
    int tid_ = wid_s * 64 + lane_id_(); asm volatile("" : "+v"(tid_));
    const int tid = tid_, G = gridDim.x;
    unsigned char* ws = p.ws;
    LAS float* tile = (LAS float*)lds;
    {
        const int NT = DEPTH * 2624;
        const int lr = tid >> 4, c4 = (tid & 15) * 4;
        int t = blockIdx.x;
        TrJob job; f32x4 v0, v1; float s0 = 1.f, s1 = 1.f;
        if (t < NT) { job = tr_decode(p, t);
            v0 = *(const f32x4*)(job.src + (size_t)(job.r0 + lr) * job.C + job.c0 + c4); v1 = *(const f32x4*)(job.src + (size_t)(job.r0 + 32 + lr) * job.C + job.c0 + c4);
            if (job.scale) { s0 = job.scale[job.r0 + lr]; s1 = job.scale[job.r0 + 32 + lr]; } }
        for (; t < NT; t += G) {
            TrJob nxt = job; f32x4 n0 = v0, n1 = v1; float ns0 = 1.f, ns1 = 1.f;
            if (t + G < NT) { nxt = tr_decode(p, t + G);
                n0 = *(const f32x4*)(nxt.src + (size_t)(nxt.r0 + lr) * nxt.C + nxt.c0 + c4); n1 = *(const f32x4*)(nxt.src + (size_t)(nxt.r0 + 32 + lr) * nxt.C + nxt.c0 + c4);
                if (nxt.scale) { ns0 = nxt.scale[nxt.r0 + lr]; ns1 = nxt.scale[nxt.r0 + 32 + lr]; } }
            tile[(c4 + 0) * 65 + lr] = v0[0] * s0; tile[(c4 + 1) * 65 + lr] = v0[1] * s0; tile[(c4 + 2) * 65 + lr] = v0[2] * s0; tile[(c4 + 3) * 65 + lr] = v0[3] * s0;
            tile[(c4 + 0) * 65 + 32 + lr] = v1[0] * s1; tile[(c4 + 1) * 65 + 32 + lr] = v1[1] * s1; tile[(c4 + 2) * 65 + 32 + lr] = v1[2] * s1; tile[(c4 + 3) * 65 + 32 + lr] = v1[3] * s1;
            __syncthreads();
            const int c = tid >> 3, r8 = (tid & 7) * 8;
            float f[8];
#pragma unroll
            for (int j = 0; j < 8; ++j) f[j] = tile[c * 65 + r8 + j];
            u32x4 w; w.x = cvt_pk_bf16(f[0], f[1]); w.y = cvt_pk_bf16(f[2], f[3]); w.z = cvt_pk_bf16(f[4], f[5]); w.w = cvt_pk_bf16(f[6], f[7]);
            *(u32x4*)(job.dst + (size_t)(job.c0 + c) * job.ldd + job.coff + job.r0 + r8) = w;
            __syncthreads();
            job = nxt; v0 = n0; v1 = n1; s0 = ns0; s1 = ns1;
        }
    }
    for (int e = blockIdx.x * 512 + tid; e < DEPTH * 8 * 128 * 128 / 8; e += G * 512) {
        const int s8 = (e & 15) * 8, t = (e >> 4) & 127;
        const f32x4 a = *(const f32x4*)(p.w_spatial + (size_t)e * 8), b = *(const f32x4*)(p.w_spatial + (size_t)e * 8 + 4);
        float f[8] = {a[0], a[1], a[2], a[3], b[0], b[1], b[2], b[3]};
#pragma unroll
        for (int j = 0; j < 8; ++j) f[j] = (s8 + j <= t) ? f[j] : 0.f;
        u32x4 w; w.x = cvt_pk_bf16(f[0], f[1]); w.y = cvt_pk_bf16(f[2], f[3]); w.z = cvt_pk_bf16(f[4], f[5]); w.w = cvt_pk_bf16(f[6], f[7]);
        *(u32x4*)((bf16_t*)(ws + WS_WSB) + (size_t)e * 8) = w;
    }
    {
        const int wave = tid >> 6, lane = tid & 63;
        bf16_t* xbf = (bf16_t*)(ws + WS_XBF); float* ssqx = (float*)(ws + WS_SSQX);
        for (int row = (blockIdx.x * 8 + wave) * 2; row < MTOT; row += G * 16) {
            f32x4 v[2][4];
#pragma unroll
            for (int r = 0; r < 2; ++r)
#pragma unroll
                for (int i = 0; i < 4; ++i) v[r][i] = *(const f32x4*)(p.x + (size_t)(row + r) * DM + i * 256 + lane * 4);
#pragma unroll
            for (int r = 0; r < 2; ++r) {
                float sq = 0.f;
#pragma unroll
                for (int i = 0; i < 4; ++i) {
                    sq += (v[r][i][0] * v[r][i][0] + v[r][i][1] * v[r][i][1]) + (v[r][i][2] * v[r][i][2] + v[r][i][3] * v[r][i][3]);
                    u32x2 w; w.x = cvt_pk_bf16(v[r][i][0], v[r][i][1]); w.y = cvt_pk_bf16(v[r][i][2], v[r][i][3]);
                    *(u32x2*)(xbf + (size_t)(row + r) * DM + i * 256 + lane * 4) = w;
                }
#pragma unroll
                for (int d = 1; d < 64; d <<= 1) sq += shfl_idx_(sq, lane ^ d);
                if (lane < 16) ssqx[(size_t)(row + r) * 16 + lane] = (lane == 0) ? sq : 0.f;
            }
        }
    }
    for (int e = blockIdx.x * 512 + tid; e < NBITEM * 8; e += G * 512) ((unsigned*)(ws + WS_FLG))[e] = 0u;
}

__device__ __forceinline__ void mixerA_phase(const Params& p, LAS unsigned char* lds, int l_in, int wid_s) {
    int tid_ = wid_s * 64 + lane_id_(); asm volatile("" : "+v"(tid_));
    int l = l_in; asm volatile("" : "+s"(l));
    const int tid = tid_, wid = tid >> 6, lane = tid & 63, fr = lane & 15, fq = lane >> 4;
    const int G = gridDim.x;
    unsigned char* ws = p.ws;
    const bf16_t* gu = (const bf16_t*)(ws + WS_PROJ); const bf16_t* gv = gu + (size_t)MG * DM;
    const float* ssqv = (const float*)(ws + WS_SSQV);
    bf16_t* ybuf = (bf16_t*)(ws + WS_Y);
    LAS bf16_t* sVT = (LAS bf16_t*)lds;
    const int tok = tid >> 2, cl = tid & 3;
    const int cb32 = (wid & 3) * 32, th = wid >> 2;
    const int Ge = G & ~7;
    if ((int)blockIdx.x >= Ge) return;
    const int gi = blockIdx.x & 7;
    const int cch = gi * 128 + cb32 + 8 * fq;
    bf16x8 wf[10]; f32x4 vg0, vg1; float bs[4];
    {
        const bf16_t* wsb = (const bf16_t*)(ws + WS_WSB) + ((size_t)l * 8 + gi) * 16384;
        int n = 0;
#pragma unroll
        for (int j = 0; j < 4; ++j) {
            const int i = th ? ((j == 0) ? 1 : (j == 1) ? 2 : (j == 2) ? 5 : 6) : ((j == 0) ? 0 : (j == 1) ? 3 : (j == 2) ? 4 : 7);
#pragma unroll
            for (int ks = 0; ks <= j; ++ks) { wf[n] = *(const bf16x8*)(wsb + (16 * i + fr) * 128 + ks * 32 + 8 * fq); ++n; }
            bs[j] = p.b_spatial[((size_t)l * 8 + gi) * 128 + 16 * i + fr];
        }
        vg0 = *(const f32x4*)(p.v_norm_g + l * DM + cch); vg1 = *(const f32x4*)(p.v_norm_g + l * DM + cch + 4);
    }
    u32x4 pv[4]; f32x4 pq[4];
#define A_LOAD(it_) do { const int rb_ = ((it_) >> 3) * 128, gi_ = (it_) & 7; \
        _Pragma("unroll") for (int i_ = 0; i_ < 4; ++i_) { pv[i_] = *(const u32x4*)(gv + (size_t)(rb_ + tok) * DM + gi_ * 128 + (4 * i_ + cl) * 8); pq[i_] = *(const f32x4*)(ssqv + (size_t)(rb_ + tok) * 16 + 4 * i_); } } while (0)
    int it = blockIdx.x;
    if (it < NAITEM) A_LOAD(it);
    for (; it < NAITEM; it += Ge) {
        const int chunk = it >> 3, rowbase = chunk * 128;
        u32x4 uu[4];
#pragma unroll
        for (int j = 0; j < 4; ++j) { const int i = th ? ((j == 0) ? 1 : (j == 1) ? 2 : (j == 2) ? 5 : 6) : ((j == 0) ? 0 : (j == 1) ? 3 : (j == 2) ? 4 : 7);
            uu[j] = *(const u32x4*)(gu + (size_t)(rowbase + 16 * i + fr) * DM + cch); }
        __syncthreads();
        {
            const f32x4 a = pq[0], b = pq[1], c = pq[2], d = pq[3];
            const float ssum = ((a[0] + a[1]) + (a[2] + a[3])) + ((b[0] + b[1]) + (b[2] + b[3])) + ((c[0] + c[1]) + (c[2] + c[3])) + ((d[0] + d[1]) + (d[2] + d[3]));
            const float rs = __builtin_amdgcn_rsqf(ssum * (1.0f / DM) + EPS);
#pragma unroll
            for (int i = 0; i < 4; ++i) {
                const int c8 = 4 * i + cl;
#pragma unroll
                for (int k = 0; k < 4; ++k) {
                    const unsigned pk = cvt_pk_bf16(bf_lo(pv[i][k]) * rs, bf_hi(pv[i][k]) * rs);
                    sVT[(c8 * 8 + 2 * k) * 136 + tok] = (bf16_t)(pk & 0xffffu);
                    sVT[(c8 * 8 + 2 * k + 1) * 136 + tok] = (bf16_t)(pk >> 16);
                }
            }
        }
        __syncthreads();
        if (it + Ge < NAITEM) A_LOAD(it + Ge);
        bf16x8 vf[2][4];
#pragma unroll
        for (int n2 = 0; n2 < 2; ++n2)
#pragma unroll
            for (int ks = 0; ks < 4; ++ks) vf[n2][ks] = *(const LAS bf16x8*)(sVT + (cb32 + 8 * (fr >> 2) + 4 * n2 + (fr & 3)) * 136 + ks * 32 + 8 * fq);
        int n = 0;
#pragma unroll
        for (int j = 0; j < 4; ++j) {
            const int i = th ? ((j == 0) ? 1 : (j == 1) ? 2 : (j == 2) ? 5 : 6) : ((j == 0) ? 0 : (j == 1) ? 3 : (j == 2) ? 4 : 7);
            f32x4 acc0 = (f32x4){0.f, 0.f, 0.f, 0.f}, acc1 = (f32x4){0.f, 0.f, 0.f, 0.f};
#pragma unroll
            for (int ks = 0; ks <= j; ++ks) { acc0 = __builtin_amdgcn_mfma_f32_16x16x32_bf16(vf[0][ks], wf[n], acc0, 0, 0, 0); acc1 = __builtin_amdgcn_mfma_f32_16x16x32_bf16(vf[1][ks], wf[n], acc1, 0, 0, 0); ++n; }
            const int t = 16 * i + fr;
            const u32x4 w = uu[j];
            const float y0 = bf_lo(w.x) * (vg0[0] * acc0[0] + bs[j]), y1 = bf_hi(w.x) * (vg0[1] * acc0[1] + bs[j]);
            const float y2 = bf_lo(w.y) * (vg0[2] * acc0[2] + bs[j]), y3 = bf_hi(w.y) * (vg0[3] * acc0[3] + bs[j]);
            const float y4 = bf_lo(w.z) * (vg1[0] * acc1[0] + bs[j]), y5 = bf_hi(w.z) * (vg1[1] * acc1[1] + bs[j]);
            const float y6 = bf_lo(w.w) * (vg1[2] * acc1[2] + bs[j]), y7 = bf_hi(w.w) * (vg1[3] * acc1[3] + bs[j]);
            u32x4 o; o.x = cvt_pk_bf16(y0, y1); o.y = cvt_pk_bf16(y2, y3); o.z = cvt_pk_bf16(y4, y5); o.w = cvt_pk_bf16(y6, y7);
            *(u32x4*)(ybuf + (size_t)(rowbase + t) * 2048 + cch) = o;
        }
    }
#undef A_LOAD
}

#define DPP_SHR(v, ident, d) __uint_as_float((unsigned)__builtin_amdgcn_update_dpp((int)__float_as_uint(ident), (int)__float_as_uint(v), 0x110 + (d), 0xf, 0xf, false))

constexpr int LSB = 256, NSB = SEQ / LSB, XB_OFF1 = LSB * 136 * 2, CW_OFF = 2 * XB_OFF1, AGG_OFF = CW_OFF + 2560, XBAR_LDS_OFF = AGG_OFF + 1024;
__device__ __forceinline__ void mixerB_phase(const Params& p, LAS unsigned char* lds, int l_in, int wid_s) {
    int tid_ = wid_s * 64 + lane_id_(); asm volatile("" : "+v"(tid_));
    int l = l_in; asm volatile("" : "+s"(l));
    const int tid = tid_, wid = __builtin_amdgcn_readfirstlane(tid >> 6), lane = tid & 63, fr = lane & 15, fq = lane >> 4;
    const int G = gridDim.x;
    unsigned char* ws = p.ws;
    const bf16_t* xb = (const bf16_t*)(ws + WS_PROJ) + (size_t)3 * MG * DM; const bf16_t* zb = (const bf16_t*)(ws + WS_PROJ) + (size_t)4 * MG * DM;
    bf16_t* ybuf = (bf16_t*)(ws + WS_Y);
    LAS float* sCW = (LAS float*)(lds + CW_OFF);
    LAS float* sAgg = (LAS float*)(lds + AGG_OFF);
    const int c8 = (tid & 15) * 8, t8 = (tid >> 4) * 8;
    const int chh = wid & 1, tq = wid >> 1;
    for (int task = blockIdx.x; task < BG * 8 * 4; task += G) {
        const int bh = task & (BG * 8 - 1), cq = task / (BG * 8), bl = bh >> 3, h = bh & 7;
        const int j0 = cq * 32 + chh * 16, chl = h * 128 + j0 + 4 * fq;
        __syncthreads();
        for (int e = tid; e < 640; e += 512) { const int k = e >> 7, c = e & 127; sCW[e] = (k < 4) ? p.conv_w[((size_t)l * 4 + k) * DM + h * 128 + c] : p.conv_b[(size_t)l * DM + h * 128 + c]; }
        bf16x8 wrf[4], wif[4]; f32x4 br, bi, nsp;
        {
            const bf16_t* wr_ = (const bf16_t*)(ws + WS_WRT) + ((size_t)l * 8 + h) * 16384 + (j0 + fr) * 128 + 8 * fq;
            const bf16_t* wi_ = (const bf16_t*)(ws + WS_WIT) + ((size_t)l * 8 + h) * 16384 + (j0 + fr) * 128 + 8 * fq;
#pragma unroll
            for (int ks = 0; ks < 4; ++ks) { wrf[ks] = *(const bf16x8*)(wr_ + ks * 32); wif[ks] = *(const bf16x8*)(wi_ + ks * 32); }
            br = *(const f32x4*)(p.b_rgate + (size_t)l * DM + chl); bi = *(const f32x4*)(p.b_igate + (size_t)l * DM + chl);
            const f32x4 lam = *(const f32x4*)(p.lru_lambda + (size_t)l * DM + chl);
#pragma unroll
            for (int r = 0; r < 4; ++r) { const float z = -lam[r]; nsp[r] = -8.0f * (fmaxf(z, 0.f) + log1pf(expf(-fabsf(z)))); }
        }
        u32x4 xr[11];
#define XB_LOAD(seg_) do { const int rb_ = bl * SEQ + (seg_) * LSB, ch_ = h * 128 + c8; \
        _Pragma("unroll") for (int r_ = 0; r_ < 11; ++r_) { const int t_ = t8 - 3 + r_; xr[r_] = (u32x4){0u, 0u, 0u, 0u}; \
            if (t_ >= 0 || (seg_) > 0) xr[r_] = *(const u32x4*)(xb + (size_t)(rb_ + t_) * DM + ch_); } } while (0)
        XB_LOAD(0);
        float S[4] = {0.f, 0.f, 0.f, 0.f};
        __syncthreads();
        for (int seg = 0; seg < NSB; ++seg) {
            const int rowbase = bl * SEQ + seg * LSB;
            LAS bf16_t* sXb = (LAS bf16_t*)(lds + (seg & 1) * XB_OFF1);
            {
                f32x2 cw2[5][4];
#pragma unroll
                for (int k = 0; k < 5; ++k) { const f32x4 a = *(const LAS f32x4*)(sCW + k * 128 + c8), b = *(const LAS f32x4*)(sCW + k * 128 + c8 + 4);
                    cw2[k][0] = (f32x2){a[0], a[1]}; cw2[k][1] = (f32x2){a[2], a[3]}; cw2[k][2] = (f32x2){b[0], b[1]}; cw2[k][3] = (f32x2){b[2], b[3]}; }
                f32x2 ur[11][4];
#pragma unroll
                for (int r = 0; r < 3; ++r)
#pragma unroll
                    for (int k = 0; k < 4; ++k) ur[r][k] = (f32x2){bf_lo(xr[r][k]), bf_hi(xr[r][k])};
#pragma unroll
                for (int tt = 0; tt < 8; ++tt) {
#pragma unroll
                    for (int k = 0; k < 4; ++k) ur[tt + 3][k] = (f32x2){bf_lo(xr[tt + 3][k]), bf_hi(xr[tt + 3][k])};
                    f32x2 o2[4];
#pragma unroll
                    for (int k = 0; k < 4; ++k) o2[k] = cw2[4][k] + cw2[0][k] * ur[tt][k] + cw2[1][k] * ur[tt + 1][k] + cw2[2][k] * ur[tt + 2][k] + cw2[3][k] * ur[tt + 3][k];
                    u32x4 w; w.x = cvt_pk_bf16(o2[0].x, o2[0].y); w.y = cvt_pk_bf16(o2[1].x, o2[1].y); w.z = cvt_pk_bf16(o2[2].x, o2[2].y); w.w = cvt_pk_bf16(o2[3].x, o2[3].y);
                    *(LAS u32x4*)(sXb + (t8 + tt) * 136 + c8) = w;
                }
            }
            __syncthreads();
            if (seg + 1 < NSB) XB_LOAD(seg + 1);
            u32x2 zz[4];
#pragma unroll
            for (int tt = 0; tt < 4; ++tt) zz[tt] = *(const u32x2*)(zb + (size_t)(rowbase + 64 * tq + 16 * tt + fr) * DM + chl);
            float Pt[4][4], Ht[4][4];
            float Pc[4] = {1.f, 1.f, 1.f, 1.f}, Hc[4] = {0.f, 0.f, 0.f, 0.f};
            f32x4 aRa[4], aIa[4]; u32x2 xcwa[4];
#pragma unroll
            for (int tt = 0; tt < 4; ++tt) {
                const int trow = 64 * tq + 16 * tt + fr;
                aRa[tt] = (f32x4){0.f, 0.f, 0.f, 0.f}; aIa[tt] = (f32x4){0.f, 0.f, 0.f, 0.f};
#pragma unroll
                for (int ks = 0; ks < 4; ++ks) {
                    const bf16x8 xf = *(const LAS bf16x8*)(sXb + trow * 136 + ks * 32 + 8 * fq);
                    aRa[tt] = __builtin_amdgcn_mfma_f32_16x16x32_bf16(wrf[ks], xf, aRa[tt], 0, 0, 0);
                    aIa[tt] = __builtin_amdgcn_mfma_f32_16x16x32_bf16(wif[ks], xf, aIa[tt], 0, 0, 0);
                }
                xcwa[tt] = *(const LAS u32x2*)(sXb + trow * 136 + j0 + 4 * fq);
            }
            __builtin_amdgcn_sched_barrier(0);
#pragma unroll
            for (int tt = 0; tt < 4; ++tt) {
                const f32x4 aR = aRa[tt], aI = aIa[tt];
                const u32x2 xcw = xcwa[tt];
                const f32x4 xc = (f32x4){bf_lo(xcw.x), bf_hi(xcw.x), bf_lo(xcw.y), bf_hi(xcw.y)};
                float Av[4], Bw[4];
#pragma unroll
                for (int pp = 0; pp < 2; ++pp) {
                    const f32x2 zr = ((f32x2){aR[2 * pp], aR[2 * pp + 1]} + (f32x2){br[2 * pp], br[2 * pp + 1]}) * -1.4426950409f;
                    const f32x2 zi = ((f32x2){aI[2 * pp], aI[2 * pp + 1]} + (f32x2){bi[2 * pp], bi[2 * pp + 1]}) * -1.4426950409f;
                    f32x2 er, ei; er.x = fast_exp2(zr.x); er.y = fast_exp2(zr.y); ei.x = fast_exp2(zi.x); ei.y = fast_exp2(zi.y);
                    const f32x2 dr = er + 1.0f, di = ei + 1.0f;
                    f32x2 rg, ig; rg.x = fast_rcp(dr.x); rg.y = fast_rcp(dr.y); ig.x = fast_rcp(di.x); ig.y = fast_rcp(di.y);
                    const f32x2 la = (f32x2){nsp[2 * pp], nsp[2 * pp + 1]} * rg;
                    const f32x2 la2 = la * 1.4426950409f;
                    f32x2 a; a.x = fast_exp2(la2.x); a.y = fast_exp2(la2.y);
                    const f32x2 x2 = la * 2.0f;
                    const f32x2 em = x2 * (x2 * (x2 * (x2 * (x2 * (x2 * 0.0013888889f + 0.0083333338f) + 0.041666668f) + 0.16666667f) + 0.5f) + 1.0f);
                    const f32x2 ga = a * a * -1.0f + 1.0f;
                    f32x2 g2; g2.x = (x2.x > -0.25f) ? -em.x : ga.x; g2.y = (x2.y > -0.25f) ? -em.y : ga.y;
                    f32x2 sq; sq.x = __builtin_amdgcn_sqrtf(fmaxf(g2.x, 0.f)); sq.y = __builtin_amdgcn_sqrtf(fmaxf(g2.y, 0.f));
                    const f32x2 bv = sq * (ig * (f32x2){xc[2 * pp], xc[2 * pp + 1]});
                    Av[2 * pp] = a.x; Av[2 * pp + 1] = a.y; Bw[2 * pp] = bv.x; Bw[2 * pp + 1] = bv.y;
                }
#define SCAN_STEP(d) asm volatile("s_nop 1\n" \
                    "v_fmac_f32_dpp %0, %0, %4 row_shr:" #d " row_mask:0xf bank_mask:0xf\n v_fmac_f32_dpp %1, %1, %5 row_shr:" #d " row_mask:0xf bank_mask:0xf\n" \
                    "v_fmac_f32_dpp %2, %2, %6 row_shr:" #d " row_mask:0xf bank_mask:0xf\n v_fmac_f32_dpp %3, %3, %7 row_shr:" #d " row_mask:0xf bank_mask:0xf\n" \
                    "v_mul_f32_dpp %4, %4, %4 row_shr:" #d " row_mask:0xf bank_mask:0xf\n v_mul_f32_dpp %5, %5, %5 row_shr:" #d " row_mask:0xf bank_mask:0xf\n" \
                    "v_mul_f32_dpp %6, %6, %6 row_shr:" #d " row_mask:0xf bank_mask:0xf\n v_mul_f32_dpp %7, %7, %7 row_shr:" #d " row_mask:0xf bank_mask:0xf" \
                    : "+v"(Bw[0]), "+v"(Bw[1]), "+v"(Bw[2]), "+v"(Bw[3]), "+v"(Av[0]), "+v"(Av[1]), "+v"(Av[2]), "+v"(Av[3]))
                SCAN_STEP(1); SCAN_STEP(2); SCAN_STEP(4); SCAN_STEP(8);
#undef SCAN_STEP
#pragma unroll
                for (int r = 0; r < 4; ++r) {
                    const float A = Av[r], Bv = Bw[r];
                    const float P = A * Pc[r], H = A * Hc[r] + Bv;
                    Pt[tt][r] = P; Ht[tt][r] = H;
                    Pc[r] = shfl_idx_(P, lane | 15); Hc[r] = shfl_idx_(H, lane | 15);
                }
            }
            if (fr == 0) {
                LAS float* q = sAgg + ((tq * 2 + chh) * 16 + 4 * fq) * 2;
                *(LAS f32x4*)q = (f32x4){Pc[0], Hc[0], Pc[1], Hc[1]}; *(LAS f32x4*)(q + 4) = (f32x4){Pc[2], Hc[2], Pc[3], Hc[3]};
            }
            __syncthreads();
            float carry[4] = {S[0], S[1], S[2], S[3]};
#pragma unroll
            for (int qd = 0; qd < 4; ++qd) {
                const LAS float* q = sAgg + ((qd * 2 + chh) * 16 + 4 * fq) * 2;
                const f32x4 a0 = *(const LAS f32x4*)q, a1 = *(const LAS f32x4*)(q + 4);
                if (qd == tq) { carry[0] = S[0]; carry[1] = S[1]; carry[2] = S[2]; carry[3] = S[3]; }
                S[0] = a0[0] * S[0] + a0[1]; S[1] = a0[2] * S[1] + a0[3]; S[2] = a1[0] * S[2] + a1[1]; S[3] = a1[2] * S[3] + a1[3];
            }
#pragma unroll
            for (int tt = 0; tt < 4; ++tt) {
                const int t = 64 * tq + 16 * tt + fr;
                const float y0 = (Ht[tt][0] + Pt[tt][0] * carry[0]) * bf_lo(zz[tt].x), y1 = (Ht[tt][1] + Pt[tt][1] * carry[1]) * bf_hi(zz[tt].x);
                const float y2 = (Ht[tt][2] + Pt[tt][2] * carry[2]) * bf_lo(zz[tt].y), y3 = (Ht[tt][3] + Pt[tt][3] * carry[3]) * bf_hi(zz[tt].y);
                u32x2 ov; ov.x = cvt_pk_bf16(y0, y1); ov.y = cvt_pk_bf16(y2, y3);
                *(u32x2*)(ybuf + (size_t)(rowbase + t) * 2048 + 1024 + chl) = ov;
            }
        }
#undef XB_LOAD
    }
}

__device__ void phase_final(const Params& p, int wid_s) {
    int tid_ = wid_s * 64 + lane_id_(); asm volatile("" : "+v"(tid_));
    const int tid = tid_, wave = tid >> 6, lane = tid & 63, G = gridDim.x;
    const float* ssqx = (const float*)(p.ws + WS_SSQX);
    f32x4 gv[4];
#pragma unroll
    for (int i = 0; i < 4; ++i) gv[i] = *(const f32x4*)(p.final_g + i * 256 + lane * 4);
    for (int row = blockIdx.x * 8 + wave; row < MTOT; row += G * 8) {
        float s = (lane < 16) ? ssqx[(size_t)row * 16 + lane] : 0.f;
#pragma unroll
        for (int d = 1; d < 16; d <<= 1) s += shfl_idx_(s, lane ^ d);
        s = shfl_idx_(s, lane & 0);
        const float rstd = __builtin_amdgcn_rsqf(s * (1.0f / DM) + EPS);
        float* xr = p.out + (size_t)row * DM; const bf16_t* xb = (const bf16_t*)(p.ws + WS_XBF) + (size_t)row * DM;
        u32x2 w[4];
#pragma unroll
        for (int i = 0; i < 4; ++i) w[i] = *(const u32x2*)(xb + i * 256 + lane * 4);
#pragma unroll
        for (int i = 0; i < 4; ++i) { f32x4 v = (f32x4){bf_lo(w[i].x), bf_hi(w[i].x), bf_lo(w[i].y), bf_hi(w[i].y)}; v = v * rstd * gv[i]; *(f32x4*)(xr + i * 256 + lane * 4) = v; }
    }
}

#define XB_TMO      128
#define XB_XCNT(j)  (256  + 64 * (j))
#define XB_XSUB(j)  (1280 + 64 * (j))
#define XB_XGEN(j)  (2304 + 64 * (j))
#define XB_TOP      3328
#define XB_TOPGEN   3392
#define XCD_BAR_WORDS 3456
#define XB_SPIN_CAP (1u << 18)
__device__ __forceinline__ unsigned xb_ld(unsigned* p)              { return __hip_atomic_load(p, __ATOMIC_RELAXED, __HIP_MEMORY_SCOPE_AGENT); }
__device__ __forceinline__ unsigned xb_add(unsigned* p, unsigned v) { return __hip_atomic_fetch_add(p, v, __ATOMIC_RELAXED, __HIP_MEMORY_SCOPE_AGENT); }
__device__ __forceinline__ unsigned xb_xcc_id() { return (unsigned)__builtin_amdgcn_s_getreg((3 << 11) | 20) & 0xFu; }
#define XB_SPIN(cond, bar) do { unsigned _sp = 0; while (cond) { __builtin_amdgcn_s_sleep(1); \
    if ((++_sp & 255u) == 0u) { if (xb_ld(&(bar)[XB_TMO])) break; if (_sp > XB_SPIN_CAP) { atomicAdd(&(bar)[XB_TMO], 1u); break; } } } } while (0)
struct XcdBarrier { unsigned* bar; unsigned x; volatile LAS unsigned* st; };
__device__ __forceinline__ XcdBarrier xcd_barrier_post(unsigned* bar, volatile LAS unsigned* st, int wid_s) {
    XcdBarrier b; b.bar = bar; b.x = xb_xcc_id(); b.st = st;
    if (wid_s == 0 && lane_id_() == 0) (void)xb_add(&bar[XB_XCNT(b.x)], 1u);
    return b;
}
__device__ __forceinline__ void xcd_barrier_complete(unsigned* bar, unsigned x, unsigned& nloc, unsigned& nx) {
    const unsigned G = gridDim.x * gridDim.y * gridDim.z;
    unsigned sum, cnt, mine, sp = 0u;
    for (;;) {
        sum = 0u; cnt = 0u; mine = 0u;
#pragma unroll
        for (unsigned j = 0; j < 16; ++j) { const unsigned c = xb_ld(&bar[XB_XCNT(j)]); sum += c; cnt += (c > 0u) ? 1u : 0u; mine = (j == x) ? c : mine; }
        if (sum == G) break;
        __builtin_amdgcn_s_sleep(1);
        if ((++sp & 255u) == 0u) { if (xb_ld(&bar[XB_TMO])) break; if (sp > XB_SPIN_CAP) { atomicAdd(&bar[XB_TMO], 1u); break; } }
    }
    nloc = mine > 0u ? mine : 1u; nx = cnt > 0u ? cnt : 1u;
}
__device__ __forceinline__ void xcd_barrier(const XcdBarrier& b, int wid_s) {
    asm volatile("s_waitcnt vmcnt(0)" ::: "memory");
    __syncthreads();
    if (wid_s == 0 && lane_id_() == 0) {
        unsigned* bar = b.bar;
        __builtin_amdgcn_s_waitcnt(0);
        unsigned nloc = b.st[0], nx = b.st[1];
        if (nloc == 0u) { xcd_barrier_complete(bar, b.x, nloc, nx); b.st[0] = nloc; b.st[1] = nx; }
        const unsigned old = xb_add(&bar[XB_XSUB(b.x)], 1u);
        const unsigned gen = old / nloc;
        if (old + 1u == (gen + 1u) * nloc) {
            __builtin_amdgcn_fence(__ATOMIC_RELEASE, "agent");
            asm volatile("s_waitcnt vmcnt(0)" ::: "memory");
            const unsigned og = xb_add(&bar[XB_TOP], 1u);
            const unsigned tg = og / nx;
            if (og + 1u == (tg + 1u) * nx) xb_add(&bar[XB_TOPGEN], 1u);
            else XB_SPIN(xb_ld(&bar[XB_TOPGEN]) == tg, bar);
            __builtin_amdgcn_fence(__ATOMIC_ACQUIRE, "agent");
            xb_add(&bar[XB_XGEN(b.x)], 1u);
            asm volatile("s_waitcnt vmcnt(0)" ::: "memory");
        } else {
            XB_SPIN(xb_ld(&bar[XB_XGEN(b.x)]) == gen, bar);
            __builtin_amdgcn_fence(__ATOMIC_ACQUIRE, "agent");
            asm volatile("s_waitcnt vmcnt(0)" ::: "memory");
        }
    }
    __syncthreads();
}

__global__ void __launch_bounds__(512, 2) mega_fwd(Params p) {
    extern __shared__ __attribute__((aligned(16))) unsigned char lds_raw[];
    LAS unsigned char* lds = (LAS unsigned char*)lds_raw;
    cg::grid_group grid = cg::this_grid();
    unsigned char* ws = p.ws;
    const int G = gridDim.x;
    const int wid_s = __builtin_amdgcn_readfirstlane((int)threadIdx.x >> 6);
    if (threadIdx.x < 4) ((LAS unsigned*)(lds + XBAR_LDS_OFF))[threadIdx.x] = 0u;
    __syncthreads();
    const XcdBarrier xbar = xcd_barrier_post((unsigned*)(ws + WS_BAR), (volatile LAS unsigned*)(lds + XBAR_LDS_OFF), wid_s);

#ifndef PM
#define PM 0xff
#endif
    if (PM & 1) phase_prep(p, lds, wid_s);
    grid.sync();

    for (int l = 0; l < DEPTH; ++l) {
        for (int grp = 0; grp < NGRP; ++grp) {
            const size_t r0 = (size_t)grp * MG;
            if (PM & 2) {
                pg8::Gemm g{(const bf16_t*)(ws + WS_XBF) + r0 * DM, (const bf16_t*)(ws + WS_WIN) + (size_t)l * NIN * DM, MG, NIN, DM};
                pg8::StaticOrder S; S.init(MG, NIN, G, (int)blockIdx.x);
                Epi1 E{(bf16_t*)(ws + WS_PROJ), (const float*)(ws + WS_SSQX) + r0 * 16, (float*)(ws + WS_SSQV), p.b_merge + (size_t)l * 2 * DM};
                pg8::gemm_phase<Epi1>(lds, g, S, E, wid_s);
#ifdef REPG1
                pg8::gemm_phase<Epi1>(lds, g, S, E, wid_s);
#endif
            }
            xcd_barrier(xbar, wid_s);
            if (PM & 4) {
                const unsigned epoch = (unsigned)(l * NGRP + grp + 1);
#ifndef REPB
#define REPB 1
#define REPA 1
#endif
                for (int rep = 0; rep < REPB; ++rep)
                mixerB_phase(p, lds, l, wid_s);
                for (int rep = 0; rep < REPA; ++rep)
                mixerA_phase(p, lds, l, wid_s);
                __syncthreads();
            }
            xcd_barrier(xbar, wid_s);
            if (PM & 8) {
                pg8::Gemm g{(const bf16_t*)(ws + WS_Y), (const bf16_t*)(ws + WS_WP) + (size_t)l * DM * 2048, MG, DM, 2048};
                pg8::StaticOrder S; S.init(MG, DM, G, (int)blockIdx.x);
                Epi2 E{(const bf16_t*)(ws + WS_PROJ) + (size_t)5 * MG * DM, (const bf16_t*)(ws + WS_PROJ) + (size_t)6 * MG * DM, (bf16_t*)(ws + WS_MB)};
                pg8::gemm_phase<Epi2>(lds, g, S, E, wid_s);
#ifdef REPG2
                pg8::gemm_phase<Epi2>(lds, g, S, E, wid_s);
#endif
            }
            xcd_barrier(xbar, wid_s);
            if (PM & 16) {
                pg8::Gemm g{(const bf16_t*)(ws + WS_MB), (const bf16_t*)(ws + WS_WO) + (size_t)l * DM * DM, MG, DM, DM};
                pg8::StaticOrder S; S.init(MG, DM, G, (int)blockIdx.x);
                Epi3 E{l == 0 ? p.x + r0 * DM : nullptr, nullptr, (bf16_t*)(ws + WS_XBF) + r0 * DM, (float*)(ws + WS_SSQX) + r0 * 16};
                pg8::gemm_phase<Epi3>(lds, g, S, E, wid_s);
            }
            if (NGRP == 1) xcd_barrier(xbar, wid_s);
        }
    }
    xcd_barrier(xbar, wid_s);
    if (PM & 32) phase_final(p, wid_s);
}

extern "C" void kernel_launch(void* const* d_in, const int* in_sizes, int n_in, void* d_out, int out_size, void* d_ws, size_t ws_size, hipStream_t stream) {
    static int grid_blocks = 0;
    if (grid_blocks == 0) {
        if (ws_size < WS_END) { fprintf(stderr, "kernel_launch: workspace too small (%zu < %zu)\n", ws_size, (size_t)WS_END); grid_blocks = -1; return; }
        int dev = 0, cus = 0, per_cu = 0;
        hipGetDevice(&dev);
        hipDeviceGetAttribute(&cus, hipDeviceAttributeMultiprocessorCount, dev);
        hipFuncSetAttribute((const void*)mega_fwd, hipFuncAttributeMaxDynamicSharedMemorySize, LDS_BYTES);
        hipOccupancyMaxActiveBlocksPerMultiprocessor(&per_cu, (const void*)mega_fwd, 512, LDS_BYTES);
        if (per_cu < 1) per_cu = 1;
        grid_blocks = cus * 1;
        fprintf(stderr, "kernel_launch: cus %d per_cu %d grid %d\n", cus, per_cu, grid_blocks);
    }
    if (grid_blocks < 0) return;
    Params p{};
    p.x = (const float*)d_in[0]; p.norm_g = (const float*)d_in[1]; p.w_in = (const float*)d_in[2]; p.b_merge = (const float*)d_in[3]; p.v_norm_g = (const float*)d_in[4];
    p.w_spatial = (const float*)d_in[5]; p.b_spatial = (const float*)d_in[6]; p.conv_w = (const float*)d_in[7]; p.conv_b = (const float*)d_in[8];
    p.w_rgate = (const float*)d_in[9]; p.b_rgate = (const float*)d_in[10]; p.w_igate = (const float*)d_in[11]; p.b_igate = (const float*)d_in[12]; p.lru_lambda = (const float*)d_in[13];
    p.w_proj_a = (const float*)d_in[14]; p.w_proj_b = (const float*)d_in[15]; p.w_out = (const float*)d_in[16]; p.final_g = (const float*)d_in[17];
    p.out = (float*)d_out; p.ws = (unsigned char*)d_ws;
    hipMemsetAsync((unsigned char*)d_ws + WS_BAR, 0, 16384, stream);
    void* args[] = {&p};
    hipError_t e = hipLaunchCooperativeKernel((const void*)mega_fwd, dim3(grid_blocks), dim3(512), args, LDS_BYTES, stream);
    if (e != hipSuccess) fprintf(stderr, "cooperative launch failed: %s (grid %d)\n", hipGetErrorString(e), grid_blocks);
}
```

```cpp
#include <hip/hip_runtime.h>
#include <hip/hip_cooperative_groups.h>
#include <cstdio>
namespace cg = cooperative_groups;

#define LAS __attribute__((address_space(3)))
typedef unsigned short bf16_t;
typedef short bf16x8 __attribute__((ext_vector_type(8)));
typedef float f32x4 __attribute__((ext_vector_type(4)));
typedef unsigned u32x4 __attribute__((ext_vector_type(4)));
typedef unsigned u32x2 __attribute__((ext_vector_type(2)));
typedef float f32x2 __attribute__((ext_vector_type(2)));

constexpr int DM = 1024, NBATCH = 16, SEQ = 4096, MTOT = NBATCH * SEQ, DEPTH = 4, NIN = 7168;
constexpr int NGRP = 2, MG = MTOT / NGRP, BG = NBATCH / NGRP;
constexpr int LSEG = 128, NSEG = SEQ / LSEG;
constexpr int NBITEM = BG * 8 * NSEG, NAITEM = (MG / 128) * 8;
constexpr float EPS = 1e-6f;
constexpr int LDS_BYTES = 142848 + 16;

constexpr size_t WS_WIN = 0;
constexpr size_t WS_WP = WS_WIN + (size_t)DEPTH * NIN * DM * 2;
constexpr size_t WS_WO = WS_WP + (size_t)DEPTH * DM * 2048 * 2;
constexpr size_t WS_WSB = WS_WO + (size_t)DEPTH * DM * DM * 2;
constexpr size_t WS_WRT = WS_WSB + (size_t)DEPTH * 8 * 128 * 128 * 2;
constexpr size_t WS_WIT = WS_WRT + (size_t)DEPTH * 8 * 128 * 128 * 2;
constexpr size_t WS_XBF = WS_WIT + (size_t)DEPTH * 8 * 128 * 128 * 2;
constexpr size_t WS_SSQX = WS_XBF + (size_t)MTOT * DM * 2;
constexpr size_t WS_SSQV = WS_SSQX + (size_t)MTOT * 16 * 4;
constexpr size_t WS_PROJ = WS_SSQV + (size_t)MG * 16 * 4;
constexpr size_t WS_Y = WS_PROJ + (size_t)7 * MG * DM * 2;
constexpr size_t WS_MB = WS_Y + (size_t)MG * 2048 * 2;
constexpr size_t WS_PAY = WS_MB + (size_t)MG * DM * 2;
constexpr size_t WS_PAYP = WS_PAY + (size_t)NBITEM * 8 * 16 * 8;
constexpr size_t WS_FLG = WS_PAYP + (size_t)NBITEM * 8 * 16 * 4;
constexpr size_t WS_BAR = WS_FLG + (size_t)NBITEM * 8 * 4;
constexpr size_t WS_END = WS_BAR + 16384;

struct Params {
    const float* x; const float* norm_g; const float* w_in; const float* b_merge; const float* v_norm_g; const float* w_spatial; const float* b_spatial;
    const float* conv_w; const float* conv_b; const float* w_rgate; const float* b_rgate; const float* w_igate; const float* b_igate; const float* lru_lambda;
    const float* w_proj_a; const float* w_proj_b; const float* w_out; const float* final_g;
    float* out; unsigned char* ws;
};

__device__ __forceinline__ float shfl_idx_(float v, int src_lane) { return __uint_as_float((unsigned)__builtin_amdgcn_ds_bpermute(src_lane << 2, (int)__float_as_uint(v))); }
__device__ __forceinline__ int lane_id_() { return (int)__builtin_amdgcn_mbcnt_hi(~0u, __builtin_amdgcn_mbcnt_lo(~0u, 0u)); }
__device__ __forceinline__ unsigned cvt_pk_bf16(float lo, float hi) { unsigned r; asm volatile("v_cvt_pk_bf16_f32 %0, %1, %2" : "=v"(r) : "v"(lo), "v"(hi)); return r; }
__device__ __forceinline__ float bf_lo(unsigned w) { return __uint_as_float(w << 16); }
__device__ __forceinline__ float bf_hi(unsigned w) { return __uint_as_float(w & 0xffff0000u); }
__device__ __forceinline__ float fast_rcp(float x) { return __builtin_amdgcn_rcpf(x); }
__device__ __forceinline__ float fast_exp2(float x) { return __builtin_amdgcn_exp2f(x); }
__device__ __forceinline__ float sigmoidf_(float x) { return fast_rcp(1.0f + fast_exp2(-1.4426950409f * x)); }

namespace pg8 {
constexpr int BM = 256, BK = 64, HALF = 128, HTB = HALF * BK * 2, STAGE_BYTES = 8 * HTB, NXCD = 8, WGM = 8;
__host__ __device__ __forceinline__ int lds_byte(int r, int c) { const int st = (r >> 4) * 2 + (c >> 5), rr = r & 15, cc = c & 31, ob = rr * 64 + cc * 2; return st * 1024 + (ob ^ (((ob >> 9) & 1) << 5)); }
__host__ __device__ __forceinline__ void stage_rc(int b, int& R, int& C) { const int st = b / 1024, sb = b % 1024, swz = sb ^ (((sb >> 9) & 1) << 5); R = (st >> 1) * 16 + swz / 64; C = (st & 1) * 32 + (swz % 64) / 2; }
__host__ __device__ __forceinline__ int perm32(int rho) { const int n = rho >> 4, i = rho & 15; return 8 * (i >> 2) + 4 * n + (i & 3); }
struct Unit { int pm, pn; };
struct Gemm { const bf16_t* A; const bf16_t* Bt; int M, N, K; };
struct StaticOrder {
    int nM, nN, nwg, G, c;
    __device__ void init(int M, int N, int G_, int c_) { nM = M / BM; nN = N / BM; nwg = nM * nN; G = G_; c = c_; }
    __device__ bool next(int i, Unit& u) const {
        const long L = (long)i * G + c; if (L >= nwg) return false;
        int wgid = (int)L; { const int q = nwg / NXCD, r = nwg % NXCD, xcd = wgid % NXCD, off = wgid / NXCD; wgid = (xcd < r ? xcd * (q + 1) : r * (q + 1) + (xcd - r) * q) + off; }
        const int nig = WGM * nN, gid = wgid / nig, fm = gid * WGM, gsz = (nM - fm) < WGM ? (nM - fm) : WGM;
        u.pm = fm + ((wgid % nig) % gsz); u.pn = (wgid % nig) / gsz; return true;
    }
};
template <class Epi>
__device__ __forceinline__ void gemm_phase(LAS unsigned char* lds, const Gemm g, const StaticOrder& S, const Epi& E, int wid_s) {
    int tid_ = wid_s * 64 + lane_id_(); asm volatile("" : "+v"(tid_));
    const int tid = tid_, wid = __builtin_amdgcn_readfirstlane(tid >> 6), lane = tid & 63, wr = wid >> 2, wc = wid & 3, fr = lane & 15, fq = lane >> 4;
    const int K = g.K, nt = K / BK;
    unsigned voffA[2], voffB[2];
#pragma unroll
    for (int i = 0; i < 2; ++i) { int R, C; stage_rc(tid * 16 + i * 8192, R, C); const int Rb = ((R & ~31) + perm32(R & 31));
        voffA[i] = (unsigned)(R * K + C) * 2u; voffB[i] = (unsigned)(Rb * K + C) * 2u; }
    const size_t kstep = (size_t)(BK * 2);
    const size_t hstep = (size_t)HALF * K * 2;
    const size_t tstep = 2 * hstep;
    const unsigned ldsw = (unsigned)wid * 1024u;
    const int aoff = lds_byte(wr * 64 + fr, fq * 8), boff = lds_byte(wc * 32 + fr, fq * 8);
#define PG8_SA(b, h) (((b) * 2 + (h)) * HTB)
#define PG8_SB(b, h) ((4 + (b) * 2 + (h)) * HTB)
#define PG8_STAGE(bufoff, gbase, voff) do { _Pragma("unroll") for (int _i = 0; _i < 2; ++_i) \
        __builtin_amdgcn_global_load_lds((const unsigned*)((const char*)(gbase) + (voff)[_i]), (LAS unsigned*)(lds + (bufoff) + ldsw + _i * 8192), 16, 0, 0); } while (0)
#define PG8_LDA(dst, b, h) do { _Pragma("unroll") for (int m = 0; m < 4; ++m) _Pragma("unroll") for (int k = 0; k < 2; ++k) dst[m][k] = *(const LAS bf16x8*)(lds + PG8_SA(b, h) + aoff + m * 2048 + k * 1024); } while (0)
#define PG8_LDB(dst, b, h) do { _Pragma("unroll") for (int n = 0; n < 2; ++n) _Pragma("unroll") for (int k = 0; k < 2; ++k) dst[n][k] = *(const LAS bf16x8*)(lds + PG8_SB(b, h) + boff + n * 2048 + k * 1024); } while (0)
#define PG8_MMA(ai, bj, At, Bt) do { __builtin_amdgcn_s_setprio(1); _Pragma("unroll") for (int m = 0; m < 4; ++m) _Pragma("unroll") for (int n = 0; n < 2; ++n) _Pragma("unroll") for (int k = 0; k < 2; ++k) \
        acc[ai][bj][m][n] = __builtin_amdgcn_mfma_f32_16x16x32_bf16(Bt[n][k], At[m][k], acc[ai][bj][m][n], 0, 0, 0); __builtin_amdgcn_s_setprio(0); } while (0)
#define PG8_WAIT_V(n) asm volatile("s_waitcnt vmcnt(" #n ")" ::: "memory")
#define PG8_WAIT_L(n) asm volatile("s_waitcnt lgkmcnt(" #n ")" ::: "memory")
#define PG8_BAR __builtin_amdgcn_s_barrier()
#define PG8_SCHED __builtin_amdgcn_sched_barrier(0)
    Unit cur, nxt; int ui = 0;
    if (!S.next(0, cur)) return;
    float est[8]; int est_pm = -1;
#pragma unroll
    for (int i = 0; i < 8; ++i) est[i] = 0.f;
    f32x4 acc[2][2][4][2];
#pragma unroll
    for (int a = 0; a < 2; ++a)
#pragma unroll
        for (int b = 0; b < 2; ++b)
#pragma unroll
            for (int m = 0; m < 4; ++m)
#pragma unroll
                for (int n = 0; n < 2; ++n) acc[a][b][m][n] = (f32x4){0.f, 0.f, 0.f, 0.f};
    bf16x8 At[4][2], B0[2][2], B1[2][2];
    const char* cA = (const char*)g.A + (size_t)cur.pm * tstep; const char* cB = (const char*)g.Bt + (size_t)cur.pn * tstep;
    PG8_STAGE(PG8_SB(0, 0), cB, voffB); PG8_STAGE(PG8_SB(0, 1), cB + hstep, voffB); PG8_STAGE(PG8_SA(0, 0), cA, voffA); PG8_STAGE(PG8_SA(0, 1), cA + hstep, voffA);
    if (wr == 1) PG8_BAR;
    PG8_WAIT_V(2); PG8_BAR;
    PG8_STAGE(PG8_SB(1, 0), cB + kstep, voffB); PG8_STAGE(PG8_SA(1, 0), cA + kstep, voffA); PG8_STAGE(PG8_SB(1, 1), cB + hstep + kstep, voffB);
    PG8_WAIT_V(6); PG8_BAR;
    for (;;) {
        const bool has_next = S.next(ui + 1, nxt);
        const char* nA = has_next ? (const char*)g.A + (size_t)nxt.pm * tstep : cA; const char* nB = has_next ? (const char*)g.Bt + (size_t)nxt.pn * tstep : cB;
        for (int t = 0; t < nt; t += 2) {
            const bool last = (t == nt - 2);
            const char* a1 = cA + (size_t)(t + 1) * kstep;
            const char* a2 = last ? nA : cA + (size_t)(t + 2) * kstep; const char* b2 = last ? nB : cB + (size_t)(t + 2) * kstep;
            const char* a3 = a2 + kstep; const char* b3 = b2 + kstep;
            if constexpr (Epi::HAS_MID) { if (t == nt / 2) E.mid(acc, cur, wr, wc, fr, fq); }
            PG8_LDB(B0, 0, 0); PG8_LDB(B1, 0, 1); PG8_SCHED; PG8_LDA(At, 0, 0); PG8_STAGE(PG8_SA(1, 1), a1 + hstep, voffA);
            PG8_WAIT_V(8); PG8_WAIT_L(0); PG8_BAR; PG8_MMA(0, 0, At, B0); PG8_MMA(0, 1, At, B1); PG8_BAR; PG8_SCHED;
            PG8_LDA(At, 0, 1); PG8_STAGE(PG8_SB(0, 0), b2, voffB); PG8_STAGE(PG8_SB(0, 1), b2 + hstep, voffB); PG8_STAGE(PG8_SA(0, 0), a2, voffA);
            PG8_WAIT_V(8); PG8_WAIT_L(0); PG8_BAR; PG8_MMA(1, 0, At, B0); PG8_MMA(1, 1, At, B1); PG8_BAR; PG8_SCHED;
            PG8_LDB(B0, 1, 0); PG8_LDB(B1, 1, 1); PG8_SCHED; PG8_LDA(At, 1, 0); PG8_STAGE(PG8_SA(0, 1), a2 + hstep, voffA);
            PG8_WAIT_V(8); PG8_WAIT_L(0); PG8_BAR; PG8_MMA(0, 0, At, B0); PG8_MMA(0, 1, At, B1); PG8_BAR; PG8_SCHED;
            PG8_LDA(At, 1, 1); PG8_STAGE(PG8_SB(1, 0), b3, voffB); PG8_STAGE(PG8_SB(1, 1), b3 + hstep, voffB); PG8_STAGE(PG8_SA(1, 0), a3, voffA);
            PG8_WAIT_V(8); PG8_WAIT_L(0); PG8_BAR; PG8_MMA(1, 0, At, B0); PG8_MMA(1, 1, At, B1); PG8_BAR; PG8_SCHED;
        }
        if (wr == 0) PG8_BAR;
        E(acc, cur, wr, wc, fr, fq, est, est_pm);
        if (!has_next) break;
#pragma unroll
        for (int a = 0; a < 2; ++a)
#pragma unroll
            for (int b = 0; b < 2; ++b)
#pragma unroll
                for (int m = 0; m < 4; ++m)
#pragma unroll
                    for (int n = 0; n < 2; ++n) acc[a][b][m][n] = (f32x4){0.f, 0.f, 0.f, 0.f};
        cur = nxt; cA = nA; cB = nB; ++ui;
        if (wr == 1) PG8_BAR;
    }
    PG8_WAIT_V(0);
    PG8_BAR;
#undef PG8_SA
#undef PG8_SB
#undef PG8_STAGE
#undef PG8_LDA
#undef PG8_LDB
#undef PG8_MMA
#undef PG8_WAIT_V
#undef PG8_WAIT_L
#undef PG8_BAR
#undef PG8_SCHED
}
}

struct Epi1 {
    static constexpr bool HAS_MID = false;
    bf16_t* proj; const float* ssqx; float* ssqv; const LAS float* sbm;
    __device__ __forceinline__ void mid(f32x4 (&)[2][2][4][2], const pg8::Unit&, int, int, int, int) const {}
    __device__ __forceinline__ void operator()(const f32x4 (&acc)[2][2][4][2], const pg8::Unit& u, int wr, int wc, int fr, int fq, float (&est)[8], int& est_pm) const {
        const int pn = u.pn; const bool uz = pn < 8, gg = pn >= 20;
        const int seg = uz ? 0 : (pn < 12 ? 1 : (gg ? 5 : (pn >> 2)));
        const int colt = uz ? pn * 128 : (gg ? (pn - 20) * 128 : (pn & 3) * 256);
        bf16_t* base = proj + (size_t)seg * MG * DM;
        const int row0 = u.pm * 256 + wr * 64 + fr, colw = wc * 32 + 8 * fq;
        const float G1c = -2.3022082f, G3c = -2.3022082f * 0.044715f, S1c = -1.4426950409f;
        const float c1_0 = (seg <= 1) ? G1c : S1c, c3_0 = (seg <= 1) ? G3c : 0.f;
        const float c1_1 = (seg == 1) ? G1c : S1c, c3_1 = (seg == 1) ? G3c : 0.f;
        const bool numx = (seg <= 4), raw = (seg == 3);
        float cb[2][8];
#pragma unroll
        for (int bj = 0; bj < 2; ++bj)
#pragma unroll
            for (int j = 0; j < 8; ++j) cb[bj][j] = gg ? sbm[bj * DM + colt + colw + j] : 0.f;
        if (u.pm != est_pm) {
            est_pm = u.pm;
            f32x4 pp[2][4];
#pragma unroll
            for (int ai = 0; ai < 2; ++ai)
#pragma unroll
                for (int m = 0; m < 4; ++m) pp[ai][m] = *(const f32x4*)(ssqx + (size_t)(row0 + ai * 128 + m * 16) * 16 + fq * 4);
#pragma unroll
            for (int ai = 0; ai < 2; ++ai)
#pragma unroll
                for (int m = 0; m < 4; ++m) { float s = (pp[ai][m][0] + pp[ai][m][1]) + (pp[ai][m][2] + pp[ai][m][3]); s += shfl_idx_(s, (fq * 16 + fr) ^ 16); s += shfl_idx_(s, (fq * 16 + fr) ^ 32);
                    est[ai * 4 + m] = __builtin_amdgcn_rsqf(s * (1.0f / DM) + EPS); }
        }
#pragma unroll
        for (int ai = 0; ai < 2; ++ai)
#pragma unroll
            for (int m = 0; m < 4; ++m) {
                const int row = row0 + ai * 128 + m * 16;
                const float rstd = est[ai * 4 + m];
                float sq = 0.f;
                float v[2][8];
#pragma unroll
                for (int bj = 0; bj < 2; ++bj) {
                    const float c1 = bj ? c1_1 : c1_0, c3 = bj ? c3_1 : c3_0;
#pragma unroll
                    for (int n = 0; n < 2; ++n)
#pragma unroll
                        for (int j = 0; j < 4; ++j) v[bj][n * 4 + j] = acc[ai][bj][m][n][j] * rstd;
                    if (!raw) {
#pragma unroll
                        for (int j = 0; j < 8; ++j) { const float x = v[bj][j]; const float arg = x * (c1 + c3 * x * x) + cb[bj][j]; const float r = fast_rcp(1.0f + fast_exp2(arg)); v[bj][j] = numx ? x * r : r; }
                    }
                    if (seg == 1) {
#pragma unroll
                        for (int j = 0; j < 8; ++j) sq += v[bj][j] * v[bj][j];
                    }
                }
                if (uz) {
                    u32x4 w; w.x = cvt_pk_bf16(v[0][0] * v[1][0], v[0][1] * v[1][1]); w.y = cvt_pk_bf16(v[0][2] * v[1][2], v[0][3] * v[1][3]);
                    w.z = cvt_pk_bf16(v[0][4] * v[1][4], v[0][5] * v[1][5]); w.w = cvt_pk_bf16(v[0][6] * v[1][6], v[0][7] * v[1][7]);
                    *(u32x4*)(base + (size_t)row * DM + colt + colw) = w;
                } else if (gg) {
                    float q[8];
#pragma unroll
                    for (int j = 0; j < 8; ++j) q[j] = v[0][j] * fast_rcp(fmaxf(v[1][j], 1e-30f));
                    u32x4 w; w.x = cvt_pk_bf16(q[0], q[1]); w.y = cvt_pk_bf16(q[2], q[3]); w.z = cvt_pk_bf16(q[4], q[5]); w.w = cvt_pk_bf16(q[6], q[7]);
                    *(u32x4*)(base + (size_t)row * DM + colt + colw) = w;
                    u32x4 w2; w2.x = cvt_pk_bf16(v[1][0], v[1][1]); w2.y = cvt_pk_bf16(v[1][2], v[1][3]); w2.z = cvt_pk_bf16(v[1][4], v[1][5]); w2.w = cvt_pk_bf16(v[1][6], v[1][7]);
                    *(u32x4*)(base + (size_t)MG * DM + (size_t)row * DM + colt + colw) = w2;
                } else {
#pragma unroll
                    for (int bj = 0; bj < 2; ++bj) {
                        u32x4 w; w.x = cvt_pk_bf16(v[bj][0], v[bj][1]); w.y = cvt_pk_bf16(v[bj][2], v[bj][3]); w.z = cvt_pk_bf16(v[bj][4], v[bj][5]); w.w = cvt_pk_bf16(v[bj][6], v[bj][7]);
                        *(u32x4*)(base + (size_t)row * DM + colt + bj * 128 + colw) = w;
                    }
                }
                if (seg == 1) { sq += shfl_idx_(sq, (fq * 16 + fr) ^ 16); sq += shfl_idx_(sq, (fq * 16 + fr) ^ 32); if (fq == 0) ssqv[(size_t)row * 16 + (pn & 3) * 4 + wc] = sq; }
            }
    }
};
struct Epi2 {
    static constexpr bool HAS_MID = true;
    const bf16_t* sa; const bf16_t* sb; bf16_t* mout;
    __device__ __forceinline__ void mid(f32x4 (&acc)[2][2][4][2], const pg8::Unit& u, int wr, int wc, int fr, int fq) const {
        int row0 = u.pm * 256 + wr * 64 + fr, col0 = u.pn * 256 + wc * 32 + 8 * fq;
        asm volatile("" : "+v"(row0), "+v"(col0));
#pragma unroll
        for (int ai = 0; ai < 2; ++ai) {
            u32x4 av[4][2];
#pragma unroll
            for (int m = 0; m < 4; ++m)
#pragma unroll
                for (int bj = 0; bj < 2; ++bj) av[m][bj] = *(const u32x4*)(sa + (size_t)(row0 + ai * 128 + m * 16) * DM + col0 + bj * 128);
#pragma unroll
            for (int m = 0; m < 4; ++m)
#pragma unroll
                for (int bj = 0; bj < 2; ++bj) {
#pragma unroll
                    for (int q = 0; q < 4; ++q) { acc[ai][bj][m][q >> 1][(q & 1) * 2] *= bf_lo(av[m][bj][q]); acc[ai][bj][m][q >> 1][(q & 1) * 2 + 1] *= bf_hi(av[m][bj][q]); }
                }
            asm volatile("" ::: "memory");
        }
    }
    __device__ __forceinline__ void operator()(const f32x4 (&acc)[2][2][4][2], const pg8::Unit& u, int wr, int wc, int fr, int fq, float (&)[8], int&) const {
        const int row0 = u.pm * 256 + wr * 64 + fr, col0 = u.pn * 256 + wc * 32 + 8 * fq;
        u32x4 bv[2][4][2];
#pragma unroll
        for (int ai = 0; ai < 2; ++ai)
#pragma unroll
            for (int m = 0; m < 4; ++m)
#pragma unroll
                for (int bj = 0; bj < 2; ++bj) bv[ai][m][bj] = *(const u32x4*)(sb + (size_t)(row0 + ai * 128 + m * 16) * DM + col0 + bj * 128);
#pragma unroll
        for (int ai = 0; ai < 2; ++ai)
#pragma unroll
            for (int m = 0; m < 4; ++m)
#pragma unroll
                for (int bj = 0; bj < 2; ++bj) {
                    const size_t off = (size_t)(row0 + ai * 128 + m * 16) * DM + col0 + bj * 128;
                    const u32x4 b = bv[ai][m][bj];
                    u32x4 w;
#pragma unroll
                    for (int q = 0; q < 4; ++q) w[q] = cvt_pk_bf16(acc[ai][bj][m][q >> 1][(q & 1) * 2] * bf_lo(b[q]), acc[ai][bj][m][q >> 1][(q & 1) * 2 + 1] * bf_hi(b[q]));
                    *(u32x4*)(mout + off) = w;
                }
    }
};
struct Epi3 {
    static constexpr bool HAS_MID = false;
    const float* xin_f; float* xout_f; bf16_t* xbf; float* ssqx;
    __device__ __forceinline__ void mid(f32x4 (&)[2][2][4][2], const pg8::Unit&, int, int, int, int) const {}
    __device__ __forceinline__ void operator()(const f32x4 (&acc)[2][2][4][2], const pg8::Unit& u, int wr, int wc, int fr, int fq, float (&)[8], int&) const {
        const int row0 = u.pm * 256 + wr * 64 + fr, col0 = u.pn * 256 + wc * 32 + 8 * fq;
#pragma unroll
        for (int ai = 0; ai < 2; ++ai) {
            f32x4 xv[4][2][2];
            if (xin_f) {
#pragma unroll
                for (int m = 0; m < 4; ++m)
#pragma unroll
                    for (int bj = 0; bj < 2; ++bj) { const size_t off = (size_t)(row0 + ai * 128 + m * 16) * DM + col0 + bj * 128; xv[m][bj][0] = *(const f32x4*)(xin_f + off); xv[m][bj][1] = *(const f32x4*)(xin_f + off + 4); }
            } else {
                u32x4 xb_[4][2];
#pragma unroll
                for (int m = 0; m < 4; ++m)
#pragma unroll
                    for (int bj = 0; bj < 2; ++bj) xb_[m][bj] = *(const u32x4*)(xbf + (size_t)(row0 + ai * 128 + m * 16) * DM + col0 + bj * 128);
#pragma unroll
                for (int m = 0; m < 4; ++m)
#pragma unroll
                    for (int bj = 0; bj < 2; ++bj) { const u32x4 w = xb_[m][bj];
                        xv[m][bj][0] = (f32x4){bf_lo(w.x), bf_hi(w.x), bf_lo(w.y), bf_hi(w.y)}; xv[m][bj][1] = (f32x4){bf_lo(w.z), bf_hi(w.z), bf_lo(w.w), bf_hi(w.w)}; }
            }
#pragma unroll
            for (int m = 0; m < 4; ++m) {
                const int row = row0 + ai * 128 + m * 16; float sq = 0.f;
#pragma unroll
                for (int bj = 0; bj < 2; ++bj) {
                    const size_t off = (size_t)row * DM + col0 + bj * 128;
                    const f32x4 x0 = xv[m][bj][0] + acc[ai][bj][m][0], x1 = xv[m][bj][1] + acc[ai][bj][m][1];
                    sq += (x0[0] * x0[0] + x0[1] * x0[1]) + (x0[2] * x0[2] + x0[3] * x0[3]) + (x1[0] * x1[0] + x1[1] * x1[1]) + (x1[2] * x1[2] + x1[3] * x1[3]);
                    if (xout_f) { *(f32x4*)(xout_f + off) = x0; *(f32x4*)(xout_f + off + 4) = x1; }
                    else { u32x4 w; w.x = cvt_pk_bf16(x0[0], x0[1]); w.y = cvt_pk_bf16(x0[2], x0[3]); w.z = cvt_pk_bf16(x1[0], x1[1]); w.w = cvt_pk_bf16(x1[2], x1[3]); *(u32x4*)(xbf + off) = w; }
                }
                sq += shfl_idx_(sq, (fq * 16 + fr) ^ 16); sq += shfl_idx_(sq, (fq * 16 + fr) ^ 32);
                if (fq == 0) ssqx[(size_t)row * 16 + u.pn * 4 + wc] = sq;
            }
            asm volatile("" ::: "memory");
        }
    }
};

struct TrJob { const float* src; const float* scale; bf16_t* dst; int C, ldd, coff, r0, c0; };
__device__ __forceinline__ TrJob tr_decode(const Params& p, int t) {
    unsigned char* ws = p.ws;
    const int l = t / 2624; int q = t % 2624; TrJob j;
    if (q < 1792) { j.src = p.w_in + (size_t)l * DM * NIN; j.C = NIN; j.scale = p.norm_g + l * DM; j.ldd = DM; j.coff = 0; j.r0 = (q / 112) * 64; j.c0 = (q % 112) * 64;
        const int n = j.c0; int d0 = n;
        if (n < 1024) d0 = (n >> 7) * 256 + (n & 127); else if (n < 2048) d0 = 2048 + (n - 1024); else if (n < 3072) d0 = ((n - 2048) >> 7) * 256 + 128 + ((n - 2048) & 127);
        else if (n >= 6144) d0 = 5120 + ((n - 6144) >> 7) * 256 + 128 + ((n - 6144) & 127); else if (n >= 5120) d0 = 5120 + ((n - 5120) >> 7) * 256 + ((n - 5120) & 127);
        j.dst = (bf16_t*)(ws + WS_WIN) + (size_t)l * NIN * DM + (ptrdiff_t)(d0 - j.c0) * DM; return j; }
    q -= 1792; j.scale = nullptr;
    if (q < 256) { j.src = p.w_proj_a + (size_t)l * DM * DM; j.C = DM; j.dst = (bf16_t*)(ws + WS_WP) + (size_t)l * DM * 2048; j.ldd = 2048; j.coff = 0; j.r0 = (q / 16) * 64; j.c0 = (q % 16) * 64; return j; }
    q -= 256;
    if (q < 256) { j.src = p.w_proj_b + (size_t)l * DM * DM; j.C = DM; j.dst = (bf16_t*)(ws + WS_WP) + (size_t)l * DM * 2048; j.ldd = 2048; j.coff = 1024; j.r0 = (q / 16) * 64; j.c0 = (q % 16) * 64; return j; }
    q -= 256;
    if (q < 256) { j.src = p.w_out + (size_t)l * DM * DM; j.C = DM; j.dst = (bf16_t*)(ws + WS_WO) + (size_t)l * DM * DM; j.ldd = DM; j.coff = 0; j.r0 = (q / 16) * 64; j.c0 = (q % 16) * 64; return j; }
    q -= 256;
    const bool ig = q >= 32; if (ig) q -= 32;
    const int h = q >> 2, tt = q & 3;
    j.src = (ig ? p.w_igate : p.w_rgate) + ((size_t)l * 8 + h) * 16384; j.C = 128; j.dst = (bf16_t*)(ws + (ig ? WS_WIT : WS_WRT)) + ((size_t)l * 8 + h) * 16384; j.ldd = 128; j.coff = 0; j.r0 = (tt >> 1) * 64; j.c0 = (tt & 1) * 64;
    return j;
}

__device__ void phase_prep(const Params& p, LAS unsigned char* lds, int wid_s) {
    int tid_ = wid_s * 64 + lane_id_(); asm volatile("" : "+v"(tid_));
    const int tid = tid_, G = gridDim.x;
    unsigned char* ws = p.ws;
    LAS float* tile = (LAS float*)lds;
    {
        const int NT = DEPTH * 2624;
        const int lr = tid >> 4, c4 = (tid & 15) * 4;
        int t = blockIdx.x;
        TrJob job; f32x4 v0, v1; float s0 = 1.f, s1 = 1.f;
        if (t < NT) { job = tr_decode(p, t);
            v0 = *(const f32x4*)(job.src + (size_t)(job.r0 + lr) * job.C + job.c0 + c4); v1 = *(const f32x4*)(job.src + (size_t)(job.r0 + 32 + lr) * job.C + job.c0 + c4);
            if (job.scale) { s0 = job.scale[job.r0 + lr]; s1 = job.scale[job.r0 + 32 + lr]; } }
        for (; t < NT; t += G) {
            TrJob nxt = job; f32x4 n0 = v0, n1 = v1; float ns0 = 1.f, ns1 = 1.f;
            if (t + G < NT) { nxt = tr_decode(p, t + G);
                n0 = *(const f32x4*)(nxt.src + (size_t)(nxt.r0 + lr) * nxt.C + nxt.c0 + c4); n1 = *(const f32x4*)(nxt.src + (size_t)(nxt.r0 + 32 + lr) * nxt.C + nxt.c0 + c4);
                if (nxt.scale) { ns0 = nxt.scale[nxt.r0 + lr]; ns1 = nxt.scale[nxt.r0 + 32 + lr]; } }
            tile[(c4 + 0) * 65 + lr] = v0[0] * s0; tile[(c4 + 1) * 65 + lr] = v0[1] * s0; tile[(c4 + 2) * 65 + lr] = v0[2] * s0; tile[(c4 + 3) * 65 + lr] = v0[3] * s0;
            tile[(c4 + 0) * 65 + 32 + lr] = v1[0] * s1; tile[(c4 + 1) * 65 + 32 + lr] = v1[1] * s1; tile[(c4 + 2) * 65 + 32 + lr] = v1[2] * s1; tile[(c4 + 3) * 65 + 32 + lr] = v1[3] * s1;
            __syncthreads();
            const int c = tid >> 3, r8 = (tid & 7) * 8;
            float f[8];
#pragma unroll
            for (int j = 0; j < 8; ++j) f[j] = tile[c * 65 + r8 + j];
            u32x4 w; w.x = cvt_pk_bf16(f[0], f[1]); w.y = cvt_pk_bf16(f[2], f[3]); w.z = cvt_pk_bf16(f[4], f[5]); w.w = cvt_pk_bf16(f[6], f[7]);
            *(u32x4*)(job.dst + (size_t)(job.c0 + c) * job.ldd + job.coff + job.r0 + r8) = w;
            __syncthreads();
            job = nxt; v0 = n0; v1 = n1; s0 = ns0; s1 = ns1;
        }
    }
    for (int e = blockIdx.x * 512 + tid; e < DEPTH * 8 * 128 * 128 / 8; e += G * 512) {
        const int s8 = (e & 15) * 8, t = (e >> 4) & 127;
        const f32x4 a = *(const f32x4*)(p.w_spatial + (size_t)e * 8), b = *(const f32x4*)(p.w_spatial + (size_t)e * 8 + 4);
        float f[8] = {a[0], a[1], a[2], a[3], b[0], b[1], b[2], b[3]};
#pragma unroll
        for (int j = 0; j < 8; ++j) f[j] = (s8 + j <= t) ? f[j] : 0.f;
        u32x4 w; w.x = cvt_pk_bf16(f[0], f[1]); w.y = cvt_pk_bf16(f[2], f[3]); w.z = cvt_pk_bf16(f[4], f[5]); w.w = cvt_pk_bf16(f[6], f[7]);
        *(u32x4*)((bf16_t*)(ws + WS_WSB) + (size_t)e * 8) = w;
    }
    {
        const int wave = tid >> 6, lane = tid & 63;
        bf16_t* xbf = (bf16_t*)(ws + WS_XBF); float* ssqx = (float*)(ws + WS_SSQX);
        for (int row = (blockIdx.x * 8 + wave) * 2; row < MTOT; row += G * 16) {
            f32x4 v[2][4];
#pragma unroll
            for (int r = 0; r < 2; ++r)
#pragma unroll
                for (int i = 0; i < 4; ++i) v[r][i] = *(const f32x4*)(p.x + (size_t)(row + r) * DM + i * 256 + lane * 4);
#pragma unroll
            for (int r = 0; r < 2; ++r) {
                float sq = 0.f;
#pragma unroll
                for (int i = 0; i < 4; ++i) {
                    sq += (v[r][i][0] * v[r][i][0] + v[r][i][1] * v[r][i][1]) + (v[r][i][2] * v[r][i][2] + v[r][i][3] * v[r][i][3]);
                    u32x2 w; w.x = cvt_pk_bf16(v[r][i][0], v[r][i][1]); w.y = cvt_pk_bf16(v[r][i][2], v[r][i][3]);
                    *(u32x2*)(xbf + (size_t)(row + r) * DM + i * 256 + lane * 4) = w;
                }
#pragma unroll
                for (int d = 1; d < 64; d <<= 1) sq += shfl_idx_(sq, lane ^ d);
                if (lane < 16) ssqx[(size_t)(row + r) * 16 + lane] = (lane == 0) ? sq : 0.f;
            }
        }
    }
    for (int e = blockIdx.x * 512 + tid; e < NBITEM * 8; e += G * 512) ((unsigned*)(ws + WS_FLG))[e] = 0u;
}

__device__ __forceinline__ void mixerA_phase(const Params& p, LAS unsigned char* lds, int l_in, int wid_s) {
    int tid_ = wid_s * 64 + lane_id_(); asm volatile("" : "+v"(tid_));
    int l = l_in; asm volatile("" : "+s"(l));
    const int tid = tid_, wid = tid >> 6, lane = tid & 63, fr = lane & 15, fq = lane >> 4;
    const int G = gridDim.x;
    unsigned char* ws = p.ws;
    const bf16_t* gu = (const bf16_t*)(ws + WS_PROJ); const bf16_t* gv = gu + (size_t)MG * DM;
    const float* ssqv = (const float*)(ws + WS_SSQV);
    bf16_t* ybuf = (bf16_t*)(ws + WS_Y);
    LAS bf16_t* sVT = (LAS bf16_t*)lds;
    const int tok = tid >> 2, cl = tid & 3;
    const int cb32 = (wid & 3) * 32, th = wid >> 2;
    const int Ge = G & ~7;
    if ((int)blockIdx.x >= Ge) return;
    const int gi = blockIdx.x & 7;
    const int cch = gi * 128 + cb32 + 8 * fq;
    bf16x8 wf[10]; f32x4 vg0, vg1; float bs[4];
    {
        const bf16_t* wsb = (const bf16_t*)(ws + WS_WSB) + ((size_t)l * 8 + gi) * 16384;
        int n = 0;
#pragma unroll
        for (int j = 0; j < 4; ++j) {
            const int i = th ? ((j == 0) ? 1 : (j == 1) ? 2 : (j == 2) ? 5 : 6) : ((j == 0) ? 0 : (j == 1) ? 3 : (j == 2) ? 4 : 7);
#pragma unroll
            for (int ks = 0; ks <= j; ++ks) { wf[n] = *(const bf16x8*)(wsb + (16 * i + fr) * 128 + ks * 32 + 8 * fq); ++n; }
            bs[j] = p.b_spatial[((size_t)l * 8 + gi) * 128 + 16 * i + fr];
        }
        vg0 = *(const f32x4*)(p.v_norm_g + l * DM + cch); vg1 = *(const f32x4*)(p.v_norm_g + l * DM + cch + 4);
    }
    u32x4 pv[4]; f32x4 pq[4];
#define A_LOAD(it_) do { const int rb_ = ((it_) >> 3) * 128, gi_ = (it_) & 7; \
        _Pragma("unroll") for (int i_ = 0; i_ < 4; ++i_) { pv[i_] = *(const u32x4*)(gv + (size_t)(rb_ + tok) * DM + gi_ * 128 + (4 * i_ + cl) * 8); pq[i_] = *(const f32x4*)(ssqv + (size_t)(rb_ + tok) * 16 + 4 * i_); } } while (0)
    int it = blockIdx.x;
    if (it < NAITEM) A_LOAD(it);
    for (; it < NAITEM; it += Ge) {
        const int chunk = it >> 3, rowbase = chunk * 128;
        u32x4 uu[4];
#pragma unroll
        for (int j = 0; j < 4; ++j) { const int i = th ? ((j == 0) ? 1 : (j == 1) ? 2 : (j == 2) ? 5 : 6) : ((j == 0) ? 0 : (j == 1) ? 3 : (j == 2) ? 4 : 7);
            uu[j] = *(const u32x4*)(gu + (size_t)(rowbase + 16 * i + fr) * DM + cch); }
        __syncthreads();
        {
            const f32x4 a = pq[0], b = pq[1], c = pq[2], d = pq[3];
            const float ssum = ((a[0] + a[1]) + (a[2] + a[3])) + ((b[0] + b[1]) + (b[2] + b[3])) + ((c[0] + c[1]) + (c[2] + c[3])) + ((d[0] + d[1]) + (d[2] + d[3]));
            const float rs = __builtin_amdgcn_rsqf(ssum * (1.0f / DM) + EPS);
#pragma unroll
            for (int i = 0; i < 4; ++i) {
                const int c8 = 4 * i + cl;
#pragma unroll
                for (int k = 0; k < 4; ++k) {
                    const unsigned pk = cvt_pk_bf16(bf_lo(pv[i][k]) * rs, bf_hi(pv[i][k]) * rs);
                    sVT[(c8 * 8 + 2 * k) * 136 + tok] = (bf16_t)(pk & 0xffffu);
                    sVT[(c8 * 8 + 2 * k + 1) * 136 + tok] = (bf16_t)(pk >> 16);
                }
            }
        }
        __syncthreads();
        if (it + Ge < NAITEM) A_LOAD(it + Ge);
        bf16x8 vf[2][4];
#pragma unroll
        for (int n2 = 0; n2 < 2; ++n2)
#pragma unroll
            for (int ks = 0; ks < 4; ++ks) vf[n2][ks] = *(const LAS bf16x8*)(sVT + (cb32 + 8 * (fr >> 2) + 4 * n2 + (fr & 3)) * 136 + ks * 32 + 8 * fq);
        int n = 0;
#pragma unroll
        for (int j = 0; j < 4; ++j) {
            const int i = th ? ((j == 0) ? 1 : (j == 1) ? 2 : (j == 2) ? 5 : 6) : ((j == 0) ? 0 : (j == 1) ? 3 : (j == 2) ? 4 : 7);
            f32x4 acc0 = (f32x4){0.f, 0.f, 0.f, 0.f}, acc1 = (f32x4){0.f, 0.f, 0.f, 0.f};
#pragma unroll
            for (int ks = 0; ks <= j; ++ks) { acc0 = __builtin_amdgcn_mfma_f32_16x16x32_bf16(vf[0][ks], wf[n], acc0, 0, 0, 0); acc1 = __builtin_amdgcn_mfma_f32_16x16x32_bf16(vf[1][ks], wf[n], acc1, 0, 0, 0); ++n; }
            const int t = 16 * i + fr;
            const u32x4 w = uu[j];
            const float y0 = bf_lo(w.x) * (vg0[0] * acc0[0] + bs[j]), y1 = bf_hi(w.x) * (vg0[1] * acc0[1] + bs[j]);
            const float y2 = bf_lo(w.y) * (vg0[2] * acc0[2] + bs[j]), y3 = bf_hi(w.y) * (vg0[3] * acc0[3] + bs[j]);
            const float y4 = bf_lo(w.z) * (vg1[0] * acc1[0] + bs[j]), y5 = bf_hi(w.z) * (vg1[1] * acc1[1] + bs[j]);
            const float y6 = bf_lo(w.w) * (vg1[2] * acc1[2] + bs[j]), y7 = bf_hi(w.w) * (vg1[3] * acc1[3] + bs[j]);
            u32x4 o; o.x = cvt_pk_bf16(y0, y1); o.y = cvt_pk_bf16(y2, y3); o.z = cvt_pk_bf16(y4, y5); o.w = cvt_pk_bf16(y6, y7);
            *(u32x4*)(ybuf + (size_t)(rowbase + t) * 2048 + cch) = o;
        }
    }
#undef A_LOAD
}

#define DPP_SHR(v, ident, d) __uint_as_float((unsigned)__builtin_amdgcn_update_dpp((int)__float_as_uint(ident), (int)__float_as_uint(v), 0x110 + (d), 0xf, 0xf, false))

constexpr int LSB = 256, NSB = SEQ / LSB, XB_OFF1 = LSB * 136 * 2, CW_OFF = 2 * XB_OFF1, AGG_OFF = CW_OFF + 2560, XBAR_LDS_OFF = AGG_OFF + 1024;
__device__ __forceinline__ void mixerB_phase(const Params& p, LAS unsigned char* lds, int l_in, int wid_s) {
    int tid_ = wid_s * 64 + lane_id_(); asm volatile("" : "+v"(tid_));
    int l = l_in; asm volatile("" : "+s"(l));
    const int tid = tid_, wid = __builtin_amdgcn_readfirstlane(tid >> 6), lane = tid & 63, fr = lane & 15, fq = lane >> 4;
    const int G = gridDim.x;
    unsigned char* ws = p.ws;
    const bf16_t* xb = (const bf16_t*)(ws + WS_PROJ) + (size_t)3 * MG * DM; const bf16_t* zb = (const bf16_t*)(ws + WS_PROJ) + (size_t)4 * MG * DM;
    bf16_t* ybuf = (bf16_t*)(ws + WS_Y);
    LAS float* sCW = (LAS float*)(lds + CW_OFF);
    LAS float* sAgg = (LAS float*)(lds + AGG_OFF);
    const int c8 = (tid & 15) * 8, t8 = (tid >> 4) * 8;
    const int chh = wid & 1, tq = wid >> 1;
    for (int task = blockIdx.x; task < BG * 8 * 4; task += G) {
        const int bh = task & (BG * 8 - 1), cq = task / (BG * 8), bl = bh >> 3, h = bh & 7;
        const int j0 = cq * 32 + chh * 16, chl = h * 128 + j0 + 4 * fq;
        __syncthreads();
        for (int e = tid; e < 640; e += 512) { const int k = e >> 7, c = e & 127; sCW[e] = (k < 4) ? p.conv_w[((size_t)l * 4 + k) * DM + h * 128 + c] : p.conv_b[(size_t)l * DM + h * 128 + c]; }
        bf16x8 wrf[4], wif[4]; f32x4 br, bi, nsp;
        {
            const bf16_t* wr_ = (const bf16_t*)(ws + WS_WRT) + ((size_t)l * 8 + h) * 16384 + (j0 + fr) * 128 + 8 * fq;
            const bf16_t* wi_ = (const bf16_t*)(ws + WS_WIT) + ((size_t)l * 8 + h) * 16384 + (j0 + fr) * 128 + 8 * fq;
#pragma unroll
            for (int ks = 0; ks < 4; ++ks) { wrf[ks] = *(const bf16x8*)(wr_ + ks * 32); wif[ks] = *(const bf16x8*)(wi_ + ks * 32); }
            br = *(const f32x4*)(p.b_rgate + (size_t)l * DM + chl); bi = *(const f32x4*)(p.b_igate + (size_t)l * DM + chl);
            const f32x4 lam = *(const f32x4*)(p.lru_lambda + (size_t)l * DM + chl);
#pragma unroll
            for (int r = 0; r < 4; ++r) { const float z = -lam[r]; nsp[r] = -8.0f * (fmaxf(z, 0.f) + log1pf(expf(-fabsf(z)))); }
        }
        u32x4 xr[11];
#define XB_LOAD(seg_) do { const int rb_ = bl * SEQ + (seg_) * LSB, ch_ = h * 128 + c8; \
        _Pragma("unroll") for (int r_ = 0; r_ < 11; ++r_) { const int t_ = t8 - 3 + r_; xr[r_] = (u32x4){0u, 0u, 0u, 0u}; \
            if (t_ >= 0 || (seg_) > 0) xr[r_] = *(const u32x4*)(xb + (size_t)(rb_ + t_) * DM + ch_); } } while (0)
        XB_LOAD(0);
        float S[4] = {0.f, 0.f, 0.f, 0.f};
        __syncthreads();
        for (int seg = 0; seg < NSB; ++seg) {
            const int rowbase = bl * SEQ + seg * LSB;
            LAS bf16_t* sXb = (LAS bf16_t*)(lds + (seg & 1) * XB_OFF1);
            {
                f32x2 cw2[5][4];
#pragma unroll
                for (int k = 0; k < 5; ++k) { const f32x4 a = *(const LAS f32x4*)(sCW + k * 128 + c8), b = *(const LAS f32x4*)(sCW + k * 128 + c8 + 4);
                    cw2[k][0] = (f32x2){a[0], a[1]}; cw2[k][1] = (f32x2){a[2], a[3]}; cw2[k][2] = (f32x2){b[0], b[1]}; cw2[k][3] = (f32x2){b[2], b[3]}; }
                f32x2 ur[11][4];
#pragma unroll
                for (int r = 0; r < 3; ++r)
#pragma unroll
                    for (int k = 0; k < 4; ++k) ur[r][k] = (f32x2){bf_lo(xr[r][k]), bf_hi(xr[r][k])};
#pragma unroll
                for (int tt = 0; tt < 8; ++tt) {
#pragma unroll
                    for (int k = 0; k < 4; ++k) ur[tt + 3][k] = (f32x2){bf_lo(xr[tt + 3][k]), bf_hi(xr[tt + 3][k])};
                    f32x2 o2[4];
#pragma unroll
                    for (int k = 0; k < 4; ++k) o2[k] = cw2[4][k] + cw2[0][k] * ur[tt][k] + cw2[1][k] * ur[tt + 1][k] + cw2[2][k] * ur[tt + 2][k] + cw2[3][k] * ur[tt + 3][k];
                    u32x4 w; w.x = cvt_pk_bf16(o2[0].x, o2[0].y); w.y = cvt_pk_bf16(o2[1].x, o2[1].y); w.z = cvt_pk_bf16(o2[2].x, o2[2].y); w.w = cvt_pk_bf16(o2[3].x, o2[3].y);
                    *(LAS u32x4*)(sXb + (t8 + tt) * 136 + c8) = w;
                }
            }
            __syncthreads();
            if (seg + 1 < NSB) XB_LOAD(seg + 1);
            u32x2 zz[4];
#pragma unroll
            for (int tt = 0; tt < 4; ++tt) zz[tt] = *(const u32x2*)(zb + (size_t)(rowbase + 64 * tq + 16 * tt + fr) * DM + chl);
            float Pt[4][4], Ht[4][4];
            float Pc[4] = {1.f, 1.f, 1.f, 1.f}, Hc[4] = {0.f, 0.f, 0.f, 0.f};
            f32x4 aRa[4], aIa[4]; u32x2 xcwa[4];
#pragma unroll
            for (int tt = 0; tt < 4; ++tt) {
                const int trow = 64 * tq + 16 * tt + fr;
                aRa[tt] = (f32x4){0.f, 0.f, 0.f, 0.f}; aIa[tt] = (f32x4){0.f, 0.f, 0.f, 0.f};
#pragma unroll
                for (int ks = 0; ks < 4; ++ks) {
                    const bf16x8 xf = *(const LAS bf16x8*)(sXb + trow * 136 + ks * 32 + 8 * fq);
                    aRa[tt] = __builtin_amdgcn_mfma_f32_16x16x32_bf16(wrf[ks], xf, aRa[tt], 0, 0, 0);
                    aIa[tt] = __builtin_amdgcn_mfma_f32_16x16x32_bf16(wif[ks], xf, aIa[tt], 0, 0, 0);
                }
                xcwa[tt] = *(const LAS u32x2*)(sXb + trow * 136 + j0 + 4 * fq);
            }
            __builtin_amdgcn_sched_barrier(0);
#pragma unroll
            for (int tt = 0; tt < 4; ++tt) {
                const f32x4 aR = aRa[tt], aI = aIa[tt];
                const u32x2 xcw = xcwa[tt];
                const f32x4 xc = (f32x4){bf_lo(xcw.x), bf_hi(xcw.x), bf_lo(xcw.y), bf_hi(xcw.y)};
                float Av[4], Bw[4];
#pragma unroll
                for (int pp = 0; pp < 2; ++pp) {
                    const f32x2 zr = ((f32x2){aR[2 * pp], aR[2 * pp + 1]} + (f32x2){br[2 * pp], br[2 * pp + 1]}) * -1.4426950409f;
                    const f32x2 zi = ((f32x2){aI[2 * pp], aI[2 * pp + 1]} + (f32x2){bi[2 * pp], bi[2 * pp + 1]}) * -1.4426950409f;
                    f32x2 er, ei; er.x = fast_exp2(zr.x); er.y = fast_exp2(zr.y); ei.x = fast_exp2(zi.x); ei.y = fast_exp2(zi.y);
                    const f32x2 dr = er + 1.0f, di = ei + 1.0f;
                    f32x2 rg, ig; rg.x = fast_rcp(dr.x); rg.y = fast_rcp(dr.y); ig.x = fast_rcp(di.x); ig.y = fast_rcp(di.y);
                    const f32x2 la = (f32x2){nsp[2 * pp], nsp[2 * pp + 1]} * rg;
                    const f32x2 la2 = la * 1.4426950409f;
                    f32x2 a; a.x = fast_exp2(la2.x); a.y = fast_exp2(la2.y);
                    const f32x2 x2 = la * 2.0f;
                    const f32x2 em = x2 * (x2 * (x2 * (x2 * (x2 * (x2 * 0.0013888889f + 0.0083333338f) + 0.041666668f) + 0.16666667f) + 0.5f) + 1.0f);
                    const f32x2 ga = a * a * -1.0f + 1.0f;
                    f32x2 g2; g2.x = (x2.x > -0.25f) ? -em.x : ga.x; g2.y = (x2.y > -0.25f) ? -em.y : ga.y;
                    f32x2 sq; sq.x = __builtin_amdgcn_sqrtf(fmaxf(g2.x, 0.f)); sq.y = __builtin_amdgcn_sqrtf(fmaxf(g2.y, 0.f));
                    const f32x2 bv = sq * (ig * (f32x2){xc[2 * pp], xc[2 * pp + 1]});
                    Av[2 * pp] = a.x; Av[2 * pp + 1] = a.y; Bw[2 * pp] = bv.x; Bw[2 * pp + 1] = bv.y;
                }
#define SCAN_STEP(d) asm volatile("s_nop 1\n" \
                    "v_fmac_f32_dpp %0, %0, %4 row_shr:" #d " row_mask:0xf bank_mask:0xf\n v_fmac_f32_dpp %1, %1, %5 row_shr:" #d " row_mask:0xf bank_mask:0xf\n" \
                    "v_fmac_f32_dpp %2, %2, %6 row_shr:" #d " row_mask:0xf bank_mask:0xf\n v_fmac_f32_dpp %3, %3, %7 row_shr:" #d " row_mask:0xf bank_mask:0xf\n" \
                    "v_mul_f32_dpp %4, %4, %4 row_shr:" #d " row_mask:0xf bank_mask:0xf\n v_mul_f32_dpp %5, %5, %5 row_shr:" #d " row_mask:0xf bank_mask:0xf\n" \
                    "v_mul_f32_dpp %6, %6, %6 row_shr:" #d " row_mask:0xf bank_mask:0xf\n v_mul_f32_dpp %7, %7, %7 row_shr:" #d " row_mask:0xf bank_mask:0xf" \
                    : "+v"(Bw[0]), "+v"(Bw[1]), "+v"(Bw[2]), "+v"(Bw[3]), "+v"(Av[0]), "+v"(Av[1]), "+v"(Av[2]), "+v"(Av[3]))
                SCAN_STEP(1); SCAN_STEP(2); SCAN_STEP(4); SCAN_STEP(8);
#undef SCAN_STEP
#pragma unroll
                for (int r = 0; r < 4; ++r) {
                    const float A = Av[r], Bv = Bw[r];
                    const float P = A * Pc[r], H = A * Hc[r] + Bv;
                    Pt[tt][r] = P; Ht[tt][r] = H;
                    Pc[r] = shfl_idx_(P, lane | 15); Hc[r] = shfl_idx_(H, lane | 15);
                }
            }
            if (fr == 0) {
                LAS float* q = sAgg + ((tq * 2 + chh) * 16 + 4 * fq) * 2;
                *(LAS f32x4*)q = (f32x4){Pc[0], Hc[0], Pc[1], Hc[1]}; *(LAS f32x4*)(q + 4) = (f32x4){Pc[2], Hc[2], Pc[3], Hc[3]};
            }
            __syncthreads();
            float carry[4] = {S[0], S[1], S[2], S[3]};
#pragma unroll
            for (int qd = 0; qd < 4; ++qd) {
                const LAS float* q = sAgg + ((qd * 2 + chh) * 16 + 4 * fq) * 2;
                const f32x4 a0 = *(const LAS f32x4*)q, a1 = *(const LAS f32x4*)(q + 4);
                if (qd == tq) { carry[0] = S[0]; carry[1] = S[1]; carry[2] = S[2]; carry[3] = S[3]; }
                S[0] = a0[0] * S[0] + a0[1]; S[1] = a0[2] * S[1] + a0[3]; S[2] = a1[0] * S[2] + a1[1]; S[3] = a1[2] * S[3] + a1[3];
            }
#pragma unroll
            for (int tt = 0; tt < 4; ++tt) {
                const int t = 64 * tq + 16 * tt + fr;
                const float y0 = (Ht[tt][0] + Pt[tt][0] * carry[0]) * bf_lo(zz[tt].x), y1 = (Ht[tt][1] + Pt[tt][1] * carry[1]) * bf_hi(zz[tt].x);
                const float y2 = (Ht[tt][2] + Pt[tt][2] * carry[2]) * bf_lo(zz[tt].y), y3 = (Ht[tt][3] + Pt[tt][3] * carry[3]) * bf_hi(zz[tt].y);
                u32x2 ov; ov.x = cvt_pk_bf16(y0, y1); ov.y = cvt_pk_bf16(y2, y3);
                *(u32x2*)(ybuf + (size_t)(rowbase + t) * 2048 + 1024 + chl) = ov;
            }
        }
#undef XB_LOAD
    }
}

__device__ void phase_final(const Params& p, int wid_s) {
    int tid_ = wid_s * 64 + lane_id_(); asm volatile("" : "+v"(tid_));
    const int tid = tid_, wave = tid >> 6, lane = tid & 63, G = gridDim.x;
    const float* ssqx = (const float*)(p.ws + WS_SSQX);
    f32x4 gv[4];
#pragma unroll
    for (int i = 0; i < 4; ++i) gv[i] = *(const f32x4*)(p.final_g + i * 256 + lane * 4);
    for (int row = blockIdx.x * 8 + wave; row < MTOT; row += G * 8) {
        float s = (lane < 16) ? ssqx[(size_t)row * 16 + lane] : 0.f;
#pragma unroll
        for (int d = 1; d < 16; d <<= 1) s += shfl_idx_(s, lane ^ d);
        s = shfl_idx_(s, lane & 0);
        const float rstd = __builtin_amdgcn_rsqf(s * (1.0f / DM) + EPS);
        float* xr = p.out + (size_t)row * DM; const bf16_t* xb = (const bf16_t*)(p.ws + WS_XBF) + (size_t)row * DM;
        u32x2 w[4];
#pragma unroll
        for (int i = 0; i < 4; ++i) w[i] = *(const u32x2*)(xb + i * 256 + lane * 4);
#pragma unroll
        for (int i = 0; i < 4; ++i) { f32x4 v = (f32x4){bf_lo(w[i].x), bf_hi(w[i].x), bf_lo(w[i].y), bf_hi(w[i].y)}; v = v * rstd * gv[i]; *(f32x4*)(xr + i * 256 + lane * 4) = v; }
    }
}

#define XB_TMO      128
#define XB_XCNT(j)  (256  + 64 * (j))
#define XB_XSUB(j)  (1280 + 64 * (j))
#define XB_XGEN(j)  (2304 + 64 * (j))
#define XB_TOP      3328
#define XB_TOPGEN   3392
#define XCD_BAR_WORDS 3456
#define XB_SPIN_CAP (1u << 18)
__device__ __forceinline__ unsigned xb_ld(unsigned* p)              { return __hip_atomic_load(p, __ATOMIC_RELAXED, __HIP_MEMORY_SCOPE_AGENT); }
__device__ __forceinline__ unsigned xb_add(unsigned* p, unsigned v) { return __hip_atomic_fetch_add(p, v, __ATOMIC_RELAXED, __HIP_MEMORY_SCOPE_AGENT); }
__device__ __forceinline__ unsigned xb_xcc_id() { return (unsigned)__builtin_amdgcn_s_getreg((3 << 11) | 20) & 0xFu; }
#define XB_SPIN(cond, bar) do { unsigned _sp = 0; while (cond) { __builtin_amdgcn_s_sleep(1); \
    if ((++_sp & 255u) == 0u) { if (xb_ld(&(bar)[XB_TMO])) break; if (_sp > XB_SPIN_CAP) { atomicAdd(&(bar)[XB_TMO], 1u); break; } } } } while (0)
struct XcdBarrier { unsigned* bar; unsigned x; volatile LAS unsigned* st; };
__device__ __forceinline__ XcdBarrier xcd_barrier_post(unsigned* bar, volatile LAS unsigned* st, int wid_s) {
    XcdBarrier b; b.bar = bar; b.x = xb_xcc_id(); b.st = st;
    if (wid_s == 0 && lane_id_() == 0) (void)xb_add(&bar[XB_XCNT(b.x)], 1u);
    return b;
}
__device__ __forceinline__ void xcd_barrier_complete(unsigned* bar, unsigned x, unsigned& nloc, unsigned& nx) {
    const unsigned G = gridDim.x * gridDim.y * gridDim.z;
    unsigned sum, cnt, mine, sp = 0u;
    for (;;) {
        sum = 0u; cnt = 0u; mine = 0u;
#pragma unroll
        for (unsigned j = 0; j < 16; ++j) { const unsigned c = xb_ld(&bar[XB_XCNT(j)]); sum += c; cnt += (c > 0u) ? 1u : 0u; mine = (j == x) ? c : mine; }
        if (sum == G) break;
        __builtin_amdgcn_s_sleep(1);
        if ((++sp & 255u) == 0u) { if (xb_ld(&bar[XB_TMO])) break; if (sp > XB_SPIN_CAP) { atomicAdd(&bar[XB_TMO], 1u); break; } }
    }
    nloc = mine > 0u ? mine : 1u; nx = cnt > 0u ? cnt : 1u;
}
__device__ __forceinline__ void xcd_barrier(const XcdBarrier& b, int wid_s) {
    asm volatile("s_waitcnt vmcnt(0)" ::: "memory");
    __syncthreads();
    if (wid_s == 0 && lane_id_() == 0) {
        unsigned* bar = b.bar;
        __builtin_amdgcn_s_waitcnt(0);
        unsigned nloc = b.st[0], nx = b.st[1];
        if (nloc == 0u) { xcd_barrier_complete(bar, b.x, nloc, nx); b.st[0] = nloc; b.st[1] = nx; }
        const unsigned old = xb_add(&bar[XB_XSUB(b.x)], 1u);
        const unsigned gen = old / nloc;
        if (old + 1u == (gen + 1u) * nloc) {
            __builtin_amdgcn_fence(__ATOMIC_RELEASE, "agent");
            asm volatile("s_waitcnt vmcnt(0)" ::: "memory");
            const unsigned og = xb_add(&bar[XB_TOP], 1u);
            const unsigned tg = og / nx;
            if (og + 1u == (tg + 1u) * nx) xb_add(&bar[XB_TOPGEN], 1u);
            else XB_SPIN(xb_ld(&bar[XB_TOPGEN]) == tg, bar);
            __builtin_amdgcn_fence(__ATOMIC_ACQUIRE, "agent");
            xb_add(&bar[XB_XGEN(b.x)], 1u);
            asm volatile("s_waitcnt vmcnt(0)" ::: "memory");
        } else {
            XB_SPIN(xb_ld(&bar[XB_XGEN(b.x)]) == gen, bar);
            __builtin_amdgcn_fence(__ATOMIC_ACQUIRE, "agent");
            asm volatile("s_waitcnt vmcnt(0)" ::: "memory");
        }
    }
    __syncthreads();
}

__global__ void __launch_bounds__(512, 2) mega_fwd(Params p) {
    extern __shared__ __attribute__((aligned(16))) unsigned char lds_raw[];
    LAS unsigned char* lds = (LAS unsigned char*)lds_raw;
    cg::grid_group grid = cg::this_grid();
    unsigned char* ws = p.ws;
    const int G = gridDim.x;
    const int wid_s = __builtin_amdgcn_readfirstlane((int)threadIdx.x >> 6);
    if (threadIdx.x < 4) ((LAS unsigned*)(lds + XBAR_LDS_OFF))[threadIdx.x] = 0u;
    __syncthreads();
    const XcdBarrier xbar = xcd_barrier_post((unsigned*)(ws + WS_BAR), (volatile LAS unsigned*)(lds + XBAR_LDS_OFF), wid_s);

#ifndef PM
#define PM 0xff
#endif
    if (PM & 1) phase_prep(p, lds, wid_s);
    grid.sync();

    for (int l = 0; l < DEPTH; ++l) {
        for (int grp = 0; grp < NGRP; ++grp) {
            const size_t r0 = (size_t)grp * MG;
            if (PM & 2) {
                pg8::Gemm g{(const bf16_t*)(ws + WS_XBF) + r0 * DM, (const bf16_t*)(ws + WS_WIN) + (size_t)l * NIN * DM, MG, NIN, DM};
                pg8::StaticOrder S; S.init(MG, NIN, G, (int)blockIdx.x);
                LAS float* sbm = (LAS float*)(lds + pg8::STAGE_BYTES);
                { int t_ = wid_s * 64 + lane_id_(); asm volatile("" : "+v"(t_));
                  for (int e = t_; e < 2 * DM; e += 512) sbm[e] = -1.4426950409f * p.b_merge[(size_t)l * 2 * DM + e];
                  __syncthreads(); }
                Epi1 E{(bf16_t*)(ws + WS_PROJ), (const float*)(ws + WS_SSQX) + r0 * 16, (float*)(ws + WS_SSQV), sbm};
                pg8::gemm_phase<Epi1>(lds, g, S, E, wid_s);
#ifdef REPG1
                pg8::gemm_phase<Epi1>(lds, g, S, E, wid_s);
#endif
            }
            xcd_barrier(xbar, wid_s);
            if (PM & 4) {
                const unsigned epoch = (unsigned)(l * NGRP + grp + 1);
#ifndef REPB
#define REPB 1
#define REPA 1
#endif
                for (int rep = 0; rep < REPB; ++rep)
                mixerB_phase(p, lds, l, wid_s);
                for (int rep = 0; rep < REPA; ++rep)
                mixerA_phase(p, lds, l, wid_s);
                __syncthreads();
            }
            xcd_barrier(xbar, wid_s);
            if (PM & 8) {
                pg8::Gemm g{(const bf16_t*)(ws + WS_Y), (const bf16_t*)(ws + WS_WP) + (size_t)l * DM * 2048, MG, DM, 2048};
                pg8::StaticOrder S; S.init(MG, DM, G, (int)blockIdx.x);
                Epi2 E{(const bf16_t*)(ws + WS_PROJ) + (size_t)5 * MG * DM, (const bf16_t*)(ws + WS_PROJ) + (size_t)6 * MG * DM, (bf16_t*)(ws + WS_MB)};
                pg8::gemm_phase<Epi2>(lds, g, S, E, wid_s);
#ifdef REPG2
                pg8::gemm_phase<Epi2>(lds, g, S, E, wid_s);
#endif
            }
            xcd_barrier(xbar, wid_s);
            if (PM & 16) {
                pg8::Gemm g{(const bf16_t*)(ws + WS_MB), (const bf16_t*)(ws + WS_WO) + (size_t)l * DM * DM, MG, DM, DM};
                pg8::StaticOrder S; S.init(MG, DM, G, (int)blockIdx.x);
                Epi3 E{l == 0 ? p.x + r0 * DM : nullptr, nullptr, (bf16_t*)(ws + WS_XBF) + r0 * DM, (float*)(ws + WS_SSQX) + r0 * 16};
                pg8::gemm_phase<Epi3>(lds, g, S, E, wid_s);
            }
            if (NGRP == 1) xcd_barrier(xbar, wid_s);
        }
    }
    xcd_barrier(xbar, wid_s);
    if (PM & 32) phase_final(p, wid_s);
}

extern "C" void kernel_launch(void* const* d_in, const int* in_sizes, int n_in, void* d_out, int out_size, void* d_ws, size_t ws_size, hipStream_t stream) {
    static int grid_blocks = 0;
    if (grid_blocks == 0) {
        if (ws_size < WS_END) { fprintf(stderr, "kernel_launch: workspace too small (%zu < %zu)\n", ws_size, (size_t)WS_END); grid_blocks = -1; return; }
        int dev = 0, cus = 0, per_cu = 0;
        hipGetDevice(&dev);
        hipDeviceGetAttribute(&cus, hipDeviceAttributeMultiprocessorCount, dev);
        hipFuncSetAttribute((const void*)mega_fwd, hipFuncAttributeMaxDynamicSharedMemorySize, LDS_BYTES);
        hipOccupancyMaxActiveBlocksPerMultiprocessor(&per_cu, (const void*)mega_fwd, 512, LDS_BYTES);
        if (per_cu < 1) per_cu = 1;
        grid_blocks = cus * 1;
        fprintf(stderr, "kernel_launch: cus %d per_cu %d grid %d\n", cus, per_cu, grid_blocks);
    }
    if (grid_blocks < 0) return;
    Params p{};
    p.x = (const float*)d_in[0]; p.norm_g = (const float*)d_in[1]; p.w_in = (const float*)d_in[2]; p.b_merge = (const float*)d_in[3]; p.v_norm_g = (const float*)d_in[4];
    p.w_spatial = (const float*)d_in[5]; p.b_spatial = (const float*)d_in[6]; p.conv_w = (const float*)d_in[7]; p.conv_b = (const float*)d_in[8];
    p.w_rgate = (const float*)d_in[9]; p.b_rgate = (const float*)d_in[10]; p.w_igate = (const float*)d_in[11]; p.b_igate = (const float*)d_in[12]; p.lru_lambda = (const float*)d_in[13];
    p.w_proj_a = (const float*)d_in[14]; p.w_proj_b = (const float*)d_in[15]; p.w_out = (const float*)d_in[16]; p.final_g = (const float*)d_in[17];
    p.out = (float*)d_out; p.ws = (unsigned char*)d_ws;
    hipMemsetAsync((unsigned char*)d_ws + WS_BAR, 0, 16384, stream);
    void* args[] = {&p};
    hipError_t e = hipLaunchCooperativeKernel((const void*)mega_fwd, dim3(grid_blocks), dim3(512), args, LDS_BYTES, stream);
    if (e != hipSuccess) fprintf(stderr, "cooperative launch failed: %s (grid %d)\n", hipGetErrorString(e), grid_blocks);
}
```
